# Optimizing an MI355X kernel written in HIP

```python
import jax, jax.numpy as jnp
from jax import lax
import numpy as np

D_MODEL = 1024
BATCH = 8
SEQ = 4096
DEPTH = 4

GRID_W = 64
CTX_LEN = 256
N_EVEN = (DEPTH + 1) // 2
N_ODD = DEPTH // 2
MOD_CHUNKS = 6
EPS = 1e-6
CHUNK = 128
GMLP_GROUP_W = 128
D_GMLP = D_MODEL // 2
GMLP_GROUPS = D_GMLP // GMLP_GROUP_W
FOURIER_GROUP_W = 128
D_FOURIER = D_MODEL // 2
FOURIER_GROUPS = D_FOURIER // FOURIER_GROUP_W
EVEN_IN = 2 * D_GMLP + D_FOURIER
EVEN_MIX = D_GMLP + D_FOURIER
HEAD_DIM = 64
N_HEADS = (D_MODEL // 2) // HEAD_DIM
N_KV_HEADS = 2
Q_PER_KV = N_HEADS // N_KV_HEADS
WINDOW = 128
ATT_BLOCK = 128
AXIS_DIM = HEAD_DIM // 2
ROPE_BASE = 10000.0
D_CONV = D_MODEL // 2
CONV_WIDTH = 3
Q_W = N_HEADS * HEAD_DIM
KV_W = N_KV_HEADS * HEAD_DIM
ODD_SPLITS = (Q_W, Q_W + KV_W, Q_W + 2 * KV_W, Q_W + 2 * KV_W + D_CONV, Q_W + 2 * KV_W + 2 * D_CONV)
ODD_IN = Q_W + 2 * KV_W + 3 * D_CONV
ODD_MIX = Q_W + D_CONV
N_EXPERTS = 64
TOP_K = 6
D_EXPERT = 256
D_SHARED = 256
ROUTED_SCALE = 2.5
EXPERT_BLOCK = 128

kernel_name = "hybrid_gmlp_fourier_swa_conv_moe_dit"


def rms_norm(x, g):
    xf = x.astype(jnp.float32)
    y = xf * lax.rsqrt(jnp.mean(xf * xf, axis=-1, keepdims=True) + EPS)
    return (y * g.astype(jnp.float32)).astype(x.dtype)


def modulation(cond, w, b):
    m = jax.nn.silu(cond) @ w + b
    return jnp.split(m[..., None, :], MOD_CHUNKS, axis=-1)


def modulate(h, shift, scale):
    return h * (1 + scale) + shift


def axial_rope_tables(n_tok):
    rows = n_tok // GRID_W
    r = jnp.repeat(jnp.arange(rows, dtype=jnp.float32), GRID_W)
    col = jnp.tile(jnp.arange(GRID_W, dtype=jnp.float32), rows)
    inv = ROPE_BASE ** (-jnp.arange(0, AXIS_DIM, 2, dtype=jnp.float32) / AXIS_DIM)
    ang = jnp.stack([r[:, None] * inv, col[:, None] * inv], axis=1)
    return jnp.cos(ang), jnp.sin(ang)


def apply_axial_rope(x, cos, sin):
    b, s, h, _ = x.shape
    xr = x.reshape(b, s, h, 2, 2, AXIS_DIM // 2)
    x1, x2 = xr[..., 0, :], xr[..., 1, :]
    cs = cos[:, None].astype(x.dtype)
    sn = sin[:, None].astype(x.dtype)
    out = jnp.stack([x1 * cs - x2 * sn, x2 * cs + x1 * sn], axis=-2)
    return out.reshape(x.shape)


def heads(t, n):
    return t.reshape(t.shape[0], t.shape[1], n, HEAD_DIM)


def gmlp_spatial_gating(u, v, w_s, b_s):
    b, L, _ = u.shape
    nc = L // CHUNK
    u = jax.nn.gelu(u).reshape(b, nc, CHUNK, GMLP_GROUPS, GMLP_GROUP_W)
    vf = jax.nn.gelu(v).astype(jnp.float32).reshape(b, nc, CHUNK, GMLP_GROUPS, GMLP_GROUP_W)
    mu = jnp.mean(vf, axis=-1, keepdims=True)
    var = jnp.mean(jnp.square(vf - mu), axis=-1, keepdims=True)
    vn = ((vf - mu) * lax.rsqrt(var + 1e-5)).astype(u.dtype)
    f = jnp.einsum("gpq,bnqgc->bnpgc", w_s, vn) + b_s.T[:, :, None]
    return (u * f).reshape(b, L, D_GMLP)


def fourier_mix(f):
    b, L, _ = f.shape
    fg = f.astype(jnp.float32).reshape(b, L, FOURIER_GROUPS, FOURIER_GROUP_W)
    y = jnp.fft.fft2(fg, axes=(1, 3), norm="ortho").real
    return y.astype(f.dtype).reshape(b, L, D_FOURIER)


def even_mixer(h, w_in, w_s, b_s, w_out):
    u, v, f = jnp.split(h @ w_in, [D_GMLP, 2 * D_GMLP], axis=-1)
    mixed = jnp.concatenate([gmlp_spatial_gating(u, v, w_s, b_s), fourier_mix(f)], axis=-1)
    return mixed @ w_out


def short_conv(g_in, g_out, z_in, w):
    z = g_in * z_in
    L = z.shape[1]
    pad = CONV_WIDTH // 2
    zp = jnp.pad(z, ((0, 0), (pad, pad), (0, 0)))
    y = zp[:, 0:L] * w[0]
    for j in range(1, CONV_WIDTH):
        y = y + zp[:, j:j + L] * w[j]
    return g_out * y


def sink_softmax(parts, sink):
    m = sink
    for s in parts:
        m = jnp.maximum(m, jnp.max(s, axis=-1, keepdims=True))
    den = jnp.exp(sink - m)
    es = []
    for s in parts:
        e = jnp.exp(s - m)
        den = den + jnp.sum(e, axis=-1, keepdims=True)
        es.append(e)
    return [e / den for e in es]


def latent_window_attention(q, k, v, kc, vc, sink):
    b, s, _, dh = q.shape
    nb = s // ATT_BLOCK
    scale = dh ** -0.5
    qb = q.reshape(b, nb, ATT_BLOCK, N_KV_HEADS, Q_PER_KV, dh)

    def band(t):
        tb = t.reshape(b, nb, ATT_BLOCK, N_KV_HEADS, dh)
        tp = jnp.pad(tb, ((0, 0), (1, 1), (0, 0), (0, 0), (0, 0)))
        return jnp.concatenate([tp[:, :-2], tp[:, 1:-1], tp[:, 2:]], axis=2)

    kb, vb = band(k), band(v)
    s_band = jnp.einsum("bnqhgd,bnkhd->bnhgqk", qb, kb).astype(jnp.float32) * scale
    blk = jnp.arange(nb)[:, None, None]
    qpos = blk * ATT_BLOCK + jnp.arange(ATT_BLOCK)[None, :, None]
    kpos = (blk - 1) * ATT_BLOCK + jnp.arange(3 * ATT_BLOCK)[None, None, :]
    valid = (jnp.abs(kpos - qpos) <= WINDOW) & (kpos >= 0) & (kpos < s)
    s_band = jnp.where(valid[None, :, None, None], s_band, -jnp.inf)
    s_ctx = jnp.einsum("bnqhgd,bkhd->bnhgqk", qb, kc).astype(jnp.float32) * scale
    snk = sink.astype(jnp.float32).reshape(1, 1, N_KV_HEADS, Q_PER_KV, 1, 1)
    p_band, p_ctx = sink_softmax([s_band, s_ctx], snk)
    o = (jnp.einsum("bnhgqk,bnkhd->bnqhgd", p_band.astype(v.dtype), vb)
         + jnp.einsum("bnhgqk,bkhd->bnqhgd", p_ctx.astype(v.dtype), vc))
    return o.reshape(b, s, N_HEADS * dh)


def context_attention(qc, kc, vc, sink):
    b, lc, _, dh = qc.shape
    qg = qc.reshape(b, lc, N_KV_HEADS, Q_PER_KV, dh)
    sc = jnp.einsum("bqhgd,bkhd->bhgqk", qg, kc).astype(jnp.float32) * dh ** -0.5
    snk = sink.astype(jnp.float32).reshape(1, N_KV_HEADS, Q_PER_KV, 1, 1)
    (p,) = sink_softmax([sc], snk)
    o = jnp.einsum("bhgqk,bkhd->bqhgd", p.astype(vc.dtype), vc)
    return o.reshape(b, lc, N_HEADS * dh)


def odd_mixer(h, hc, w_in, q_g, k_g, sink, conv_w, w_out, cos, sin, ctx_out):
    q, k, v, g_in, g_out, z = jnp.split(h @ w_in, list(ODD_SPLITS), axis=-1)
    q = apply_axial_rope(rms_norm(heads(q, N_HEADS), q_g), cos, sin)
    k = apply_axial_rope(rms_norm(heads(k, N_KV_HEADS), k_g), cos, sin)
    v = heads(v, N_KV_HEADS)
    if ctx_out:
        qc, kc, vc, gc_in, gc_out, zc = jnp.split(hc @ w_in, list(ODD_SPLITS), axis=-1)
    else:
        kc, vc = jnp.split(hc @ w_in[:, Q_W:Q_W + 2 * KV_W], 2, axis=-1)
    kc = rms_norm(heads(kc, N_KV_HEADS), k_g)
    vc = heads(vc, N_KV_HEADS)
    y = jnp.concatenate([latent_window_attention(q, k, v, kc, vc, sink),
                         short_conv(g_in, g_out, z, conv_w)], axis=-1) @ w_out
    if not ctx_out:
        return y, None
    qc = rms_norm(heads(qc, N_HEADS), q_g)
    yc = jnp.concatenate([context_attention(qc, kc, vc, sink),
                          short_conv(gc_in, gc_out, zc, conv_w)], axis=-1) @ w_out
    return y, yc


def swiglu(x, w1, w3, w2):
    return (jax.nn.silu(x @ w1) * (x @ w3)) @ w2


def routed_experts(xf, idx, gates, w1, w3, w2):
    n, d = xf.shape
    nk = n * TOP_K
    flat_e = idx.reshape(-1)
    flat_g = gates.reshape(-1)
    flat_tok = jnp.arange(nk, dtype=jnp.int32) // TOP_K
    order = jnp.argsort(flat_e)
    sorted_e = flat_e[order]
    counts = jax.ops.segment_sum(jnp.ones((nk,), jnp.int32), flat_e, num_segments=N_EXPERTS)
    padded = (counts + EXPERT_BLOCK - 1) // EXPERT_BLOCK * EXPERT_BLOCK
    pend = jnp.cumsum(padded)
    pstart = pend - padded
    start = jnp.cumsum(counts) - counts
    dest = pstart[sorted_e] + jnp.arange(nk, dtype=jnp.int32) - start[sorted_e]
    n_blocks = (nk + N_EXPERTS * (EXPERT_BLOCK - 1) + EXPERT_BLOCK - 1) // EXPERT_BLOCK
    p_rows = n_blocks * EXPERT_BLOCK
    row_tok = jnp.full((p_rows,), n, jnp.int32).at[dest].set(flat_tok[order])
    row_gate = jnp.zeros((p_rows,), xf.dtype).at[dest].set(flat_g[order])
    block_start = jnp.arange(n_blocks, dtype=jnp.int32) * EXPERT_BLOCK
    block_e = jnp.minimum(jnp.searchsorted(pend, block_start, side="right"), N_EXPERTS - 1)
    x_pad = jnp.concatenate([xf, jnp.zeros((1, d), xf.dtype)], axis=0)

    def block_fn(args):
        tok, e, g = args
        xb = x_pad[tok]
        return swiglu(xb, w1[e], w3[e], w2[e]) * g[:, None]

    yb = lax.map(block_fn, (row_tok.reshape(n_blocks, EXPERT_BLOCK), block_e,
                            row_gate.reshape(n_blocks, EXPERT_BLOCK)))
    y = jax.ops.segment_sum(yb.reshape(p_rows, d), row_tok, num_segments=n + 1)
    return y[:n]


def moe(xf, router_w, router_b, w1, w3, w2, sw1, sw3, sw2):
    scores = jax.nn.sigmoid((xf @ router_w).astype(jnp.float32))
    _, idx = lax.top_k(scores + router_b.astype(jnp.float32), TOP_K)
    g = jnp.take_along_axis(scores, idx, axis=-1)
    g = g / (jnp.sum(g, axis=-1, keepdims=True) + 1e-20) * ROUTED_SCALE
    return routed_experts(xf, idx, g.astype(xf.dtype), w1, w3, w2) + swiglu(xf, sw1, sw3, sw2)


def setup_inputs(seed: int = 0) -> dict:
    key = jax.random.key(seed)
    k = jax.random.split(key, 26)
    d = D_MODEL

    def nrm(kk, shape, scale):
        return jax.random.normal(kk, shape, jnp.float32) * scale

    return {
        "x": nrm(k[0], (BATCH, SEQ, d), 1.0),
        "c": nrm(k[1], (BATCH, d), 1.0),
        "ctx": nrm(k[2], (BATCH, CTX_LEN, d), 1.0),
        "c_ctx": nrm(k[3], (d,), 1.0),
        "ada_w": nrm(k[4], (DEPTH, d, MOD_CHUNKS * d), 0.01),
        "ada_b": nrm(k[5], (DEPTH, MOD_CHUNKS * d), 0.02),
        "norm1_g": 1.0 + nrm(k[6], (DEPTH, d), 0.02),
        "norm2_g": 1.0 + nrm(k[7], (DEPTH, d), 0.02),
        "ev_w_in": nrm(k[8], (N_EVEN, d, EVEN_IN), d ** -0.5),
        "ev_w_s": nrm(k[9], (N_EVEN, GMLP_GROUPS, CHUNK, CHUNK), CHUNK ** -0.5),
        "ev_b_s": 1.0 + nrm(k[10], (N_EVEN, GMLP_GROUPS, CHUNK), 0.02),
        "ev_w_out": nrm(k[11], (N_EVEN, EVEN_MIX, d), EVEN_MIX ** -0.5),
        "od_w_in": nrm(k[12], (N_ODD, d, ODD_IN), d ** -0.5),
        "od_q_norm_g": 1.0 + nrm(k[13], (N_ODD, HEAD_DIM), 0.02),
        "od_k_norm_g": 1.0 + nrm(k[14], (N_ODD, HEAD_DIM), 0.02),
        "od_sink": nrm(k[15], (N_ODD, N_HEADS), 0.5),
        "od_conv_w": nrm(k[16], (N_ODD, CONV_WIDTH, D_CONV), CONV_WIDTH ** -0.5),
        "od_w_out": nrm(k[17], (N_ODD, ODD_MIX, d), ODD_MIX ** -0.5),
        "router_w": nrm(k[18], (DEPTH, d, N_EXPERTS), d ** -0.5),
        "router_b": nrm(k[19], (DEPTH, N_EXPERTS), 0.01),
        "exp_w_gate": nrm(k[20], (DEPTH, N_EXPERTS, d, D_EXPERT), d ** -0.5),
        "exp_w_up": nrm(k[21], (DEPTH, N_EXPERTS, d, D_EXPERT), d ** -0.5),
        "exp_w_down": nrm(k[22], (DEPTH, N_EXPERTS, D_EXPERT, d), D_EXPERT ** -0.5),
        "sh_w_gate": nrm(k[23], (DEPTH, d, D_SHARED), d ** -0.5),
        "sh_w_up": nrm(k[24], (DEPTH, d, D_SHARED), d ** -0.5),
        "sh_w_down": nrm(k[25], (DEPTH, D_SHARED, d), D_SHARED ** -0.5),
    }


def reference(x, c, ctx, c_ctx, ada_w, ada_b, norm1_g, norm2_g,
              ev_w_in, ev_w_s, ev_b_s, ev_w_out,
              od_w_in, od_q_norm_g, od_k_norm_g, od_sink, od_conv_w, od_w_out,
              router_w, router_b, exp_w_gate, exp_w_up, exp_w_down,
              sh_w_gate, sh_w_up, sh_w_down):
    b, s, d = x.shape
    lc = ctx.shape[1]
    cos, sin = axial_rope_tables(s)
    xc = ctx
    for l in range(DEPTH):
        last = l == DEPTH - 1
        even = l % 2 == 0
        need_ctx_mix = not (last and even)
        sh1, sc1, gt1, sh2, sc2, gt2 = modulation(c, ada_w[l], ada_b[l])
        h = modulate(rms_norm(x, norm1_g[l]), sh1, sc1)
        if need_ctx_mix:
            csh1, csc1, cgt1, csh2, csc2, cgt2 = modulation(c_ctx, ada_w[l], ada_b[l])
            hc = modulate(rms_norm(xc, norm1_g[l]), csh1, csc1)
        if even:
            e = l // 2
            y = even_mixer(h, ev_w_in[e], ev_w_s[e], ev_b_s[e], ev_w_out[e])
            yc = None if last else even_mixer(hc, ev_w_in[e], ev_w_s[e], ev_b_s[e], ev_w_out[e])
        else:
            o = l // 2
            y, yc = odd_mixer(h, hc, od_w_in[o], od_q_norm_g[o], od_k_norm_g[o], od_sink[o],
                              od_conv_w[o], od_w_out[o], cos, sin, not last)
        x = x + gt1 * y
        h2 = modulate(rms_norm(x, norm2_g[l]), sh2, sc2)
        moe_args = (router_w[l], router_b[l], exp_w_gate[l], exp_w_up[l], exp_w_down[l],
                    sh_w_gate[l], sh_w_up[l], sh_w_down[l])
        if last:
            x = x + gt2 * moe(h2.reshape(b * s, d), *moe_args).reshape(b, s, d)
        else:
            xc = xc + cgt1 * yc
            h2c = modulate(rms_norm(xc, norm2_g[l]), csh2, csc2)
            tokens = jnp.concatenate([h2.reshape(b * s, d), h2c.reshape(b * lc, d)], axis=0)
            out = moe(tokens, *moe_args)
            x = x + gt2 * out[:b * s].reshape(b, s, d)
            xc = xc + cgt2 * out[b * s:].reshape(b, lc, d)
    return x
```

```cpp
#include <hip/hip_runtime.h>
#include <cstdio>
#include <cstdint>
namespace pg8 {
#define PG8_LAS __attribute__((address_space(3)))
typedef unsigned short bf16_t;
typedef short bf16x8 __attribute__((ext_vector_type(8)));
typedef float f32x4 __attribute__((ext_vector_type(4)));
typedef float f32x2 __attribute__((ext_vector_type(2)));
typedef unsigned u32x4 __attribute__((ext_vector_type(4)));
typedef unsigned u32x2 __attribute__((ext_vector_type(2)));
constexpr int BM = 256, BK = 64, HALF = 128, HTB = HALF * BK * 2  , STAGE_BYTES = 8 * HTB, NXCD = 8, WGM = 8;

__host__ __device__ __forceinline__ int lds_byte(int r, int c) { const int st = (r >> 4) * 2 + (c >> 5), rr = r & 15, cc = c & 31, ob = rr * 64 + cc * 2; return st * 1024 + (ob ^ (((ob >> 9) & 1) << 5)); }
__host__ __device__ __forceinline__ void stage_rc(int b, int& R, int& C) { const int st = b / 1024, sb = b % 1024, swz = sb ^ (((sb >> 9) & 1) << 5); R = (st >> 1) * 16 + swz / 64; C = (st & 1) * 32 + (swz % 64) / 2; }
__host__ __device__ __forceinline__ int perm32(int rho) { const int n = rho >> 4, i = rho & 15; return 8 * (i >> 2) + 4 * n + (i & 3); }

struct Unit { const char* A; const char* B; int nt, ldb; int i0, i1, i2, i3; const char* B1; int mir; };

__device__ __forceinline__ void tile_order(int L, int nM, int nN, int& pm, int& pn) {
    const int nwg = nM * nN; int wgid = L; { const int q = nwg / NXCD, r = nwg % NXCD, xcd = wgid % NXCD, off = wgid / NXCD; wgid = (xcd < r ? xcd * (q + 1) : r * (q + 1) + (xcd - r) * q) + off; }
    const int nig = WGM * nN, gid = wgid / nig, fm = gid * WGM, gsz = (nM - fm) < WGM ? (nM - fm) : WGM;
    pm = fm + ((wgid % nig) % gsz); pn = (wgid % nig) / gsz;
}

typedef _Float16 h16x8 __attribute__((ext_vector_type(8)));
typedef _Float16 h16x2v __attribute__((ext_vector_type(2)));
__device__ __forceinline__ unsigned cvt_pk_bf16(float lo, float hi) { f32x2 v = {lo, hi}; return __builtin_bit_cast(unsigned, __builtin_convertvector(v, h16x2v)); }

__device__ __forceinline__ void pg8_dma16(const char* base, unsigned off, unsigned ldsaddr) {
    asm volatile("s_mov_b32 m0, %2\n\ts_nop 0\n\tglobal_load_lds_dwordx4 %0, %1" :: "v"(off), "s"(base), "s"(ldsaddr) : "memory", "m0"); }
__device__ __forceinline__ unsigned pg8_mirror_off(unsigned off, int ldb) { unsigned o = off; asm volatile("" : "+v"(o)); return 127u * (unsigned)(ldb * 2) + 2u * (o & 127u) - o; }
__device__ __forceinline__ unsigned pg8_umin(unsigned a, unsigned b) { return a < b ? a : b; }
__device__ __forceinline__ void pg8_dma4(const char* base, unsigned off, unsigned ldsaddr) {
    asm volatile("s_mov_b32 m0, %2\n\ts_nop 0\n\tglobal_load_lds_dword %0, %1" :: "v"(off), "s"(base), "s"(ldsaddr) : "memory", "m0"); }
typedef int i32x8 __attribute__((ext_vector_type(8)));
typedef int i32x4 __attribute__((ext_vector_type(4)));
__device__ __forceinline__ i32x8 pg8_cat(bf16x8 lo, bf16x8 hi) { const i32x4 a = __builtin_bit_cast(i32x4, lo), b = __builtin_bit_cast(i32x4, hi); return (i32x8){a[0], a[1], a[2], a[3], b[0], b[1], b[2], b[3]}; }
__device__ __forceinline__ void pg8_mma8(f32x4& c, i32x8 a, i32x8 b) { asm("v_mfma_f32_16x16x128_f8f6f4 %0, %1, %2, %0" : "+v"(c) : "v"(a), "v"(b)); }
template <int N> __device__ __forceinline__ void pg8_wait_vm() { asm volatile("s_waitcnt vmcnt(%0)" :: "n"(N) : "memory"); }
template <class Epi, class Sched>
__device__ __forceinline__ void gemm_phase(PG8_LAS unsigned char* lds, int wave  , const Sched& S, const Epi& E) {
    unsigned z_ = 0u; asm volatile("" : "+v"(z_)); int lane_ = (int)__builtin_amdgcn_mbcnt_hi(~0u, __builtin_amdgcn_mbcnt_lo(~0u, z_));
    const int wid = wave, lane = lane_, tid = wid * 64 + lane, wr = wid >> 2, wc = wid & 3, fr = lane & 15, fq = lane >> 4;
    int RR[2], CC[2], RB[2]; unsigned voffB[2]; unsigned voffB1 = 0u; long dB1 = 0;
#pragma unroll
    for (int i = 0; i < 2; ++i) { int R, C; stage_rc(tid * 16 + i * 8192, R, C); RR[i] = R; CC[i] = C; RB[i] = (R & ~31) + perm32(R & 31); }
    const size_t kstep = (size_t)(BK * 2);
    size_t hstepB;
    const unsigned ldsw = (unsigned)wid * 1024u;
    const int aoff = Sched::FP8 ? lds_byte(wr * 64 + fr, fq * 16) : lds_byte(wr * 64 + fr, fq * 8), boff = Sched::FP8 ? lds_byte(wc * 32 + fr, fq * 16) : lds_byte(wc * 32 + fr, fq * 8);
    constexpr int KSTR = Sched::FP8 ? 16 : 1024;
#define PG8_SA(b, h) (((b) * 2 + (h)) * HTB)
#define PG8_SB(b, h) ((4 + (b) * 2 + (h)) * HTB)
#define PG8_LDSA(x) ((unsigned)(unsigned long)(lds + (x)))
#define PG8_STAGEB(bufoff, gbase) do { _Pragma("unroll") for (int _i = 0; _i < 2; ++_i) \
        pg8_dma16((const char*)(gbase) + _i * (hstepB >> 1), voffB[0], PG8_LDSA((bufoff) + ldsw + _i * 8192)); } while (0)
#define PG8_STAGEB1(bufoff, gbase) do { _Pragma("unroll") for (int _i = 0; _i < 2; ++_i) \
        pg8_dma16((const char*)(gbase), voffB1 + (unsigned)(_i * (int)dB1), PG8_LDSA((bufoff) + ldsw + _i * 8192)); } while (0)
#define PG8_STAGEA(bufoff, gbase, o0, o1) do { \
        pg8_dma16((const char*)(gbase), (o0), PG8_LDSA((bufoff) + ldsw)); \
        if constexpr (Sched::DENSE_A) pg8_dma16((const char*)(gbase) + (hstepA >> 1), (o0), PG8_LDSA((bufoff) + ldsw + 8192)); \
        else pg8_dma16((const char*)(gbase), (o1), PG8_LDSA((bufoff) + ldsw + 8192)); } while (0)
#define PG8_LDA(dst, b, h) do { _Pragma("unroll") for (int m = 0; m < 4; ++m) _Pragma("unroll") for (int k = 0; k < 2; ++k) dst[m][k] = *(const PG8_LAS bf16x8*)(lds + PG8_SA(b, h) + aoff + m * 2048 + k * KSTR); } while (0)
#define PG8_LDB(dst, b, h) do { _Pragma("unroll") for (int n = 0; n < 2; ++n) _Pragma("unroll") for (int k = 0; k < 2; ++k) dst[n][k] = *(const PG8_LAS bf16x8*)(lds + PG8_SB(b, h) + boff + n * 2048 + k * KSTR); } while (0)
#define PG8_MMA(ai, bj, At, Bt) do { __builtin_amdgcn_s_setprio(1); \
        if constexpr (Sched::FP8) { _Pragma("unroll") for (int m = 0; m < 4; ++m) _Pragma("unroll") for (int n = 0; n < 2; ++n) \
            pg8_mma8(acc[ai][bj][m][n], pg8_cat(Bt[n][0], Bt[n][1]), pg8_cat(At[m][0], At[m][1])); } \
        else { _Pragma("unroll") for (int m = 0; m < 4; ++m) _Pragma("unroll") for (int n = 0; n < 2; ++n) _Pragma("unroll") for (int k = 0; k < 2; ++k) \
            acc[ai][bj][m][n] = __builtin_amdgcn_mfma_f32_16x16x32_f16(__builtin_bit_cast(h16x8, Bt[n][k]), __builtin_bit_cast(h16x8, At[m][k]), acc[ai][bj][m][n], 0, 0, 0); } \
        __builtin_amdgcn_s_setprio(0); } while (0)
#define PG8_GOFF(tab, h, i) ((unsigned)(pg8_umin((unsigned)((tab)[128 * (h) + 64 * (i) + RR[0]]) >> 3, Sched::NROWS - 1u) * Sched::ROWB + (unsigned)CC[0] * 2u))
#define AO(tab, h, i) ({ unsigned o_; if constexpr (Sched::DENSE_A) o_ = oC[0][i]; else o_ = PG8_GOFF(tab, h, i); o_; })
#define BH1(bufoff, p0, p1) do { if constexpr (Sched::SPLIT_B) PG8_STAGEB1(bufoff, p1); else PG8_STAGEB(bufoff, (p0) + hstepB); } while (0)
#define AH1(p) (Sched::DENSE_A ? (p) + hstepA : (p))
#define PG8_WAIT_V(n) asm volatile("s_waitcnt vmcnt(" #n ")" ::: "memory")
#define PG8_WAIT_L(n) asm volatile("s_waitcnt lgkmcnt(" #n ")" ::: "memory")
#define PG8_BAR __builtin_amdgcn_s_barrier()
#define PG8_SCHED __builtin_amdgcn_sched_barrier(0)
    constexpr int VMX = 8 + (Epi::VM_MIN > 55 ? 55 : Epi::VM_MIN);
    Unit cur, nxt; int ui = 0;
    if (!S.next(0, cur)) return;
    f32x4 acc[2][2][4][2];
#pragma unroll
    for (int a = 0; a < 2; ++a)
#pragma unroll
        for (int b = 0; b < 2; ++b)
#pragma unroll
            for (int m = 0; m < 4; ++m)
#pragma unroll
                for (int n = 0; n < 2; ++n) acc[a][b][m][n] = (f32x4){0.f, 0.f, 0.f, 0.f};
    bf16x8 At[4][2], B0[2][2], B1[2][2];
    unsigned oC[2][2] = {{0u, 0u}, {0u, 0u}};
    const PG8_LAS int* tabC = nullptr; const PG8_LAS int* tabN = nullptr;
    if constexpr (Sched::PREFETCH_A) { S.prefetch_rows(cur, wave); PG8_WAIT_V(0); PG8_BAR; }
    if constexpr (Sched::DENSE_A) S.aoff(cur, RR, CC, oC); else tabC = S.table(cur);
    const size_t hstepA = Sched::DENSE_A ? (size_t)(unsigned)__builtin_amdgcn_readfirstlane((int)(oC[1][0] - oC[0][0])) : 0;
    const char* cA = cur.A; const char* cB = cur.B;
    voffB[0] = (unsigned)(RB[0] * cur.ldb + CC[0]) * 2u; voffB[1] = (unsigned)(RB[1] * cur.ldb + CC[1]) * 2u; hstepB = (size_t)HALF * cur.ldb * 2;
    const char* cB1 = cB;
    if constexpr (Sched::SPLIT_B) { cB1 = cur.B1; voffB1 = cur.mir ? pg8_mirror_off(voffB[0], cur.ldb) : voffB[0]; dB1 = cur.mir ? -(long)(64 * cur.ldb * 2) : (long)(64 * cur.ldb * 2); }
    PG8_STAGEB(PG8_SB(0, 0), cB); BH1(PG8_SB(0, 1), cB, cB1); PG8_STAGEA(PG8_SA(0, 0), cA, AO(tabC, 0, 0), AO(tabC, 0, 1)); PG8_STAGEA(PG8_SA(0, 1), AH1(cA), AO(tabC, 1, 0), AO(tabC, 1, 1));
    if (wr == 1) PG8_BAR;
    PG8_WAIT_V(2); PG8_BAR;
    PG8_STAGEB(PG8_SB(1, 0), cB + kstep); PG8_STAGEA(PG8_SA(1, 0), cA + kstep, AO(tabC, 0, 0), AO(tabC, 0, 1)); BH1(PG8_SB(1, 1), cB + kstep, cB1 + kstep);
    PG8_WAIT_V(6); PG8_BAR;
    for (;;) {
        const bool has_next = S.next(ui + 1, nxt);
        const char* nA = has_next ? nxt.A : cA; const char* nB = has_next ? nxt.B : cB;
        const char* nB1 = cB1; if constexpr (Sched::SPLIT_B) nB1 = has_next ? nxt.B1 : cB1;
        const int ntm2 = __builtin_amdgcn_readfirstlane(cur.nt - 2);
        if constexpr (Sched::PREFETCH_A) { if (has_next) S.prefetch_rows(nxt, wave); }
        if constexpr (!Sched::DENSE_A) tabN = has_next ? S.table(nxt) : tabC;
        if constexpr (Epi::PREFETCH) E.prefetch(cur, wave);
        for (int t = 0; t <= ntm2; t += 2) {
            const bool last = (t == ntm2);
            const bool fresh = (t == 0) && (ui > 0);
            const char* a1 = cA + (size_t)(t + 1) * kstep;
            const char* a2 = last ? nA : cA + (size_t)(t + 2) * kstep; const char* b2 = last ? nB : cB + (size_t)(t + 2) * kstep;
            const char* a3 = a2 + kstep; const char* b3 = b2 + kstep;
            const char* b21 = b2; const char* b31 = b3; if constexpr (Sched::SPLIT_B) { b21 = last ? nB1 : cB1 + (size_t)(t + 2) * kstep; b31 = b21 + kstep; }
            const PG8_LAS int* tabX = last ? tabN : tabC;
            if constexpr (Sched::SPLIT_B) { if (last && has_next) { voffB1 = nxt.mir ? pg8_mirror_off(voffB[0], nxt.ldb) : voffB[0]; dB1 = nxt.mir ? -(long)(64 * nxt.ldb * 2) : (long)(64 * nxt.ldb * 2); } }
            if constexpr (!Sched::CONST_LDB) { if (last && has_next) { voffB[0] = (unsigned)(RB[0] * nxt.ldb + CC[0]) * 2u; voffB[1] = (unsigned)(RB[1] * nxt.ldb + CC[1]) * 2u; hstepB = (size_t)HALF * nxt.ldb * 2; } }
            PG8_LDB(B0, 0, 0); PG8_LDB(B1, 0, 1); PG8_SCHED; PG8_LDA(At, 0, 0); PG8_STAGEA(PG8_SA(1, 1), AH1(a1), AO(tabC, 1, 0), AO(tabC, 1, 1));
            if (VMX > 8 && fresh) pg8_wait_vm<VMX>(); else PG8_WAIT_V(8);
            PG8_WAIT_L(0); PG8_BAR; PG8_MMA(0, 0, At, B0); PG8_MMA(0, 1, At, B1); PG8_BAR; PG8_SCHED;
            PG8_LDA(At, 0, 1); PG8_STAGEB(PG8_SB(0, 0), b2); BH1(PG8_SB(0, 1), b2, b21); PG8_STAGEA(PG8_SA(0, 0), a2, AO(tabX, 0, 0), AO(tabX, 0, 1));
            if (VMX > 8 && fresh) pg8_wait_vm<VMX>(); else PG8_WAIT_V(8);
            PG8_WAIT_L(0); PG8_BAR; PG8_MMA(1, 0, At, B0); PG8_MMA(1, 1, At, B1); PG8_BAR; PG8_SCHED;
            PG8_LDB(B0, 1, 0); PG8_LDB(B1, 1, 1); PG8_SCHED; PG8_LDA(At, 1, 0); PG8_STAGEA(PG8_SA(0, 1), AH1(a2), AO(tabX, 1, 0), AO(tabX, 1, 1));
            PG8_WAIT_V(8); PG8_WAIT_L(0); PG8_BAR; PG8_MMA(0, 0, At, B0); PG8_MMA(0, 1, At, B1); PG8_BAR; PG8_SCHED;
            PG8_LDA(At, 1, 1); PG8_STAGEB(PG8_SB(1, 0), b3); BH1(PG8_SB(1, 1), b3, b31); PG8_STAGEA(PG8_SA(1, 0), a3, AO(tabX, 0, 0), AO(tabX, 0, 1));
            PG8_WAIT_V(8); PG8_WAIT_L(0); PG8_BAR; PG8_MMA(1, 0, At, B0); PG8_MMA(1, 1, At, B1); PG8_BAR; PG8_SCHED;
        }
        if (wr == 0) PG8_BAR;
        if constexpr (Sched::FP8) asm volatile("s_nop 7\n\ts_nop 7\n\ts_nop 7" ::: "memory");
        { unsigned z2_ = 0u; asm volatile("" : "+v"(z2_)); const int l2_ = (int)__builtin_amdgcn_mbcnt_hi(~0u, __builtin_amdgcn_mbcnt_lo(~0u, z2_)); int fr_e = l2_ & 15, fq_e = l2_ >> 4;
          E(acc, cur, wr, wc, fr_e, fq_e); }
        if (!has_next) break;
#pragma unroll
        for (int a = 0; a < 2; ++a)
#pragma unroll
            for (int b = 0; b < 2; ++b)
#pragma unroll
                for (int m = 0; m < 4; ++m)
#pragma unroll
                    for (int n = 0; n < 2; ++n) acc[a][b][m][n] = (f32x4){0.f, 0.f, 0.f, 0.f};
        cur = nxt; cA = nA; cB = nB; cB1 = nB1; ++ui;
        tabC = tabN;
        if (wr == 1) PG8_BAR;
    }
    PG8_WAIT_V(0);
    PG8_BAR;
#undef PG8_SA
#undef PG8_SB
#undef PG8_STAGEA
#undef PG8_STAGEB
#undef PG8_STAGEB1
#undef BH1
#undef PG8_LDA
#undef PG8_LDB
#undef PG8_MMA
#undef OX
#undef OCH
#undef AH1
#undef PG8_WAIT_V
#undef PG8_WAIT_L
#undef PG8_BAR
#undef PG8_SCHED
}
}
constexpr int NWAVES = 8;
constexpr int NX = 32768, NC = 2048, NT = NX + NC, DM = 1024, NBATCH = 8, SEQ = 4096, LCTX = 256, DEPTH = 4;
constexpr int MODW = 6 * DM;
constexpr int NEXP = 64, TOPK = 6, DEXP = 256;
constexpr int ECAP = NT;
constexpr int PMAX = NT * TOPK + NEXP * 256;
constexpr float EPS_RMS = 1e-6f;
constexpr float QSCALE = 0.125f * 1.4426950408889634f;
constexpr float LOG2E = 1.4426950408889634f;

constexpr size_t al256(size_t x) { return (x + 255) & ~(size_t)255; }
constexpr size_t WS_CTL = 0;
constexpr size_t WS_MOD = 1u << 20;
constexpr size_t CTL_ZERO_BYTES = 2u << 20;
constexpr size_t WS_ROPE = CTL_ZERO_BYTES;
constexpr size_t WS_EVUV = WS_ROPE + 8192;
constexpr size_t WS_EVF = WS_EVUV + (size_t)2 * 1024 * 1024 * 2;
constexpr size_t WS_EVOUT = WS_EVF + (size_t)2 * 1024 * 1024 * 2;
constexpr size_t WS_EVWS = WS_EVOUT + (size_t)2 * 1024 * 1024 * 2;
constexpr size_t WS_ODIN = WS_EVWS + (size_t)2 * 4 * 128 * 128 * 2;
constexpr size_t WS_ODOUT = WS_ODIN + (size_t)2 * 2304 * 1024 * 2;
constexpr size_t WS_RS = WS_ODOUT + (size_t)2 * 1024 * 1024 * 2;
constexpr size_t WS_SHDN = WS_RS + (size_t)4 * 768 * 1024 * 2;
constexpr size_t WS_DFT = WS_SHDN + (size_t)4 * 1024 * 256 * 2;
constexpr size_t WS_DFTC = WS_DFT + (size_t)4096 * 8192 * 2;
constexpr size_t WS_EGU = WS_DFTC + (size_t)256 * 512 * 2;
constexpr size_t WS_EDN = WS_EGU + (size_t)64 * 512 * 1024 * 2;
constexpr size_t WS_XH = WS_EDN + (size_t)64 * 1024 * 256 * 2;
constexpr size_t WS_H = WS_XH + (size_t)NT * DM * 2;
constexpr size_t WS_PROJ = WS_H + (size_t)NT * DM * 2;
constexpr size_t PJ_UV = 0;
constexpr size_t PJ_GT = PJ_UV + (size_t)NT * 1024 * 2;
constexpr size_t PJ_GTC = PJ_GT + (size_t)8 * 1024 * 4096 * 2;
constexpr size_t PJ_PQ = PJ_GTC + (size_t)8 * 1024 * 256 * 2;
constexpr size_t PJ_NY = PJ_PQ + (size_t)8 * 2 * 2048 * 512 * 2;
constexpr size_t PJ_EVEN_END = PJ_NY + (size_t)8 * 512 * 4;
constexpr size_t PJ_Q = 0;
constexpr size_t PJ_KV = PJ_Q + (size_t)NT * 512 * 2;
constexpr size_t PJ_VT = PJ_KV + (size_t)NT * 256 * 2;
constexpr size_t PJ_VTC = PJ_VT + (size_t)8 * 2 * 64 * 4096 * 2;
constexpr size_t PJ_GZ = PJ_VTC + (size_t)8 * 2 * 64 * 256 * 2;
constexpr size_t PJ_GO = PJ_GZ + (size_t)NT * 512 * 2;
constexpr size_t PJ_ODD_END = PJ_GO + (size_t)NT * 512 * 2;
constexpr size_t PJ_HMID_END = (size_t)PMAX * 256 * 2;
constexpr size_t cmax(size_t a, size_t b) { return a > b ? a : b; }
constexpr size_t PROJ_BYTES = al256(cmax(cmax(PJ_EVEN_END, PJ_ODD_END), PJ_HMID_END));
constexpr size_t WS_LOG = WS_PROJ + PROJ_BYTES;
constexpr size_t WS_HS = WS_LOG + (size_t)NT * 64 * 4;
constexpr size_t WS_RTOK = WS_HS + (size_t)NT * 256 * 2;
constexpr size_t WS_RGATE = WS_RTOK + (size_t)NEXP * ECAP * 4;
constexpr size_t WS_YS = WS_RGATE + (size_t)NEXP * ECAP * 4;
constexpr size_t WS_H8 = WS_YS + (size_t)NT * TOPK * DM;
constexpr size_t WS_MIX = WS_YS;
constexpr size_t WS_END = WS_YS + (size_t)NT * TOPK * DM * 2;
static_assert(WS_END < (size_t)1040 * 1000 * 1000, "workspace budget");

constexpr int CW_TMO = 0;
constexpr int CW_BAR = 4096;
constexpr int CW_CNT = 16384;
constexpr int CW_CVQ = 17408;

constexpr int RING_BYTES = 131072;
constexpr int MISC_OFF = 139264;
constexpr int LDS_BYTES = 147456;

#define GAS __attribute__((address_space(1)))
#define LAS __attribute__((address_space(3)))
typedef unsigned short bf16;
typedef unsigned v4u __attribute__((ext_vector_type(4)));
typedef unsigned v2u __attribute__((ext_vector_type(2)));
typedef float f32x4 __attribute__((ext_vector_type(4)));
typedef float f32x2 __attribute__((ext_vector_type(2)));
typedef float f32x16 __attribute__((ext_vector_type(16)));
typedef short bf16x8 __attribute__((ext_vector_type(8)));
typedef short s16x4 __attribute__((ext_vector_type(4)));
typedef GAS unsigned gu32;
#define RLX_AGENT __ATOMIC_RELAXED, __HIP_MEMORY_SCOPE_AGENT
#define LDS_WAIT() asm volatile("s_waitcnt lgkmcnt(0)" ::: "memory")
#define VM_WAIT() asm volatile("s_waitcnt vmcnt(0)" ::: "memory")
typedef _Float16 h16x2 __attribute__((ext_vector_type(2)));
__device__ __forceinline__ unsigned f2bf(float f) { return (unsigned)__builtin_bit_cast(unsigned short, (_Float16)f); }
__device__ __forceinline__ unsigned pk2(float lo, float hi) { f32x2 v = {lo, hi}; return __builtin_bit_cast(unsigned, __builtin_convertvector(v, h16x2)); }
__device__ __forceinline__ float bf2f(unsigned short b) { return (float)__builtin_bit_cast(_Float16, b); }
__device__ __forceinline__ float bflo(unsigned w) { return (float)__builtin_bit_cast(h16x2, w)[0]; }
__device__ __forceinline__ float bfhi(unsigned w) { return (float)__builtin_bit_cast(h16x2, w)[1]; }
constexpr float YS_SCALE = 8.0f, YS_INV = 1.0f / 8.0f;
constexpr float HM_SCALE = 16.0f, WD_SCALE = 64.0f, DN_INV = 1.0f / (16.0f * 64.0f);
__device__ __forceinline__ float clamp8(float v) { return __builtin_amdgcn_fmed3f(v, -440.0f, 440.0f); }
__device__ __forceinline__ unsigned fp8x4(const f32x4 a) { unsigned x = 0u; x = __builtin_amdgcn_cvt_pk_fp8_f32(clamp8(a[0]), clamp8(a[1]), x, false); x = __builtin_amdgcn_cvt_pk_fp8_f32(clamp8(a[2]), clamp8(a[3]), x, true); return x; }
constexpr float WUV_SCALE = 64.0f, WF_SCALE = 32.0f, UV_INV = 1.0f / (4.0f * 64.0f), FO_INV = 1.0f / (4.0f * 32.0f);
constexpr float MIX_SCALE = 4.0f, WO_SCALE = 64.0f, MO_INV = 1.0f / (4.0f * 64.0f);
constexpr float WI_SCALE = 64.0f, OD_INV = 1.0f / (4.0f * 64.0f);
constexpr float DFT_SCALE = 8192.0f, FO_SCALE = 4.0f, PQ_INV = 1.0f / (8192.0f * 4.0f);
constexpr float H8_SCALE = 4.0f, WG_SCALE = 64.0f, GU_INV = 1.0f / (4.0f * 64.0f);
__device__ __forceinline__ unsigned mix8x4(float a, float b, float c, float d) { return fp8x4((f32x4){a, b, c, d} * MIX_SCALE); }
__device__ __forceinline__ float fast_exp2(float x) { return __builtin_amdgcn_exp2f(x); }
__device__ __forceinline__ float fast_rcp(float x) { return __builtin_amdgcn_rcpf(x); }
__device__ __forceinline__ float silu_f(float x) { return x * fast_rcp(1.0f + fast_exp2(-LOG2E * x)); }
__device__ __forceinline__ float sigmoid_f(float x) { return fast_rcp(1.0f + fast_exp2(-LOG2E * x)); }
__device__ __forceinline__ float gelu_f(float x) { const float z = 0.7978845608028654f * (x + 0.044715f * x * x * x); return x * fast_rcp(1.0f + fast_exp2(-2.0f * LOG2E * z)); }
template <int M> __device__ __forceinline__ float swz_xor(float v) { return __builtin_bit_cast(float, __builtin_amdgcn_ds_swizzle(__builtin_bit_cast(int, v), (M << 10) | 0x1f)); }
__device__ __forceinline__ float x32_other(float v) { unsigned z = 0u; asm volatile("" : "+v"(z)); const int l = (int)__builtin_amdgcn_mbcnt_hi(~0u, __builtin_amdgcn_mbcnt_lo(~0u, z)); return __builtin_bit_cast(float, __builtin_amdgcn_ds_bpermute((l ^ 32) << 2, __builtin_bit_cast(int, v))); }
__device__ __forceinline__ float x32_sum(float v) { return v + x32_other(v); }
__device__ __forceinline__ float x32_max(float v) { return fmaxf(v, x32_other(v)); }
__device__ __forceinline__ float wave_sum(float v) { v += swz_xor<1>(v); v += swz_xor<2>(v); v += swz_xor<4>(v); v += swz_xor<8>(v); v += swz_xor<16>(v); return x32_sum(v); }

__device__ __forceinline__ int lane_id_now() { unsigned z = 0u; asm volatile("" : "+v"(z)); return (int)__builtin_amdgcn_mbcnt_hi(~0u, __builtin_amdgcn_mbcnt_lo(~0u, z)); }
#define XB_TMO      128
#define XB_XCNT(j)  (256  + 64 * (j))
#define XB_XSUB(j)  (1280 + 64 * (j))
#define XB_XGEN(j)  (2304 + 64 * (j))
#define XB_TOP      3328
#define XB_TOPGEN   3392
#define XCD_BAR_WORDS 3456
#define XB_SPIN_CAP (1u << 18)
__device__ __forceinline__ unsigned xb_ld(unsigned* p)              { return __hip_atomic_load(p, __ATOMIC_RELAXED, __HIP_MEMORY_SCOPE_AGENT); }
__device__ __forceinline__ unsigned xb_add(unsigned* p, unsigned v) { return __hip_atomic_fetch_add(p, v, __ATOMIC_RELAXED, __HIP_MEMORY_SCOPE_AGENT); }
__device__ __forceinline__ unsigned xb_xcc_id() { return (unsigned)__builtin_amdgcn_s_getreg((3 << 11) | 20) & 0xFu; }
#define XB_SPIN(cond, bar) do { unsigned _sp = 0; while (cond) { __builtin_amdgcn_s_sleep(1); \
    if ((++_sp & 255u) == 0u) { if (xb_ld(&(bar)[XB_TMO])) break; if (_sp > XB_SPIN_CAP) { atomicAdd(&(bar)[XB_TMO], 1u); break; } } } } while (0)
struct XcdBarrier { unsigned* bar; unsigned x; volatile LAS unsigned* st; int wave; };
__device__ __forceinline__ XcdBarrier xcd_barrier_post(unsigned* bar, volatile LAS unsigned* st) {
    XcdBarrier b; b.bar = bar; b.x = xb_xcc_id(); b.st = st; b.wave = __builtin_amdgcn_readfirstlane((int)threadIdx.x >> 6);
    if (threadIdx.x == 0) (void)xb_add(&bar[XB_XCNT(b.x)], 1u);
    return b;
}
__device__ __forceinline__ void xcd_barrier_complete(unsigned* bar, unsigned x, unsigned& nloc, unsigned& nx) {
    const unsigned G = gridDim.x * gridDim.y * gridDim.z;
    unsigned sum, cnt, mine, sp = 0u;
    for (;;) {
        sum = 0u; cnt = 0u; mine = 0u;
#pragma unroll
        for (unsigned j = 0; j < 16; ++j) { const unsigned c = xb_ld(&bar[XB_XCNT(j)]); sum += c; cnt += (c > 0u) ? 1u : 0u; mine = (j == x) ? c : mine; }
        if (sum == G) break;
        __builtin_amdgcn_s_sleep(1);
        if ((++sp & 255u) == 0u) { if (xb_ld(&bar[XB_TMO])) break; if (sp > XB_SPIN_CAP) { atomicAdd(&bar[XB_TMO], 1u); break; } }
    }
    nloc = mine > 0u ? mine : 1u; nx = cnt > 0u ? cnt : 1u;
}
__device__ __forceinline__ void xcd_barrier(const XcdBarrier& b) {
    asm volatile("s_waitcnt vmcnt(0)" ::: "memory");
    __syncthreads();
    if (b.wave == 0 && lane_id_now() == 0) {
        unsigned* bar = b.bar; unsigned bx_ = b.x; asm volatile("" : "+s"(bar), "+s"(bx_));
        __builtin_amdgcn_s_waitcnt(0);
        unsigned nloc = b.st[0], nx = b.st[1];
        if (nloc == 0u) { xcd_barrier_complete(bar, bx_, nloc, nx); b.st[0] = nloc; b.st[1] = nx; }
        const unsigned old = xb_add(&bar[XB_XSUB(bx_)], 1u);
        const unsigned gen = old / nloc;
        if (old + 1u == (gen + 1u) * nloc) {
            __builtin_amdgcn_fence(__ATOMIC_RELEASE, "agent");
            asm volatile("s_waitcnt vmcnt(0)" ::: "memory");
            const unsigned og = xb_add(&bar[XB_TOP], 1u);
            const unsigned tg = og / nx;
            if (og + 1u == (tg + 1u) * nx) xb_add(&bar[XB_TOPGEN], 1u);
            else XB_SPIN(xb_ld(&bar[XB_TOPGEN]) == tg, bar);
            __builtin_amdgcn_fence(__ATOMIC_ACQUIRE, "agent");
            xb_add(&bar[XB_XGEN(bx_)], 1u);
            asm volatile("s_waitcnt vmcnt(0)" ::: "memory");
        } else {
            XB_SPIN(xb_ld(&bar[XB_XGEN(bx_)]) == gen, bar);
            __builtin_amdgcn_fence(__ATOMIC_ACQUIRE, "agent");
            asm volatile("s_waitcnt vmcnt(0)" ::: "memory");
        }
    }
    __syncthreads();
}

struct Frame {
    LAS unsigned char* lds;
    volatile LAS unsigned* MISC;
    unsigned* ctl;
    int tid, lane, wave, G, bx;
    const float* const* in;
    float* out; unsigned char* ws;
};
enum { I_X = 0, I_C, I_CTX, I_CCTX, I_ADAW, I_ADAB, I_N1G, I_N2G, I_EVWIN, I_EVWS, I_EVBS, I_EVWOUT, I_ODWIN, I_ODQG, I_ODKG, I_ODSINK, I_ODCONV, I_ODWOUT,
       I_RW, I_RB, I_EG, I_EU, I_ED, I_SG, I_SU, I_SD };
template <class T> __device__ __forceinline__ T* wsp(const Frame& F, size_t off) { return (T*)(F.ws + off); }
__device__ __forceinline__ int cond_of(int r) { return r < NX ? (r >> 12) : 8; }
__device__ __forceinline__ const float* modp(const Frame& F, int l, int cond, int piece) { return wsp<const float>(F, WS_MOD) + ((size_t)(l * 9 + cond) * MODW + piece * DM); }

#define PHASE_FRAME(Fp, F0) Frame Fp = F0; { int l_ = lane_id_now(); asm volatile("" : "+v"(l_)); Fp.lane = l_; Fp.tid = F0.wave * 64 + l_; }
__device__ __forceinline__ void cvt_tile64(const float* srcp, size_t spitch, bf16* dst, size_t dpitch, int j0, int k0, LAS float* scr, int lane_) {
    int lane = lane_; asm volatile("" : "+v"(lane));
    const int kq = lane >> 4, c4 = lane & 15;
    const float* p = srcp ? srcp + (size_t)(k0 + kq) * spitch : nullptr;
    LAS float* w = scr + kq * 65 + 4 * c4;
#pragma unroll
    for (int it = 0; it < 16; ++it) { f32x4 v = (f32x4){0.f, 0.f, 0.f, 0.f}; if (p) { v = *(const GAS f32x4*)p; p += 4 * spitch; }
        w[0] = v.x; w[1] = v.y; w[2] = v.z; w[3] = v.w; w += 4 * 65; }
    LDS_WAIT(); asm volatile("" ::: "memory");
    const int c = lane & 7;
#pragma unroll
    for (int i = 0; i < 8; ++i) { const int r = (lane >> 3) + 8 * i; const LAS float* s = scr + (8 * c) * 65 + r;
        v4u o; o.x = pk2(s[0], s[65]); o.y = pk2(s[130], s[195]); o.z = pk2(s[260], s[325]); o.w = pk2(s[390], s[455]);
        *(GAS v4u*)(dst + (size_t)(j0 + r) * dpitch + k0 + 8 * c) = o; }
    LDS_WAIT(); asm volatile("" ::: "memory");
}
__device__ __forceinline__ void cvt_tile64_f8(const float* srcp, size_t spitch, unsigned char* dst8, size_t dpitch, int j0, int k0, LAS float* scr, int lane_, float scale) {
    int lane = lane_; asm volatile("" : "+v"(lane));
    const int kq = lane >> 4, c4 = lane & 15;
    const float* p = srcp + (size_t)(k0 + kq) * spitch;
    LAS float* w = scr + kq * 65 + 4 * c4;
#pragma unroll
    for (int it = 0; it < 16; ++it) { const f32x4 v = *(const GAS f32x4*)p; p += 4 * spitch; w[0] = v.x; w[1] = v.y; w[2] = v.z; w[3] = v.w; w += 4 * 65; }
    LDS_WAIT(); asm volatile("" ::: "memory");
    const int c = lane & 3;
#pragma unroll
    for (int i = 0; i < 4; ++i) { const int r = (lane >> 2) + 16 * i; const LAS float* s = scr + (16 * c) * 65 + r; v4u o;
#pragma unroll
        for (int q = 0; q < 4; ++q) { unsigned x = 0u;
            x = __builtin_amdgcn_cvt_pk_fp8_f32(fminf(fmaxf(s[(4 * q) * 65] * scale, -440.f), 440.f), fminf(fmaxf(s[(4 * q + 1) * 65] * scale, -440.f), 440.f), x, false);
            x = __builtin_amdgcn_cvt_pk_fp8_f32(fminf(fmaxf(s[(4 * q + 2) * 65] * scale, -440.f), 440.f), fminf(fmaxf(s[(4 * q + 3) * 65] * scale, -440.f), 440.f), x, true); o[q] = x; }
        *(GAS v4u*)(dst8 + (size_t)(j0 + r) * dpitch + k0 + 16 * c) = o; }
    LDS_WAIT(); asm volatile("" ::: "memory");
}
__device__ __forceinline__ int odin_col(int j) {
    const int U = j >> 8, cpos = j & 255, bj = cpos >> 7, wc = (cpos >> 5) & 3, fq = (cpos >> 3) & 3, n = (cpos >> 2) & 1, e = cpos & 3;
    const int d = 32 * n + 16 * bj + 4 * fq + e;
    if (U < 2) return (4 * U + wc) * 64 + d;
    if (U == 2) return wc < 2 ? 512 + wc * 64 + d : 640 + (wc - 2) * 64 + d;
    if (U < 7) { const int ch = 128 * (U - 3) + (cpos & 127); return bj ? 1792 + ch : 768 + ch; }
    return 1280 + 256 * (U - 7) + cpos;
}
constexpr int CV_EVUV = 2 * 16 * 16, CV_EVOUT = 2 * 16 * 16, CV_ODIN = 2 * 36 * 16, CV_ODOUT = 2 * 16 * 16, CV_RS = 4 * 12 * 16, CV_SHDN = 4 * 16 * 4;
constexpr int CV_TOTAL = CV_EVUV + CV_EVOUT + CV_ODIN + CV_ODOUT + CV_RS + CV_SHDN;
__device__ __forceinline__ void p0_convert_item(const Frame& F, int it, LAS float* scr) {
    const int lane = F.lane;
    if (it < CV_EVUV) { const int e = it / 256, r = it % 256, jb = r / 16, kb = r % 16;
        cvt_tile64_f8(F.in[I_EVWIN] + (size_t)e * 1024 * 1536 + jb * 64 + 4 * (lane & 15), 1536, wsp<unsigned char>(F, WS_EVUV) + (size_t)e * 1024 * 1024, 1024, jb * 64, kb * 64, scr, lane, 64.0f); return; }
    it -= CV_EVUV;
    if (it < CV_EVOUT) { const int e = it / 256, r = it % 256, jb = r / 16, kb = r % 16;
        cvt_tile64_f8(F.in[I_EVWOUT] + (size_t)e * 1024 * 1024 + jb * 64 + 4 * (lane & 15), 1024, wsp<unsigned char>(F, WS_EVOUT) + (size_t)e * 1024 * 1024, 1024, jb * 64, kb * 64, scr, lane, 64.0f); return; }
    it -= CV_EVOUT;
    if (it < CV_ODIN) { const int o = it / 576, r = it % 576, jb = r / 16, kb = r % 16;
        cvt_tile64_f8(F.in[I_ODWIN] + (size_t)o * 1024 * 2304 + odin_col(jb * 64 + 4 * (lane & 15)), 2304, wsp<unsigned char>(F, WS_ODIN) + (size_t)o * 2304 * 1024, 1024, jb * 64, kb * 64, scr, lane, 64.0f); return; }
    it -= CV_ODIN;
    if (it < CV_ODOUT) { const int o = it / 256, r = it % 256, jb = r / 16, kb = r % 16;
        cvt_tile64_f8(F.in[I_ODWOUT] + (size_t)o * 1024 * 1024 + jb * 64 + 4 * (lane & 15), 1024, wsp<unsigned char>(F, WS_ODOUT) + (size_t)o * 1024 * 1024, 1024, jb * 64, kb * 64, scr, lane, 64.0f); return; }
    it -= CV_ODOUT;
    if (it < CV_RS) { const int l = it / 192, r = it % 192, jb = r / 16, kb = r % 16; const int j = jb * 64 + 4 * (lane & 15), t = j >> 8, cpos = j & 255, bj = cpos >> 7, cc = cpos & 127;
        const float* sp;
        if (t < 2) sp = (bj ? F.in[I_SU] : F.in[I_SG]) + (size_t)l * 1024 * 256 + 128 * t + cc;
        else sp = (cpos < 64) ? F.in[I_RW] + (size_t)l * 1024 * 64 + cpos : nullptr;
        cvt_tile64(sp, t < 2 ? 256 : 64, wsp<bf16>(F, WS_RS) + (size_t)l * 768 * 1024, 1024, jb * 64, kb * 64, scr, lane); return; }
    it -= CV_RS;
    { const int l = it / 64, r = it % 64, jb = r / 4, kb = r % 4;
        cvt_tile64(F.in[I_SD] + (size_t)l * 256 * 1024 + jb * 64 + 4 * (lane & 15), 1024, wsp<bf16>(F, WS_SHDN) + (size_t)l * 1024 * 256, 256, jb * 64, kb * 64, scr, lane); }
}
constexpr int CVX_GU = 64 * 8 * 16, CVX_DN = 64 * 16 * 4, CVX_TOTAL = CVX_GU + CVX_DN;
__device__ __forceinline__ void expert_convert_item(const Frame& F, int l, int it, LAS float* scr) {
    const int lane = F.lane;
    if (it < CVX_GU) { const int e = it / 128, r = it % 128, jb = r / 16, kb = r % 16; const int j = jb * 64 + 4 * (lane & 15), t = j >> 8, bj = (j >> 7) & 1, cc = j & 127;
        const float* sp = (bj ? F.in[I_EU] : F.in[I_EG]) + ((size_t)(l * 64 + e) * 1024) * 256 + 128 * t + cc;
        cvt_tile64_f8(sp, 256, wsp<unsigned char>(F, WS_EGU) + (size_t)e * 512 * 1024, 1024, jb * 64, kb * 64, scr, lane, 64.0f); return; }
    it -= CVX_GU;
    { const int e = it / 64, r = it % 64, jb = r / 4, kb = r % 4;
        cvt_tile64_f8(F.in[I_ED] + ((size_t)(l * 64 + e) * 256) * 1024 + jb * 64 + 4 * (lane & 15), 1024, wsp<unsigned char>(F, WS_EDN) + (size_t)e * 1024 * 256, 256, jb * 64, kb * 64, scr, lane, 64.0f); }
}
__device__ __forceinline__ void expert_convert_steal(const Frame& F0, int l, int quota_chunks) {
    PHASE_FRAME(F, F0);
    LAS float* scr = (LAS float*)(F.lds + F.wave * 16640);
    unsigned* ctr = F.ctl + CW_CVQ + 64 * l;
    for (int q = 0; quota_chunks < 0 || q < quota_chunks; ++q) {
        unsigned it0 = 0; if (F.lane == 0) it0 = atomicAdd(ctr, 4u);
        it0 = (unsigned)__builtin_amdgcn_readfirstlane((int)it0);
        if (it0 >= (unsigned)CVX_TOTAL) break;
#pragma unroll 1
        for (int j = 0; j < 4; ++j) if (it0 + j < (unsigned)CVX_TOTAL) expert_convert_item(F, l, (int)(it0 + j), scr);
    }
}
__device__ __forceinline__ void p0_fold_item(const Frame& F, int it, LAS float* scr) {
    const int lane = F.lane, e = it / 256, g = (it / 64) & 3, kb = it & 63;
    LAS float* wt = scr;
    LAS float* tab = scr + 2048;
    const float* src = F.in[I_EVWIN] + (size_t)e * 1024 * 1536 + (size_t)(kb * 16) * 1536 + 1024 + 128 * g;
#pragma unroll
    for (int i = 0; i < 32; ++i) { const int idx = i * 64 + lane, kk = idx >> 7, c = idx & 127; wt[idx] = src[(size_t)kk * 1536 + c]; }
#pragma unroll
    for (int i = 0; i < 2; ++i) { const int a = i * 64 + lane; tab[a] = __builtin_amdgcn_cosf((float)a * (1.0f / 128.0f)); tab[128 + a] = __builtin_amdgcn_sinf((float)a * (1.0f / 128.0f)); }
    LDS_WAIT(); asm volatile("" ::: "memory");
    bf16* dst = wsp<bf16>(F, WS_EVF) + (size_t)e * 1024 * 1024;
#pragma unroll 1
    for (int i = 0; i < 4; ++i) {
        const int ml = lane + 64 * i, k2 = ml >> 1, cs = ml & 1;
        float acc[16];
#pragma unroll
        for (int kk = 0; kk < 16; ++kk) acc[kk] = 0.f;
#pragma unroll 2
        for (int c = 0; c < 128; c += 4) { const float t0 = tab[cs * 128 + ((c * k2) & 127)], t1 = tab[cs * 128 + (((c + 1) * k2) & 127)], t2 = tab[cs * 128 + (((c + 2) * k2) & 127)], t3 = tab[cs * 128 + (((c + 3) * k2) & 127)];
#pragma unroll
            for (int kk = 0; kk < 16; ++kk) { const f32x4 w4 = *(const LAS f32x4*)(wt + kk * 128 + c); acc[kk] += (t0 * w4.x + t1 * w4.y) + (t2 * w4.z + t3 * w4.w); } }
        v4u o;
#pragma unroll
        for (int q = 0; q < 4; ++q) o[q] = fp8x4((f32x4){acc[4 * q], acc[4 * q + 1], acc[4 * q + 2], acc[4 * q + 3]} * WF_SCALE);
        *(GAS v4u*)(wsp<unsigned char>(F, WS_EVF) + (size_t)e * 1024 * 1024 + (size_t)(g * 256 + ml) * 1024 + kb * 16) = o;
    }
    LDS_WAIT(); asm volatile("" ::: "memory");
}
__device__ __forceinline__ void p0_mod_item(const Frame& F, int it) {
    const int l = it >> 6, cg = it & 63, tid = F.tid;
    LAS float* s = (LAS float*)F.lds;
    LAS float* red = (LAS float*)F.lds + 9 * 1024;
#pragma unroll
    for (int j = 0; j < 18; ++j) { const int idx = tid + 512 * j, i = idx >> 10, k = idx & 1023; const float v = i < 8 ? F.in[I_C][i * 1024 + k] : F.in[I_CCTX][k]; s[idx] = silu_f(v); }
    __syncthreads();
    if (tid < 384) {
        const int kl = tid / 24, c4 = tid % 24;
        const float* w = F.in[I_ADAW] + (size_t)l * 1024 * MODW + (size_t)cg * 96 + c4 * 4;
        f32x4 acc[9];
#pragma unroll
        for (int i = 0; i < 9; ++i) acc[i] = (f32x4){0.f, 0.f, 0.f, 0.f};
#pragma unroll 16
        for (int st = 0; st < 64; ++st) { const int k = st * 16 + kl; const f32x4 wv = *(const GAS f32x4*)(w + (size_t)k * MODW);
#pragma unroll
            for (int i = 0; i < 9; ++i) acc[i] += wv * s[i * 1024 + k]; }
#pragma unroll
        for (int i = 0; i < 9; ++i) *(LAS f32x4*)(red + (kl * 9 + i) * 96 + c4 * 4) = acc[i];
    }
    __syncthreads();
    for (int idx = tid; idx < 9 * 96; idx += 512) { const int i = idx / 96, c = idx % 96; float v = F.in[I_ADAB][l * MODW + cg * 96 + c];
#pragma unroll
        for (int kl = 0; kl < 16; ++kl) v += red[(kl * 9 + i) * 96 + c];
        wsp<float>(F, WS_MOD)[(size_t)(l * 9 + i) * MODW + cg * 96 + c] = v; }
    __syncthreads();
}
__device__ __forceinline__ void p0_prologue(const Frame& F0) {
    PHASE_FRAME(F, F0);
    for (int it = F.bx; it < 256; it += F.G) p0_mod_item(F, it);
    LAS float* scr = (LAS float*)(F.lds + F.wave * 16640);
    const int gw = F.bx * NWAVES + F.wave, NGW = F.G * NWAVES;
    for (int it = gw; it < CV_TOTAL + 512; it += NGW) { if (it < CV_TOTAL) p0_convert_item(F, it, scr); else p0_fold_item(F, it - CV_TOTAL, scr); }
    { const float* src = F.in[I_EVWS]; bf16* dst = wsp<bf16>(F, WS_EVWS);
      for (int i = F.bx * 512 + F.tid; i < 2 * 4 * 128 * 128 / 4; i += F.G * 512) { const f32x4 v = *(const GAS f32x4*)(src + (size_t)i * 4); v2u o; o.x = pk2(v.x, v.y); o.y = pk2(v.z, v.w); *(GAS v2u*)(dst + (size_t)i * 4) = o; } }
    { unsigned char* dst = wsp<unsigned char>(F, WS_DFT);     const float alpha = 0.0013810679320049757f;
      for (int i = F.bx * 512 + F.tid; i < 2048 * 4096 / 8; i += F.G * 512) { const int k1 = i >> 9, c0 = (i & 511) * 8, cs = c0 >> 11, n0 = c0 & 2047; float v[8];
#pragma unroll
          for (int j = 0; j < 8; ++j) { const float rev = (float)((k1 * (n0 + j)) & 4095) * (1.0f / 4096.0f); v[j] = cs ? -alpha * __builtin_amdgcn_sinf(rev) : alpha * __builtin_amdgcn_cosf(rev); }
          v2u o; o.x = fp8x4((f32x4){v[0], v[1], v[2], v[3]} * DFT_SCALE); o.y = fp8x4((f32x4){v[4], v[5], v[6], v[7]} * DFT_SCALE); *(GAS v2u*)(dst + (size_t)i * 8) = o; } }
    { bf16* dst = wsp<bf16>(F, WS_DFTC); const float alpha = 0.005524271728019903f;
      for (int i = F.bx * 512 + F.tid; i < 256 * 512 / 8; i += F.G * 512) { const int k1 = i >> 6, c0 = (i & 63) * 8, cs = c0 >> 8, n0 = c0 & 255; float v[8];
#pragma unroll
          for (int j = 0; j < 8; ++j) { const float rev = (float)((k1 * (n0 + j)) & 255) * (1.0f / 256.0f); v[j] = cs ? -alpha * __builtin_amdgcn_sinf(rev) : alpha * __builtin_amdgcn_cosf(rev); }
          v4u o; o.x = pk2(v[0], v[1]); o.y = pk2(v[2], v[3]); o.z = pk2(v[4], v[5]); o.w = pk2(v[6], v[7]); *(GAS v4u*)(dst + (size_t)i * 8) = o; } }
    if (F.bx == 0) for (int i = F.tid; i < 1024; i += 512) { const int P = i >> 4, f = i & 15; const float inv = fast_exp2(-(float)f * (2.0f / 32.0f) * 13.287712379549449f);
        float rev = (float)P * inv * 0.15915494309189535f; rev -= floorf(rev);
        wsp<float>(F, WS_ROPE)[i] = __builtin_amdgcn_cosf(rev); wsp<float>(F, WS_ROPE)[1024 + i] = __builtin_amdgcn_sinf(rev); }
}
__device__ __forceinline__ void norm_phase(const Frame& F0, int l, int nrows, bool first, const float* g, int piece_shift, int piece_scale, bool w16, bool f8out) {
    PHASE_FRAME(F, F0);
    const int gw = F.bx * NWAVES + F.wave, NGW = F.G * NWAVES, lane = F.lane;
    bf16* H = wsp<bf16>(F, WS_H); const bf16* XH = wsp<const bf16>(F, WS_XH);
    const int per = (nrows + NGW - 1) / NGW, r0 = gw * per, r1 = (r0 + per < nrows) ? r0 + per : nrows;
    f32x4 MA[2][2], MB[2][2]; int pc = -1;
#pragma unroll
    for (int j = 0; j < 2; ++j)
#pragma unroll
        for (int q = 0; q < 2; ++q) { MA[j][q] = (f32x4){0.f, 0.f, 0.f, 0.f}; MB[j][q] = MA[j][q]; }
    v4u nw[2] = {(v4u){0u, 0u, 0u, 0u}, (v4u){0u, 0u, 0u, 0u}};
    if (!first && r0 < r1) { const bf16* xr = XH + (size_t)r0 * DM + 8 * lane; nw[0] = *(const GAS v4u*)xr; nw[1] = *(const GAS v4u*)(xr + 512); }
    for (int rv = r0; rv < r1; ++rv) {
        const int r = __builtin_amdgcn_readfirstlane(rv);
        f32x4 v[2][2]; float s = 0.f;
        if (first) { const float* xr = (r < NX ? F.in[I_X] + (size_t)r * DM : F.in[I_CTX] + (size_t)(r - NX) * DM) + 8 * lane;
#pragma unroll
            for (int j = 0; j < 2; ++j) { v[j][0] = *(const GAS f32x4*)(xr + 512 * j); v[j][1] = *(const GAS f32x4*)(xr + 512 * j + 4); } }
        else {
#pragma unroll
            for (int j = 0; j < 2; ++j) { const v4u w = nw[j]; v[j][0] = (f32x4){bflo(w.x), bfhi(w.x), bflo(w.y), bfhi(w.y)}; v[j][1] = (f32x4){bflo(w.z), bfhi(w.z), bflo(w.w), bfhi(w.w)}; }
            if (rv + 1 < r1) { const bf16* xn = XH + (size_t)(r + 1) * DM + 8 * lane; nw[0] = *(const GAS v4u*)xn; nw[1] = *(const GAS v4u*)(xn + 512); } }
#pragma unroll
        for (int j = 0; j < 2; ++j)
#pragma unroll
            for (int q = 0; q < 2; ++q) s += (v[j][q].x * v[j][q].x + v[j][q].y * v[j][q].y) + (v[j][q].z * v[j][q].z + v[j][q].w * v[j][q].w);
        const float rstd = 1.0f / sqrtf(wave_sum(s) * (1.0f / DM) + EPS_RMS);
        const int cond = cond_of(r);
        if (cond != pc) { pc = cond;
            const float* gp = g + 8 * lane; const float* sh = modp(F, l, cond, piece_shift) + 8 * lane; const float* sc = modp(F, l, cond, piece_scale) + 8 * lane;
#pragma unroll
            for (int j = 0; j < 2; ++j)
#pragma unroll
                for (int q = 0; q < 2; ++q) { const f32x4 gg = *(const GAS f32x4*)(gp + 512 * j + 4 * q), a = *(const GAS f32x4*)(sc + 512 * j + 4 * q); MB[j][q] = *(const GAS f32x4*)(sh + 512 * j + 4 * q); MA[j][q] = gg * (a + 1.0f); } }
        bf16* orow = H + (size_t)r * DM + 8 * lane;
#pragma unroll
        for (int j = 0; j < 2; ++j) { f32x4 y[2];
#pragma unroll
            for (int q = 0; q < 2; ++q) y[q] = v[j][q] * rstd * MA[j][q] + MB[j][q];
            v4u o; o.x = pk2(y[0].x, y[0].y); o.y = pk2(y[0].z, y[0].w); o.z = pk2(y[1].x, y[1].y); o.w = pk2(y[1].z, y[1].w); if (w16) *(GAS v4u*)(orow + 512 * j) = o;
            if (f8out) { v2u o8; o8.x = fp8x4(y[0] * H8_SCALE); o8.y = fp8x4(y[1] * H8_SCALE); *(GAS v2u*)(wsp<unsigned char>(F, WS_H8) + (size_t)r * DM + 8 * lane + 512 * j) = o8; } }
    }
}

__device__ __forceinline__ void topk_rows(const Frame& F0, int l, int r0) {
    PHASE_FRAME(F, F0);
    volatile LAS unsigned* hist = F.MISC + 64; volatile LAS unsigned* base = F.MISC + 128;
    const int tid = F.tid;
    if (tid < 64) hist[tid] = 0u;
    __syncthreads();
    int ex[TOPK]; float gt[TOPK]; unsigned lp[TOPK];
    if (tid < 256) {
        const float* lg = wsp<const float>(F, WS_LOG) + (size_t)(r0 + tid) * 64;
        const float* rb = F.in[I_RB] + l * 64;
        float sc[64], bs[64];
#pragma unroll
        for (int q = 0; q < 16; ++q) { const f32x4 v = *(const GAS f32x4*)(lg + 4 * q); const f32x4 b = *(const GAS f32x4*)(rb + 4 * q);
            sc[4 * q + 0] = sigmoid_f(v.x); sc[4 * q + 1] = sigmoid_f(v.y); sc[4 * q + 2] = sigmoid_f(v.z); sc[4 * q + 3] = sigmoid_f(v.w);
            bs[4 * q + 0] = sc[4 * q + 0] + b.x; bs[4 * q + 1] = sc[4 * q + 1] + b.y; bs[4 * q + 2] = sc[4 * q + 2] + b.z; bs[4 * q + 3] = sc[4 * q + 3] + b.w; }
        float gsum = 0.f;
#pragma unroll
        for (int k = 0; k < TOPK; ++k) {
            float best = -3.0e38f; int bi = 0; float bsc = 0.f;
#pragma unroll
            for (int e = 0; e < 64; ++e) { const bool tk = bs[e] > best; best = tk ? bs[e] : best; bi = tk ? e : bi; bsc = tk ? sc[e] : bsc; }
#pragma unroll
            for (int e = 0; e < 64; ++e) bs[e] = (e == bi) ? -3.0e38f : bs[e];
            ex[k] = bi; gt[k] = bsc; gsum += bsc;
        }
        const float inv = 2.5f / (gsum + 1e-20f);
#pragma unroll
        for (int k = 0; k < TOPK; ++k) { gt[k] *= inv; lp[k] = atomicAdd((unsigned*)(hist + ex[k]), 1u); }
    }
    __syncthreads();
    if (tid < 64) { const unsigned c = hist[tid]; base[tid] = c ? atomicAdd(F.ctl + CW_CNT + l * 64 + tid, c) : 0u; }
    __syncthreads();
    if (tid < 256) {
        int* rtok = wsp<int>(F, WS_RTOK); float* rgate = wsp<float>(F, WS_RGATE);
#pragma unroll
        for (int k = 0; k < TOPK; ++k) { const size_t p = (size_t)ex[k] * ECAP + base[ex[k]] + lp[k]; rtok[p] = (r0 + tid) * 8 + k; rgate[p] = gt[k]; }
    }
    __syncthreads();
}

__device__ __forceinline__ void conv_phase(const Frame& F0, int o, int nrows) {
    PHASE_FRAME(F, F0);
    const bf16* GZ = wsp<const bf16>(F, WS_PROJ + PJ_GZ); const bf16* GO = wsp<const bf16>(F, WS_PROJ + PJ_GO); bf16* MIX = wsp<bf16>(F, WS_MIX);
    const float* cw = F.in[I_ODCONV] + (size_t)o * 3 * 512;
    const int total = nrows * 64;
    for (int i = F.bx * 512 + F.tid; i < total; i += F.G * 512) {
        const int r = i >> 6, c0 = (i & 63) * 8;
        const int pos = r < NX ? (r & (SEQ - 1)) : ((r - NX) & (LCTX - 1)), L = r < NX ? SEQ : LCTX;
        const v4u z1 = *(const GAS v4u*)(GZ + (size_t)r * 512 + c0);
        v4u z0 = (v4u){0u, 0u, 0u, 0u}, z2 = (v4u){0u, 0u, 0u, 0u};
        if (pos > 0) z0 = *(const GAS v4u*)(GZ + (size_t)(r - 1) * 512 + c0);
        if (pos < L - 1) z2 = *(const GAS v4u*)(GZ + (size_t)(r + 1) * 512 + c0);
        const v4u go = *(const GAS v4u*)(GO + (size_t)r * 512 + c0);
        const f32x4 w0a = *(const GAS f32x4*)(cw + c0), w0b = *(const GAS f32x4*)(cw + c0 + 4);
        const f32x4 w1a = *(const GAS f32x4*)(cw + 512 + c0), w1b = *(const GAS f32x4*)(cw + 512 + c0 + 4);
        const f32x4 w2a = *(const GAS f32x4*)(cw + 1024 + c0), w2b = *(const GAS f32x4*)(cw + 1024 + c0 + 4);
        float y[8];
#pragma unroll
        for (int q = 0; q < 4; ++q) {
            const float wl0 = q < 2 ? w0a[2 * q] : w0b[2 * q - 4], wh0 = q < 2 ? w0a[2 * q + 1] : w0b[2 * q - 3];
            const float wl1 = q < 2 ? w1a[2 * q] : w1b[2 * q - 4], wh1 = q < 2 ? w1a[2 * q + 1] : w1b[2 * q - 3];
            const float wl2 = q < 2 ? w2a[2 * q] : w2b[2 * q - 4], wh2 = q < 2 ? w2a[2 * q + 1] : w2b[2 * q - 3];
            y[2 * q] = bflo(go[q]) * (wl0 * bflo(z0[q]) + wl1 * bflo(z1[q]) + wl2 * bflo(z2[q]));
            y[2 * q + 1] = bfhi(go[q]) * (wh0 * bfhi(z0[q]) + wh1 * bfhi(z1[q]) + wh2 * bfhi(z2[q]));
        }
        v2u ov; ov.x = mix8x4(y[0], y[1], y[2], y[3]); ov.y = mix8x4(y[4], y[5], y[6], y[7]);
        *(GAS v2u*)((unsigned char*)MIX + (size_t)r * DM + 512 + c0) = ov;
    }
}

__device__ __forceinline__ void gmlp_phase(const Frame& F0, int e, int nchunks) {
    PHASE_FRAME(F, F0);
    const bf16* UV = wsp<const bf16>(F, WS_PROJ + PJ_UV); bf16* MIX = wsp<bf16>(F, WS_MIX);
    const bf16* WSB = wsp<const bf16>(F, WS_EVWS) + (size_t)e * 4 * 128 * 128;
    const float* bsv = F.in[I_EVBS] + (size_t)e * 4 * 128;
    LAS bf16* VT = (LAS bf16*)F.lds;
    const int lane = F.lane, w = F.wave, fr = lane & 15, fq = lane >> 4;
    const bool bal = (F.G == 256 && nchunks * 4 == 1088);
    const int it0 = !bal ? F.bx : F.bx < 128 ? 5 * F.bx : F.bx < 240 ? 640 + 4 * (F.bx - 128) : 1088;
    const int itn = !bal ? nchunks * 4 : it0 + (F.bx < 128 ? 5 : F.bx < 240 ? 4 : 0), its = bal ? 1 : F.G;
    for (int it = it0; it < itn; it += its) {
        const int ch = it >> 2, g = it & 3, t0 = ch * 128;
        const int p = 16 * w + fr; const float bb = bsv[g * 128 + p]; v2u ug[8];
#pragma unroll
        for (int nt = 0; nt < 8; ++nt) ug[nt] = *(const GAS v2u*)(UV + (size_t)(t0 + p) * DM + 128 * g + 16 * nt + 4 * fq);
        { const int rs_ = lane >> 4, cl = lane & 15;
#pragma unroll
          for (int ps = 0; ps < 4; ++ps) { const int q = 16 * w + 4 * ps + rs_;
            const v4u pv = *(const GAS v4u*)(UV + (size_t)(t0 + q) * DM + 512 + 128 * g + 8 * cl);
            float x[8] = {bflo(pv.x), bfhi(pv.x), bflo(pv.y), bfhi(pv.y), bflo(pv.z), bfhi(pv.z), bflo(pv.w), bfhi(pv.w)};
            float s = ((x[0] + x[1]) + (x[2] + x[3])) + ((x[4] + x[5]) + (x[6] + x[7]));
            s += swz_xor<1>(s); s += swz_xor<2>(s); s += swz_xor<4>(s); s += swz_xor<8>(s);
            const float mu = s * (1.0f / 128.0f); float v2 = 0.f;
#pragma unroll
            for (int e = 0; e < 8; ++e) { x[e] -= mu; v2 += x[e] * x[e]; }
            v2 += swz_xor<1>(v2); v2 += swz_xor<2>(v2); v2 += swz_xor<4>(v2); v2 += swz_xor<8>(v2);
            const float rstd = 1.0f / sqrtf(v2 * (1.0f / 128.0f) + 1e-5f);
#pragma unroll
            for (int e = 0; e < 8; ++e) VT[(8 * cl + e) * 136 + q] = (bf16)f2bf(x[e] * rstd); } }
        __syncthreads();
        f32x4 acc[8];
#pragma unroll
        for (int nt = 0; nt < 8; ++nt) acc[nt] = (f32x4){0.f, 0.f, 0.f, 0.f};
        bf16x8 wf[4];
#pragma unroll
        for (int s = 0; s < 4; ++s) wf[s] = *(const GAS bf16x8*)(WSB + (size_t)(g * 128 + 16 * w + fr) * 128 + 32 * s + 8 * fq);
#pragma unroll
        for (int nt = 0; nt < 8; ++nt)
#pragma unroll
            for (int s = 0; s < 4; ++s) { const bf16x8 vf = *(const LAS bf16x8*)(VT + (16 * nt + fr) * 136 + 32 * s + 8 * fq);
                acc[nt] = __builtin_amdgcn_mfma_f32_16x16x32_f16(__builtin_bit_cast(pg8::h16x8, vf), __builtin_bit_cast(pg8::h16x8, wf[s]), acc[nt], 0, 0, 0); }
#pragma unroll
        for (int nt = 0; nt < 8; ++nt) { const size_t off = (size_t)(t0 + p) * DM + 128 * g + 16 * nt + 4 * fq; const v2u uu = ug[nt];
            *(GAS unsigned*)((unsigned char*)MIX + off) = mix8x4(bflo(uu.x) * (acc[nt][0] + bb), bfhi(uu.x) * (acc[nt][1] + bb), bflo(uu.y) * (acc[nt][2] + bb), bfhi(uu.y) * (acc[nt][3] + bb)); }
        __syncthreads();
    }
}
__device__ __forceinline__ void fourier_nyq_phase(const Frame& F0, int e) {
    PHASE_FRAME(F, F0);
    const unsigned char* WF = wsp<const unsigned char>(F, WS_EVF) + (size_t)e * 1024 * 1024; const unsigned char* H = wsp<const unsigned char>(F, WS_H8); float* NY = wsp<float>(F, WS_PROJ + PJ_NY);
    const int gw = F.bx * NWAVES + F.wave, NGW = F.G * NWAVES;
    for (int it = gw; it < 8 * 512; it += NGW) { const int b = it >> 9, n = it & 511;
        const v4u wv = *(const GAS v4u*)(WF + (size_t)(2 * n) * 1024 + 16 * F.lane), hv = *(const GAS v4u*)(H + (size_t)(b * SEQ + 2048) * DM + 16 * F.lane); float a = 0.f;
#pragma unroll
        for (int q = 0; q < 4; ++q) { const f32x2 w0 = __builtin_amdgcn_cvt_pk_f32_fp8((int)wv[q], false), w1 = __builtin_amdgcn_cvt_pk_f32_fp8((int)wv[q], true), h0 = __builtin_amdgcn_cvt_pk_f32_fp8((int)hv[q], false), h1 = __builtin_amdgcn_cvt_pk_f32_fp8((int)hv[q], true);
            a += (w0.x * h0.x + w0.y * h0.y) + (w1.x * h1.x + w1.y * h1.y); }
        a = wave_sum(a) * FO_INV;
        if (F.lane == 0) NY[it] = a; }
}
__device__ __forceinline__ void fourier_combine_phase(const Frame& F0) {
    PHASE_FRAME(F, F0);
    const bf16* PQ = wsp<const bf16>(F, WS_PROJ + PJ_PQ); bf16* MIX = wsp<bf16>(F, WS_MIX); const bf16* FO = wsp<const bf16>(F, WS_PROJ + PJ_GT); const float* NY = wsp<const float>(F, WS_PROJ + PJ_NY);
    const float alpha = 0.0013810679320049757f;
    const int NIT = 8 * 2048 * 64, STR = F.G * 512;
    for (int i0 = F.bx * 512 + F.tid; i0 < NIT; i0 += 4 * STR) {
        v4u pp[4], qq[4];
#pragma unroll
        for (int jj = 0; jj < 4; ++jj) { const int i = i0 + jj * STR; pp[jj] = (v4u){0u, 0u, 0u, 0u}; qq[jj] = pp[jj];
            if (i < NIT) { const int c8 = (i & 63) * 8, k1 = (i >> 6) & 2047, b = i >> 17;
                pp[jj] = *(const GAS v4u*)(PQ + ((size_t)(b * 2 + 0) * 2048 + k1) * 512 + c8); qq[jj] = *(const GAS v4u*)(PQ + ((size_t)(b * 2 + 1) * 2048 + k1) * 512 + c8); } }
        asm volatile("" ::: "memory");
#pragma unroll
        for (int jj = 0; jj < 4; ++jj) { const int i = i0 + jj * STR; if (i < NIT) { const int c8 = (i & 63) * 8, k1 = (i >> 6) & 2047, b = i >> 17; const v4u p = pp[jj], q = qq[jj];
        const float sg = (k1 & 1) ? -alpha : alpha; const f32x4 n0 = *(const GAS f32x4*)(NY + b * 512 + c8) * sg, n1 = *(const GAS f32x4*)(NY + b * 512 + c8 + 4) * sg;
        const float nyv[8] = {n0.x, n0.y, n0.z, n0.w, n1.x, n1.y, n1.z, n1.w};
        float sv[8], dv[8];
#pragma unroll
        for (int w = 0; w < 4; ++w) { const float pl = bflo(p[w]) + nyv[2 * w], ph = bfhi(p[w]) + nyv[2 * w + 1], ql = bflo(q[w]), qh = bfhi(q[w]); sv[2 * w] = pl + ql; sv[2 * w + 1] = ph + qh; dv[2 * w] = pl - ql; dv[2 * w + 1] = ph - qh; }
        v2u s, d; s.x = mix8x4(sv[0], sv[1], sv[2], sv[3]); s.y = mix8x4(sv[4], sv[5], sv[6], sv[7]); d.x = mix8x4(dv[0], dv[1], dv[2], dv[3]); d.y = mix8x4(dv[4], dv[5], dv[6], dv[7]);
        *(GAS v2u*)((unsigned char*)MIX + (size_t)(b * SEQ + k1) * DM + 512 + c8) = s;
        if (k1 > 0) *(GAS v2u*)((unsigned char*)MIX + (size_t)(b * SEQ + SEQ - k1) * DM + 512 + c8) = d; } }
    }
    const int gw = F.bx * NWAVES + F.wave, NGW = F.G * NWAVES;
    for (int it = gw; it < 8 * 512; it += NGW) { const int b = it >> 9, n = it & 511;
        const unsigned char* g = (const unsigned char*)FO + (size_t)(b * 512 + n) * 4096; float a = 0.f;
#pragma unroll
        for (int j = 0; j < 2; ++j) { const v4u v = *(const GAS v4u*)(g + (size_t)(j * 64 + F.lane) * 16);
#pragma unroll
            for (int w = 0; w < 4; ++w) { const f32x2 x0 = __builtin_amdgcn_cvt_pk_f32_fp8((int)v[w], false), x1 = __builtin_amdgcn_cvt_pk_f32_fp8((int)v[w], true); a += (x0.x - x0.y) + (x1.x - x1.y); } }
        a *= 1.0f / FO_SCALE;
        a = (wave_sum(a) + NY[it]) * alpha;
        if (F.lane == 0) ((unsigned char*)MIX)[(size_t)(b * SEQ + 2048) * DM + 512 + n] = (unsigned char)(mix8x4(a, 0.f, 0.f, 0.f) & 0xffu); }
}
__device__ __forceinline__ void attn_phase_frag(const Frame& F0, int o, bool ctx_queries) {
    PHASE_FRAME(F, F0);
    const bf16* Q = wsp<const bf16>(F, WS_PROJ + PJ_Q); const bf16* KB = wsp<const bf16>(F, WS_PROJ + PJ_KV);
    const bf16* VT = wsp<const bf16>(F, WS_PROJ + PJ_VT); const bf16* VTC = wsp<const bf16>(F, WS_PROJ + PJ_VTC);
    bf16* MIX = wsp<bf16>(F, WS_MIX);
    const int lane = F.lane, w = F.wave, r = lane & 31, hh = lane >> 5, g = w >> 1, half = w & 1;
    const int nunits = 512 + (ctx_queries ? 32 : 0);
    for (int u = F.bx; u < nunits; u += F.G) {
        int b, blk, hk, qrow0, qp0, nband, kt_lo;
        if (u < 512) { b = u >> 6; blk = (u >> 1) & 31; hk = u & 1; qp0 = blk * 128 + 64 * half; qrow0 = b * SEQ + qp0;
            kt_lo = qp0 >= 128 ? (qp0 - 128) >> 5 : 0; int kt_hi = ((qp0 + 191) >> 5) + 1; kt_hi = kt_hi > 128 ? 128 : kt_hi; nband = kt_hi - kt_lo; }
        else { const int v = u - 512; b = v >> 2; blk = (v >> 1) & 1; hk = v & 1; qp0 = 0; qrow0 = NX + b * LCTX + blk * 128 + 64 * half; nband = 0; kt_lo = 0; }
        const int h = hk * 4 + g;
        bf16x8 qf[2][4];
#pragma unroll
        for (int qg = 0; qg < 2; ++qg)
#pragma unroll
            for (int s = 0; s < 4; ++s) qf[qg][s] = *(const GAS bf16x8*)(Q + (size_t)(qrow0 + 32 * qg + r) * 512 + h * 64 + 16 * s + 8 * hh);
        const float sink2 = F.in[I_ODSINK][o * 8 + h] * LOG2E;
        float m[2] = {sink2, sink2}, lsum[2] = {hh == 0 ? 1.0f : 0.0f, hh == 0 ? 1.0f : 0.0f};
        f32x16 oacc[2][2];
#pragma unroll
        for (int qg = 0; qg < 2; ++qg)
#pragma unroll
            for (int dh = 0; dh < 2; ++dh)
#pragma unroll
                for (int i = 0; i < 16; ++i) oacc[qg][dh][i] = 0.f;
        const int ntiles = nband + 8;
#pragma unroll 1
        for (int ti = 0; ti < ntiles; ++ti) {
            const bool band = ti < nband;
            const int kpos0 = band ? (kt_lo + ti) * 32 : 0;
            const int krow = band ? b * SEQ + kpos0 : NX + b * LCTX + (ti - nband) * 32;
            const bf16* vbase = band ? VT + (size_t)((b * 2 + hk) * 64) * SEQ + kpos0 : VTC + (size_t)((b * 2 + hk) * 64) * LCTX + (ti - nband) * 32;
            const int vpitch = band ? SEQ : LCTX;
            f32x16 sacc[2];
#pragma unroll
            for (int qg = 0; qg < 2; ++qg)
#pragma unroll
                for (int i = 0; i < 16; ++i) sacc[qg][i] = 0.f;
#pragma unroll
            for (int s = 0; s < 4; ++s) { const bf16x8 kf = *(const GAS bf16x8*)(KB + (size_t)(krow + r) * 128 + hk * 64 + 16 * s + 8 * hh);
                sacc[0] = __builtin_amdgcn_mfma_f32_32x32x16_f16(__builtin_bit_cast(pg8::h16x8, kf), __builtin_bit_cast(pg8::h16x8, qf[0][s]), sacc[0], 0, 0, 0);
                sacc[1] = __builtin_amdgcn_mfma_f32_32x32x16_f16(__builtin_bit_cast(pg8::h16x8, kf), __builtin_bit_cast(pg8::h16x8, qf[1][s]), sacc[1], 0, 0, 0); }
            bf16x8 vf[2][2];
#pragma unroll
            for (int dh = 0; dh < 2; ++dh)
#pragma unroll
                for (int s2 = 0; s2 < 2; ++s2) { const bf16* vp = vbase + (size_t)(32 * dh + r) * vpitch + 16 * s2 + 4 * hh;
                    const s16x4 lo = *(const GAS s16x4*)vp, hi = *(const GAS s16x4*)(vp + 8);
                    vf[dh][s2] = (bf16x8){lo[0], lo[1], lo[2], lo[3], hi[0], hi[1], hi[2], hi[3]}; }
#pragma unroll
            for (int qg = 0; qg < 2; ++qg) {
                if (band && (kpos0 < qp0 - 65 || kpos0 > qp0 + 97)) { const int qpos = qp0 + 32 * qg + r;
#pragma unroll
                    for (int i = 0; i < 16; ++i) { const int kpos = kpos0 + (i & 3) + 8 * (i >> 2) + 4 * hh; const int dlt = kpos - qpos; sacc[qg][i] = (dlt > 128 || dlt < -128) ? -1.0e30f : sacc[qg][i]; } }
                float tm = sacc[qg][0];
#pragma unroll
                for (int i = 1; i < 16; ++i) tm = fmaxf(tm, sacc[qg][i]);
                tm = x32_max(tm);
                const float mn = fmaxf(m[qg], tm), alpha = fast_exp2(m[qg] - mn); const bool same = __all(mn == m[qg]); m[qg] = mn;
                float ps = 0.f; float p[16];
#pragma unroll
                for (int i = 0; i < 16; ++i) { p[i] = fast_exp2(sacc[qg][i] - mn); ps += p[i]; }
                lsum[qg] = lsum[qg] * alpha + ps;
                if (!same) {
#pragma unroll
                for (int dh = 0; dh < 2; ++dh)
#pragma unroll
                    for (int i = 0; i < 16; ++i) oacc[qg][dh][i] *= alpha; }
#pragma unroll
                for (int s2 = 0; s2 < 2; ++s2) {
                    unsigned pw[4];
#pragma unroll
                    for (int j = 0; j < 4; ++j) pw[j] = pk2(p[8 * s2 + 2 * j], p[8 * s2 + 2 * j + 1]);
                    const v4u pv4 = (v4u){pw[0], pw[1], pw[2], pw[3]}; const bf16x8 pf = __builtin_bit_cast(bf16x8, pv4);
                    oacc[qg][0] = __builtin_amdgcn_mfma_f32_32x32x16_f16(__builtin_bit_cast(pg8::h16x8, vf[0][s2]), __builtin_bit_cast(pg8::h16x8, pf), oacc[qg][0], 0, 0, 0);
                    oacc[qg][1] = __builtin_amdgcn_mfma_f32_32x32x16_f16(__builtin_bit_cast(pg8::h16x8, vf[1][s2]), __builtin_bit_cast(pg8::h16x8, pf), oacc[qg][1], 0, 0, 0);
                }
            }
        }
#pragma unroll
        for (int qg = 0; qg < 2; ++qg) {
            const float lt = x32_sum(lsum[qg]), inv = 1.0f / lt;
            bf16* orow = MIX + (size_t)(qrow0 + 32 * qg + r) * DM + h * 64;
#pragma unroll
            for (int dh = 0; dh < 2; ++dh)
#pragma unroll
                for (int t = 0; t < 4; ++t) { v2u ov; ov.x = pk2(oacc[qg][dh][4 * t] * inv, oacc[qg][dh][4 * t + 1] * inv); ov.y = pk2(oacc[qg][dh][4 * t + 2] * inv, oacc[qg][dh][4 * t + 3] * inv);
                    *(GAS v2u*)(orow + 32 * dh + 8 * t + 4 * hh) = ov; }
        }
    }
}
__device__ __forceinline__ float wave_max(float v) { v = fmaxf(v, swz_xor<1>(v)); v = fmaxf(v, swz_xor<2>(v)); v = fmaxf(v, swz_xor<4>(v)); v = fmaxf(v, swz_xor<8>(v)); v = fmaxf(v, swz_xor<16>(v)); return x32_max(v); }
__device__ __forceinline__ void attn_phase_naive(const Frame& F0, int o, bool ctx_queries) {
    PHASE_FRAME(F, F0);
    const bf16* Q = wsp<const bf16>(F, WS_PROJ + PJ_Q); const bf16* KB = wsp<const bf16>(F, WS_PROJ + PJ_KV);
    const bf16* VT = wsp<const bf16>(F, WS_PROJ + PJ_VT); const bf16* VTC = wsp<const bf16>(F, WS_PROJ + PJ_VTC);
    bf16* MIX = wsp<bf16>(F, WS_MIX);
    const int lane = F.lane;
    LAS float* pbuf = (LAS float*)F.lds + F.wave * 1024;
    LAS float* qbuf = pbuf + 768;
    const int gw = F.bx * NWAVES + F.wave, NGW = F.G * NWAVES;
    const int nq = (NX + (ctx_queries ? NC : 0)) * 8;
    for (int itv = gw; itv < nq; itv += NGW) {
        const int it = __builtin_amdgcn_readfirstlane(itv);
        const int row = it >> 3, h = it & 7, hk = h >> 2; const bool isx = row < NX;
        const int b = isx ? (row >> 12) : ((row - NX) >> 8), pos = row & 4095;
        int k0 = 0, nb = 0;
        if (isx) { k0 = pos >= 128 ? pos - 128 : 0; const int k1 = pos + 128 > 4095 ? 4095 : pos + 128; nb = k1 - k0 + 1; }
        const int total = nb + 256;
        qbuf[lane] = bf2f(Q[(size_t)row * 512 + h * 64 + lane]);
        LDS_WAIT(); asm volatile("" ::: "memory");
        const float sink2 = F.in[I_ODSINK][o * 8 + h] * LOG2E;
        float mx = sink2;
        for (int j = lane; j < total; j += 64) { const int krow = j < nb ? b * SEQ + k0 + j : NX + b * LCTX + (j - nb);
            const bf16* kp = KB + (size_t)krow * 128 + hk * 64; float s = 0.f;
#pragma unroll 8
            for (int d = 0; d < 64; ++d) s += qbuf[d] * bf2f(kp[d]);
            pbuf[j] = s; mx = fmaxf(mx, s); }
        mx = wave_max(mx);
        float ps = 0.f;
        for (int j = lane; j < total; j += 64) { const float p = fast_exp2(pbuf[j] - mx); pbuf[j] = p; ps += p; }
        const float den = wave_sum(ps) + fast_exp2(sink2 - mx);
        LDS_WAIT(); asm volatile("" ::: "memory");
        float ov = 0.f;
        const bf16* vb = VT + (size_t)((b * 2 + hk) * 64 + lane) * SEQ + k0; const bf16* vc = VTC + (size_t)((b * 2 + hk) * 64 + lane) * LCTX;
        for (int j = 0; j < nb; ++j) ov += pbuf[j] * bf2f(vb[j]);
        for (int j = 0; j < 256; ++j) ov += pbuf[nb + j] * bf2f(vc[j]);
        MIX[(size_t)row * DM + h * 64 + lane] = (bf16)f2bf(ov / den);
        LDS_WAIT(); asm volatile("" ::: "memory");
    }
}

__device__ __forceinline__ void attn_phase(const Frame& F0, int o, bool ctx_queries) {
    PHASE_FRAME(F, F0);
    const bf16* Q = wsp<const bf16>(F, WS_PROJ + PJ_Q); const bf16* KB = wsp<const bf16>(F, WS_PROJ + PJ_KV);
    const bf16* VT = wsp<const bf16>(F, WS_PROJ + PJ_VT); const bf16* VTC = wsp<const bf16>(F, WS_PROJ + PJ_VTC);
    bf16* MIX = wsp<bf16>(F, WS_MIX);
    const int lane = F.lane, w = F.wave, tid = F.tid, r = lane & 31, hh = lane >> 5, g = w >> 1, half = w & 1;
    const int nunits = 512 + (ctx_queries ? 32 : 0);
    float gq_ = fabsf(F.in[I_ODQG][o * 64 + lane]), gk_ = fabsf(F.in[I_ODKG][o * 64 + lane]);
    gq_ = fmaxf(gq_, swz_xor<1>(gq_)); gq_ = fmaxf(gq_, swz_xor<2>(gq_)); gq_ = fmaxf(gq_, swz_xor<4>(gq_)); gq_ = fmaxf(gq_, swz_xor<8>(gq_)); gq_ = fmaxf(gq_, swz_xor<16>(gq_)); gq_ = x32_max(gq_);
    gk_ = fmaxf(gk_, swz_xor<1>(gk_)); gk_ = fmaxf(gk_, swz_xor<2>(gk_)); gk_ = fmaxf(gk_, swz_xor<4>(gk_)); gk_ = fmaxf(gk_, swz_xor<8>(gk_)); gk_ = fmaxf(gk_, swz_xor<16>(gk_)); gk_ = x32_max(gk_);
    const float M0 = fmaxf(0.0f, 8.0f * LOG2E * gq_ * gk_ - 14.0f);
    const bool ldk = tid < 256; const int lt = ldk ? tid : tid - 256;
    for (int u = F.bx; u < nunits; u += F.G) {
        int b, blk, hk, qrow0, qp0, nband, kt_lo;
        if (u < 512) { b = u >> 6; blk = (u >> 1) & 31; hk = u & 1; qp0 = blk * 128 + 64 * half; qrow0 = b * SEQ + qp0;
            kt_lo = blk >= 1 ? blk * 4 - 4 : 0; int kt_hi = blk * 4 + 8; kt_hi = kt_hi > 128 ? 128 : kt_hi; nband = kt_hi - kt_lo; }
        else { const int v = u - 512; b = v >> 2; blk = (v >> 1) & 1; hk = v & 1; qp0 = 0; qrow0 = NX + b * LCTX + blk * 128 + 64 * half; nband = 0; kt_lo = 0; }
        const int h = hk * 4 + g;
        bf16x8 qf[2][4];
#pragma unroll
        for (int qg = 0; qg < 2; ++qg)
#pragma unroll
            for (int s = 0; s < 4; ++s) qf[qg][s] = *(const GAS bf16x8*)(Q + (size_t)(qrow0 + 32 * qg + r) * 512 + h * 64 + 16 * s + 8 * hh);
        const float sink2 = F.in[I_ODSINK][o * 8 + h] * LOG2E;
        const float sk_ = hh == 0 ? fast_exp2(sink2 - M0) : 0.0f; float lsum[2] = {sk_, sk_};
        f32x16 oacc[2][2];
#pragma unroll
        for (int qg = 0; qg < 2; ++qg)
#pragma unroll
            for (int dh = 0; dh < 2; ++dh)
#pragma unroll
                for (int i = 0; i < 16; ++i) oacc[qg][dh][i] = 0.f;
        const int ntiles = nband + 8;
#define ATT_SRC(ti_) ((ti_) < nband ? (ldk ? KB + (size_t)(b * SEQ + (kt_lo + (ti_)) * 32 + (lt >> 3)) * 128 + hk * 64 + 8 * (lt & 7) \
                                            : VT + (size_t)((b * 2 + hk) * 64 + (lt >> 2)) * SEQ + (kt_lo + (ti_)) * 32 + 8 * (lt & 3)) \
                                    : (ldk ? KB + (size_t)(NX + b * LCTX + ((ti_) - nband) * 32 + (lt >> 3)) * 128 + hk * 64 + 8 * (lt & 7) \
                                            : VTC + (size_t)((b * 2 + hk) * 64 + (lt >> 2)) * LCTX + ((ti_) - nband) * 32 + 8 * (lt & 3)))
        const int ldst = ldk ? (lt >> 3) * 144 + (lt & 7) * 16 : 4608 + (lt >> 2) * 80 + (lt & 3) * 16;
        __syncthreads();
        { const v4u pc = *(const GAS v4u*)ATT_SRC(0); *(LAS v4u*)(F.lds + ldst) = pc; }
        v4u nx = (v4u){0u, 0u, 0u, 0u}; if (ntiles > 1) nx = *(const GAS v4u*)ATT_SRC(1);
        __syncthreads();
#pragma unroll 1
        for (int ti = 0; ti < ntiles; ++ti) {
            const bool band = ti < nband;
            const int kpos0 = band ? (kt_lo + ti) * 32 : 0;
            v4u nx2 = (v4u){0u, 0u, 0u, 0u}; const bool more = ti + 1 < ntiles;
            if (ti + 2 < ntiles) nx2 = *(const GAS v4u*)ATT_SRC(ti + 2);
            const LAS unsigned char* set = F.lds + (ti & 1) * 10240;
            const bool mine = !band || (kpos0 + 31 >= qp0 - 128 && kpos0 <= qp0 + 191);
            if (mine) {
                f32x16 sacc[2];
#pragma unroll
                for (int qg = 0; qg < 2; ++qg)
#pragma unroll
                    for (int i = 0; i < 16; ++i) sacc[qg][i] = -M0;
#pragma unroll
                for (int s = 0; s < 4; ++s) { const bf16x8 kf = *(const LAS bf16x8*)(set + r * 144 + (16 * s + 8 * hh) * 2);
                    sacc[0] = __builtin_amdgcn_mfma_f32_32x32x16_f16(__builtin_bit_cast(pg8::h16x8, kf), __builtin_bit_cast(pg8::h16x8, qf[0][s]), sacc[0], 0, 0, 0);
                    sacc[1] = __builtin_amdgcn_mfma_f32_32x32x16_f16(__builtin_bit_cast(pg8::h16x8, kf), __builtin_bit_cast(pg8::h16x8, qf[1][s]), sacc[1], 0, 0, 0); }
                bf16x8 vf[2][2];
#pragma unroll
                for (int dh = 0; dh < 2; ++dh)
#pragma unroll
                    for (int s2 = 0; s2 < 2; ++s2) { const LAS unsigned char* vp = set + 4608 + (32 * dh + r) * 80 + (16 * s2 + 4 * hh) * 2;
                        const s16x4 lo = *(const LAS s16x4*)vp, hi = *(const LAS s16x4*)(vp + 16);
                        vf[dh][s2] = (bf16x8){lo[0], lo[1], lo[2], lo[3], hi[0], hi[1], hi[2], hi[3]}; }
#pragma unroll
                for (int qg = 0; qg < 2; ++qg) {
                    if (band && (kpos0 < qp0 - 65 || kpos0 > qp0 + 97)) { const int qpos = qp0 + 32 * qg + r;
#pragma unroll
                        for (int i = 0; i < 16; ++i) { const int kpos = kpos0 + (i & 3) + 8 * (i >> 2) + 4 * hh; const int dlt = kpos - qpos; sacc[qg][i] = (dlt > 128 || dlt < -128) ? -1.0e30f : sacc[qg][i]; } }
                    float ps = 0.f; float p[16];
#pragma unroll
                    for (int i = 0; i < 16; ++i) { p[i] = fast_exp2(sacc[qg][i]); ps += p[i]; }
                    lsum[qg] += ps;
#pragma unroll
                    for (int s2 = 0; s2 < 2; ++s2) {
                        unsigned pw[4];
#pragma unroll
                        for (int j = 0; j < 4; ++j) pw[j] = pk2(p[8 * s2 + 2 * j], p[8 * s2 + 2 * j + 1]);
                        const v4u pv4 = (v4u){pw[0], pw[1], pw[2], pw[3]}; const bf16x8 pf = __builtin_bit_cast(bf16x8, pv4);
                        oacc[qg][0] = __builtin_amdgcn_mfma_f32_32x32x16_f16(__builtin_bit_cast(pg8::h16x8, vf[0][s2]), __builtin_bit_cast(pg8::h16x8, pf), oacc[qg][0], 0, 0, 0);
                        oacc[qg][1] = __builtin_amdgcn_mfma_f32_32x32x16_f16(__builtin_bit_cast(pg8::h16x8, vf[1][s2]), __builtin_bit_cast(pg8::h16x8, pf), oacc[qg][1], 0, 0, 0);
                    }
                }
            }
            if (more) *(LAS v4u*)(F.lds + ((ti + 1) & 1) * 10240 + ldst) = nx;
            __syncthreads();
            nx = nx2;
        }
#undef ATT_SRC
#pragma unroll
        for (int qg = 0; qg < 2; ++qg) {
            const float lt2 = x32_sum(lsum[qg]), inv = 1.0f / lt2;
            unsigned char* orow = (unsigned char*)MIX + (size_t)(qrow0 + 32 * qg + r) * DM + h * 64;
#pragma unroll
            for (int dh = 0; dh < 2; ++dh)
#pragma unroll
                for (int t = 0; t < 4; ++t) *(GAS unsigned*)(orow + 32 * dh + 8 * t + 4 * hh) = mix8x4(oacc[qg][dh][4 * t] * inv, oacc[qg][dh][4 * t + 1] * inv, oacc[qg][dh][4 * t + 2] * inv, oacc[qg][dh][4 * t + 3] * inv);
        }
    }
}
using pg8::Unit;
typedef pg8::f32x4 (AccT)[2][2][4][2];
#define ROWL(ai, m) (128 * (ai) + 64 * wr + 16 * (m) + fr)
#define COL8(bj) (128 * (bj) + 32 * wc + 8 * fq)
__device__ __forceinline__ v4u pack8(const f32x4 a, const f32x4 b) { v4u w; w.x = pg8::cvt_pk_bf16(a[0], a[1]); w.y = pg8::cvt_pk_bf16(a[2], a[3]); w.z = pg8::cvt_pk_bf16(b[0], b[1]); w.w = pg8::cvt_pk_bf16(b[2], b[3]); return w; }
__device__ __forceinline__ void dense_aoff(int lda, const int (&R)[2], const int (&C)[2], unsigned (&off)[2][2]) {
#pragma unroll
    for (int h = 0; h < 2; ++h)
#pragma unroll
        for (int i = 0; i < 2; ++i) off[h][i] = (unsigned)((128 * h + R[i]) * lda + C[i]) * 2u;
}
__device__ __forceinline__ unsigned swz16u(unsigned v) { return (unsigned)__builtin_amdgcn_ds_swizzle((int)v, (16 << 10) | 0x1f); }
template <bool F8> struct SchedDenseT {
    static constexpr bool PREFETCH_A = false, FP8 = F8;
    static constexpr bool SPLIT_B = false, DENSE_A = true, CONST_LDB = true;
    const char* A; const char* B; int nM, nN, lda, ldbv, nt, G, c;
    __device__ __forceinline__ bool next(int i, Unit& u) const { const int L = i * G + c; if (L >= nM * nN) return false; int pm, pn; pg8::tile_order(L, nM, nN, pm, pn);
        u.A = A + (size_t)pm * 256 * lda * 2; u.B = B + (size_t)pn * 256 * ldbv * 2; u.nt = nt; u.ldb = ldbv; u.i0 = pm; u.i1 = pn; u.i2 = 0; u.i3 = 0; return true; }
    __device__ __forceinline__ void aoff(const Unit&, const int (&R)[2], const int (&C)[2], unsigned (&off)[2][2]) const { dense_aoff(lda, R, C, off); }
};
using SchedDense = SchedDenseT<false>;
struct SchedE1 {
    static constexpr bool PREFETCH_A = false, FP8 = true;
    static constexpr bool SPLIT_B = true, DENSE_A = true, CONST_LDB = true;
    const char* H; const char* WUV; const char* WF; int nMt  , G, c;
    __device__ __forceinline__ bool next(int i, Unit& u) const { int L = i * G + c; const int n0 = nMt * 4; if (L >= n0 + 512 + 32) return false; int pm, pn; u.nt = 8; u.ldb = 512; u.i3 = 0; u.mir = 0;
        if (L < n0) { pg8::tile_order(L, nMt, 4, pm, pn); u.A = H + (size_t)pm * 256 * 1024; u.B = WUV + (size_t)pn * 256 * 1024; u.B1 = u.B + (size_t)128 * 1024; u.i2 = 0; }
        else if (L < n0 + 512) { pg8::tile_order(L - n0, 4, 128, pm, pn); const int b = pn >> 4, j0 = (pn & 15) * 128;
            u.A = WF + (size_t)pm * 256 * 1024; u.B = H + (size_t)(b * SEQ + j0) * 1024; u.B1 = H + (size_t)(b * SEQ + SEQ - j0 - 127) * 1024; u.mir = 1; u.i2 = 2; }
        else { const int v = L - n0 - 512; pm = v & 3; pn = 128 + (v >> 2); u.A = WF + (size_t)pm * 256 * 1024; u.B = H + (size_t)pn * 256 * 1024; u.B1 = u.B + (size_t)128 * 1024; u.i2 = 1; }
        u.i0 = pm; u.i1 = pn; return true; }
    __device__ __forceinline__ void aoff(const Unit&, const int (&R)[2], const int (&C)[2], unsigned (&off)[2][2]) const { dense_aoff(512, R, C, off); }
};
struct EpiE1 {
    static constexpr int VM_MIN = 0; static constexpr bool PREFETCH = false;
    bf16* UV; bf16* FO; bf16* GTC;
    __device__ __forceinline__ void operator()(const AccT& acc, const Unit& u, int wr, int wc, int fr, int fq) const {
        if (u.i2 == 0) {
#pragma unroll
            for (int ai = 0; ai < 2; ++ai)
#pragma unroll
                for (int m = 0; m < 4; ++m) { bf16* rowp = UV + (size_t)(u.i0 * 256 + ROWL(ai, m)) * DM + u.i1 * 256;
#pragma unroll
                    for (int bj = 0; bj < 2; ++bj) { f32x4 a = acc[ai][bj][m][0], b = acc[ai][bj][m][1];
#pragma unroll
                        for (int j = 0; j < 4; ++j) { a[j] = gelu_f(a[j] * UV_INV); b[j] = gelu_f(b[j] * UV_INV); }
                        *(GAS v4u*)(rowp + COL8(bj)) = pack8(a, b); } }
        } else if (u.i2 == 2) {
            const int b = u.i1 >> 4, j0 = (u.i1 & 15) * 128, c = 32 * wc + 8 * fq;
            const bool cs = (fr & 1) != 0;
#pragma unroll
            for (int ai = 0; ai < 2; ++ai)
#pragma unroll
                for (int m = 0; m < 4; ++m) { const int mp = u.i0 * 256 + ROWL(ai, m);
                    f32x4 a = acc[ai][0][m][0], bq = acc[ai][0][m][1]; const f32x4 ma = acc[ai][1][m][0], mb = acc[ai][1][m][1];
                    if (cs) { a -= ma; bq -= mb; } else { a += ma; bq += mb; }
                    if (j0 + c == 0) a[0] = cs ? 0.f : acc[ai][0][m][0][0];
                    a *= FO_INV * FO_SCALE; bq *= FO_INV * FO_SCALE;
                    { v2u o8; o8.x = fp8x4(a); o8.y = fp8x4(bq); *(GAS v2u*)((unsigned char*)FO + ((size_t)(b * 512 + (mp >> 1)) * 4096 + (cs ? 2048 : 0) + j0 + c)) = o8; } }
        } else {
            bf16* base = GTC + (size_t)(u.i1 - 128) * 1024 * LCTX;
#pragma unroll
            for (int ai = 0; ai < 2; ++ai)
#pragma unroll
                for (int m = 0; m < 4; ++m) { bf16* rowp = base + (size_t)(u.i0 * 256 + ROWL(ai, m)) * LCTX;
#pragma unroll
                    for (int bj = 0; bj < 2; ++bj) *(GAS v4u*)(rowp + COL8(bj)) = pack8(acc[ai][bj][m][0] * FO_INV, acc[ai][bj][m][1] * FO_INV); }
        }
    }
};
template <bool CTX> struct SchedFourier {
    static constexpr bool PREFETCH_A = false, FP8 = !CTX;
    static constexpr bool SPLIT_B = false, DENSE_A = true, CONST_LDB = true;
    const char* DFT; const char* GT; int G, c;
    __device__ __forceinline__ bool next(int i, Unit& u) const { const int L = i * G + c; u.i3 = 0;
        if (!CTX) { if (L >= 256) return false; const int b = L & 7, j = L >> 3, pq = j & 1, pn = (j >> 1) & 1, pm = j >> 2;
            u.A = DFT + ((size_t)pm * 256 * 4096 + (size_t)pq * 2048); u.B = GT + (((size_t)b * 512 + (size_t)pn * 256) * 4096 + (size_t)pq * 2048); u.nt = 16; u.ldb = 2048;
            u.i0 = (b * 2 + pq) * 2048 + pm * 256; u.i1 = pn; u.i2 = 1; return true; }
        else { if (L >= 16) return false; const int b = L >> 1, pn = L & 1; u.A = DFT; u.B = GT + ((size_t)b * 1024 * LCTX + (size_t)pn * 256 * 512) * 2; u.nt = 8; u.ldb = 512; u.i0 = NX + b * LCTX; u.i1 = pn; u.i2 = 0; return true; } }
    __device__ __forceinline__ void aoff(const Unit&, const int (&R)[2], const int (&C)[2], unsigned (&off)[2][2]) const { dense_aoff(CTX ? 512 : 2048, R, C, off); }
};
template <bool CTX> struct EpiFourier {
    static constexpr int VM_MIN = 0; static constexpr bool PREFETCH = false;
    bf16* MIX; bf16* PQ;
    __device__ __forceinline__ void operator()(const AccT& acc, const Unit& u, int wr, int wc, int fr, int fq) const {
        if constexpr (!CTX) { bf16* base = PQ + (size_t)u.i0 * 512 + u.i1 * 256;
#pragma unroll
            for (int ai = 0; ai < 2; ++ai)
#pragma unroll
                for (int m = 0; m < 4; ++m) { bf16* rowp = base + (size_t)ROWL(ai, m) * 512;
#pragma unroll
                    for (int bj = 0; bj < 2; ++bj) *(GAS v4u*)(rowp + COL8(bj)) = pack8(acc[ai][bj][m][0] * PQ_INV, acc[ai][bj][m][1] * PQ_INV); }
        } else { unsigned char* base = (unsigned char*)MIX + (size_t)u.i0 * DM + 512 + u.i1 * 256;
#pragma unroll
            for (int ai = 0; ai < 2; ++ai)
#pragma unroll
                for (int m = 0; m < 4; ++m) { unsigned char* rowp = base + (size_t)ROWL(ai, m) * DM;
#pragma unroll
                    for (int bj = 0; bj < 2; ++bj) { v2u o; o.x = fp8x4(acc[ai][bj][m][0] * MIX_SCALE); o.y = fp8x4(acc[ai][bj][m][1] * MIX_SCALE); *(GAS v2u*)(rowp + COL8(bj)) = o; } }
        }
    }
};
template <bool MOE> struct EpiResid {
    static constexpr int VM_MIN = 0; static constexpr bool PREFETCH = !MOE;
    const float* srcf_x; const float* srcf_c;
    float* dstf;
    bf16* XH;
    const float* mod;
    const bf16* YS;
    unsigned pfl;
    __device__ __forceinline__ void prefetch(const Unit& u, int wave) const {
        if (pfl != 0u && srcf_x == nullptr) { const char* base = (const char*)(XH + (size_t)u.i0 * 256 * DM + u.i1 * 256); const int t = wave * 64 + lane_id_now();
#pragma unroll
            for (int j = 0; j < 2; ++j) { const int li = t + 512 * j; pg8::pg8_dma4(base, (unsigned)((li >> 2) * (DM * 2) + (li & 3) * 128), pfl + (unsigned)wave * 256u); } }
    }
    __device__ __forceinline__ void operator()(const AccT& acc, const Unit& u, int wr, int wc, int fr, int fq) const {
        const int row0 = u.i0 * 256; const bool isx = row0 < NX;
        const int cond = isx ? (row0 >> 12) : 8;
        const float* gatep = mod + (size_t)cond * MODW + u.i1 * 256;
        const float* sfb = srcf_x ? (isx ? srcf_x + (size_t)row0 * DM : srcf_c + (size_t)(row0 - NX) * DM) + u.i1 * 256 : nullptr;
        bf16* xhb = XH + (size_t)row0 * DM + u.i1 * 256;
        float* dfb = dstf ? dstf + (size_t)row0 * DM + u.i1 * 256 : nullptr;
        if constexpr (!MOE) {
        f32x4 gv[2][2];
#pragma unroll
        for (int bj = 0; bj < 2; ++bj)
#pragma unroll
            for (int n = 0; n < 2; ++n) gv[bj][n] = *(const GAS f32x4*)(gatep + COL8(bj) + 4 * n) * MO_INV;
#pragma unroll
        for (int ai = 0; ai < 2; ++ai) {
            f32x4 xo[4][2][2];
#pragma unroll
            for (int m = 0; m < 4; ++m)
#pragma unroll
                for (int bj = 0; bj < 2; ++bj) { const size_t o = (size_t)ROWL(ai, m) * DM + COL8(bj);
                    if (sfb) { xo[m][bj][0] = *(const GAS f32x4*)(sfb + o); xo[m][bj][1] = *(const GAS f32x4*)(sfb + o + 4); }
                    else { const v4u w = *(const GAS v4u*)(xhb + o); xo[m][bj][0] = (f32x4){bflo(w.x), bfhi(w.x), bflo(w.y), bfhi(w.y)}; xo[m][bj][1] = (f32x4){bflo(w.z), bfhi(w.z), bflo(w.w), bfhi(w.w)}; } }
#pragma unroll
            for (int m = 0; m < 4; ++m)
#pragma unroll
                for (int bj = 0; bj < 2; ++bj) { const size_t o = (size_t)ROWL(ai, m) * DM + COL8(bj);
                    const f32x4 r0 = xo[m][bj][0] + gv[bj][0] * acc[ai][bj][m][0], r1 = xo[m][bj][1] + gv[bj][1] * acc[ai][bj][m][1];
                    if (dfb) { *(GAS f32x4*)(dfb + o) = r0; *(GAS f32x4*)(dfb + o + 4) = r1; } else *(GAS v4u*)(xhb + o) = pack8(r0, r1); }
            asm volatile("" ::: "memory"); }
        } else {
#pragma unroll
        for (int ai = 0; ai < 2; ++ai)
#pragma unroll
            for (int m = 0; m < 4; ++m) { const int rl = ROWL(ai, m);
                {
                  const unsigned char* yp = (const unsigned char*)YS + (size_t)(row0 + rl) * (TOPK * DM) + u.i1 * 256 + 64 * wc + 16 * fq;
                  float sm[16];
#pragma unroll
                  for (int q = 0; q < 16; ++q) sm[q] = 0.f;
#pragma unroll
                  for (int k = 0; k < TOPK; ++k) { const v4u y = *(const GAS v4u*)(yp + (size_t)k * DM);
#pragma unroll
                      for (int w = 0; w < 4; ++w) { const f32x2 p0 = __builtin_amdgcn_cvt_pk_f32_fp8((int)y[w], false), p1 = __builtin_amdgcn_cvt_pk_f32_fp8((int)y[w], true);
                          sm[4 * w] += p0.x; sm[4 * w + 1] += p0.y; sm[4 * w + 2] += p1.x; sm[4 * w + 3] += p1.y; } }
                  f32x4 r[2][2];
#pragma unroll
                  for (int q = 0; q < 4; ++q) { r[0][0][q] = sm[q]; r[0][1][q] = sm[4 + q]; r[1][0][q] = sm[8 + q]; r[1][1][q] = sm[12 + q]; }
#pragma unroll
                  for (int bj = 0; bj < 2; ++bj) { const size_t o = (size_t)rl * DM + COL8(bj);
                    const f32x4 a = acc[ai][bj][m][0] + r[bj][0] * YS_INV, b = acc[ai][bj][m][1] + r[bj][1] * YS_INV;
                    const v4u w = *(const GAS v4u*)(xhb + o); const f32x4 g0 = *(const GAS f32x4*)(gatep + COL8(bj)), g1 = *(const GAS f32x4*)(gatep + COL8(bj) + 4);
                    const f32x4 r0 = (f32x4){bflo(w.x), bfhi(w.x), bflo(w.y), bfhi(w.y)} + g0 * a, r1 = (f32x4){bflo(w.z), bfhi(w.z), bflo(w.w), bfhi(w.w)} + g1 * b;
                    if (dfb) { *(GAS f32x4*)(dfb + o) = r0; *(GAS f32x4*)(dfb + o + 4) = r1; } else *(GAS v4u*)(xhb + o) = pack8(r0, r1); } }
                asm volatile("" ::: "memory"); }
        }
    }
};
struct EpiOddIn {
    static constexpr int VM_MIN = 0; static constexpr bool PREFETCH = false;
    bf16* Q; bf16* KB; bf16* VT; bf16* VTC; bf16* GZ; bf16* GO; const float* qg; const float* kg; const float* rope;
    __device__ __forceinline__ void operator()(const AccT& acc, const Unit& u, int wr, int wc, int fr, int fq) const {
        const int pn = u.i1, row0 = u.i0 * 256; const bool isx = row0 < NX;
        if (pn < 2 || (pn == 2 && wc < 2)) {
            const bool isq = pn < 2; const float* gp = isq ? qg : kg;
            f32x4 gn[2][2];
#pragma unroll
            for (int bj = 0; bj < 2; ++bj)
#pragma unroll
                for (int n = 0; n < 2; ++n) gn[bj][n] = *(const GAS f32x4*)(gp + 32 * n + 16 * bj + 4 * fq);
            const float osc = isq ? QSCALE : 1.0f;
#pragma unroll
            for (int ai = 0; ai < 2; ++ai)
#pragma unroll
                for (int m = 0; m < 4; ++m) { const int row = row0 + ROWL(ai, m);
                    float ss = 0.f;
#pragma unroll
                    for (int bj = 0; bj < 2; ++bj)
#pragma unroll
                        for (int n = 0; n < 2; ++n) { const f32x4 v = (acc[ai][bj][m][n] * OD_INV); ss += (v[0] * v[0] + v[1] * v[1]) + (v[2] * v[2] + v[3] * v[3]); }
                    ss += swz_xor<16>(ss); ss = x32_sum(ss);
                    const float rstd = osc / sqrtf(ss * (1.0f / 64.0f) + EPS_RMS);
                    f32x4 y[2][2];
#pragma unroll
                    for (int bj = 0; bj < 2; ++bj)
#pragma unroll
                        for (int n = 0; n < 2; ++n) y[bj][n] = (acc[ai][bj][m][n] * OD_INV) * rstd * gn[bj][n];
                    if (isx) { const int pos = row & (SEQ - 1);
#pragma unroll
                        for (int n = 0; n < 2; ++n) { const int P = n == 0 ? (pos >> 6) : (pos & 63);
                            const f32x4 cs = *(const GAS f32x4*)(rope + P * 16 + 4 * fq), sn = *(const GAS f32x4*)(rope + 1024 + P * 16 + 4 * fq);
                            const f32x4 x1 = y[0][n], x2 = y[1][n]; y[0][n] = x1 * cs - x2 * sn; y[1][n] = x2 * cs + x1 * sn; } }
                    bf16* dst = isq ? Q + (size_t)row * 512 + (4 * pn + wc) * 64 : KB + (size_t)row * 128 + wc * 64;
#pragma unroll
                    for (int bj = 0; bj < 2; ++bj)
#pragma unroll
                        for (int n = 0; n < 2; ++n) { v2u o; o.x = pg8::cvt_pk_bf16(y[bj][n][0], y[bj][n][1]); o.y = pg8::cvt_pk_bf16(y[bj][n][2], y[bj][n][3]); *(GAS v2u*)(dst + 32 * n + 16 * bj + 4 * fq) = o; }
                    asm volatile("" ::: "memory"); }
        } else if (pn == 2) {
            const int hk = wc & 1;
            const int L = isx ? SEQ : LCTX;
            bf16* ubase = isx ? VT + (size_t)(((row0 >> 12) * 2 + hk) * 64) * SEQ + (row0 & (SEQ - 1)) : VTC + (size_t)((((row0 - NX) >> 8) * 2 + hk) * 64) * LCTX;
#pragma unroll
            for (int ai = 0; ai < 2; ++ai)
#pragma unroll
                for (int m = 0; m < 4; ++m) { bf16* base = ubase + ROWL(ai, m);
#pragma unroll
                    for (int bj = 0; bj < 2; ++bj)
#pragma unroll
                        for (int n = 0; n < 2; ++n)
#pragma unroll
                            for (int e = 0; e < 4; ++e) base[(size_t)(32 * n + 16 * bj + 4 * fq + e) * L] = (bf16)f2bf((acc[ai][bj][m][n] * OD_INV)[e]);
                    asm volatile("" ::: "memory"); }
        } else if (pn < 7) {
#pragma unroll
            for (int ai = 0; ai < 2; ++ai)
#pragma unroll
                for (int m = 0; m < 4; ++m) { const int row = row0 + ROWL(ai, m);
                    *(GAS v4u*)(GZ + (size_t)row * 512 + 128 * (pn - 3) + 32 * wc + 8 * fq) = pack8(acc[ai][0][m][0] * acc[ai][1][m][0] * (OD_INV * OD_INV), acc[ai][0][m][1] * acc[ai][1][m][1] * (OD_INV * OD_INV)); }
        } else {
#pragma unroll
            for (int ai = 0; ai < 2; ++ai)
#pragma unroll
                for (int m = 0; m < 4; ++m) { bf16* rowp = GO + (size_t)(row0 + ROWL(ai, m)) * 512 + 256 * (pn - 7);
#pragma unroll
                    for (int bj = 0; bj < 2; ++bj) *(GAS v4u*)(rowp + COL8(bj)) = pack8(acc[ai][bj][m][0] * OD_INV, acc[ai][bj][m][1] * OD_INV); }
        }
    }
};
__device__ __forceinline__ f32x4 swiglu4(const f32x4 g, const f32x4 u) { f32x4 r; r[0] = silu_f(g[0]) * u[0]; r[1] = silu_f(g[1]) * u[1]; r[2] = silu_f(g[2]) * u[2]; r[3] = silu_f(g[3]) * u[3]; return r; }
struct EpiM1 {
    static constexpr int VM_MIN = 0; static constexpr bool PREFETCH = false;
    bf16* HS; float* LOG;
    __device__ __forceinline__ void operator()(const AccT& acc, const Unit& u, int wr, int wc, int fr, int fq) const {
        const int pn = u.i1, row0 = u.i0 * 256;
        if (pn < 2) {
#pragma unroll
            for (int ai = 0; ai < 2; ++ai)
#pragma unroll
                for (int m = 0; m < 4; ++m) *(GAS v4u*)(HS + (size_t)(row0 + ROWL(ai, m)) * 256 + 128 * pn + 32 * wc + 8 * fq) = pack8(swiglu4(acc[ai][0][m][0], acc[ai][1][m][0]), swiglu4(acc[ai][0][m][1], acc[ai][1][m][1]));
        } else if (wc < 2) {
#pragma unroll
            for (int ai = 0; ai < 2; ++ai)
#pragma unroll
                for (int m = 0; m < 4; ++m) { float* lp = LOG + (size_t)(row0 + ROWL(ai, m)) * 64 + 32 * wc + 8 * fq; *(GAS f32x4*)lp = acc[ai][0][m][0]; *(GAS f32x4*)(lp + 4) = acc[ai][0][m][1]; }
        }
    }
};
__device__ __forceinline__ void build_expert_prefix(const Frame& F0, int l) {
    PHASE_FRAME(F, F0);
    volatile LAS unsigned* pfx = F.MISC + 192;
    if (F.wave == 0) { const int e = F.lane; const unsigned c = __hip_atomic_load(F.ctl + CW_CNT + l * 64 + e, RLX_AGENT); pfx[128 + e] = c;
        const unsigned b = (c + 255u) >> 8; unsigned s = b;
#pragma unroll
        for (int d = 1; d < 64; d <<= 1) { const unsigned t = (unsigned)__builtin_amdgcn_ds_bpermute(((e - d) & 63) << 2, (int)s); s += (e >= d) ? t : 0u; }
        pfx[e] = s - b; if (e == 63) pfx[64] = s; }
    __syncthreads();
}
__device__ __forceinline__ unsigned lds_u(volatile LAS unsigned* p) { return (unsigned)__builtin_amdgcn_readfirstlane((int)*p); }
__device__ __forceinline__ int find_expert(volatile LAS unsigned* pfx, unsigned rbg) {
    unsigned c[7]; int e0 = 0, e1 = 0;
#pragma unroll
    for (int j = 0; j < 7; ++j) c[j] = pfx[8 * (j + 1)];
#pragma unroll
    for (int j = 0; j < 7; ++j) e0 += (c[j] <= rbg) ? 8 : 0;
    e0 = __builtin_amdgcn_readfirstlane(e0);
#pragma unroll
    for (int j = 0; j < 7; ++j) c[j] = pfx[e0 + j + 1];
#pragma unroll
    for (int j = 0; j < 7; ++j) e1 += (c[j] <= rbg) ? 1 : 0;
    return __builtin_amdgcn_readfirstlane(e0 + e1); }
struct SchedExpertGU {
    static constexpr bool SPLIT_B = false, DENSE_A = false, CONST_LDB = true;
    const char* H; const char* EGU; const int* rtok; const unsigned* cnt; volatile LAS unsigned* pfx; int G, c; LAS unsigned char* desc;
    static constexpr bool PREFETCH_A = true, FP8 = true;
    static constexpr unsigned ROWB = 1024u, NROWS = (unsigned)NT;
    __device__ __forceinline__ const LAS int* table(const Unit& u) const { return (const LAS int*)(desc + u.mir * 1024); }

    __device__ __forceinline__ void prefetch_rows(const Unit& u, int wave) const {
        if (wave == 0) __builtin_amdgcn_global_load_lds((const unsigned*)((const char*)(rtok + (size_t)u.i0 * ECAP + u.i1 * 256) + lane_id_now() * 16), (LAS unsigned*)(desc + u.mir * 1024), 16, 0, 0); }
    __device__ __forceinline__ bool next(int i, Unit& u) const { const unsigned cp = G == 256 ? (unsigned)(((c & 7) << 5) | ((c >> 4) << 1) | ((c >> 3) & 1)) : (unsigned)c;
        const unsigned L = (unsigned)(i * G) + cp; if (L >= 2u * lds_u(pfx + 64)) return false; const unsigned rbg = L >> 1; const int t = L & 1, e = find_expert(pfx, rbg);
        u.A = H; u.B = EGU + ((size_t)e * 512 + t * 256) * 1024; u.nt = 8; u.ldb = 512;     u.i0 = e; u.i1 = (int)(rbg - lds_u(pfx + e)); u.i2 = t; u.i3 = (int)rbg * 256; u.mir = i & 1; return true; }
    __device__ __forceinline__ void aoff(const Unit& u, const int (&R)[2], const int (&C)[2], unsigned (&off)[2][2]) const {
        const int n = (int)lds_u(pfx + 128 + u.i0); const LAS int* rt = (const LAS int*)(desc + u.mir * 1024);
#pragma unroll
        for (int h = 0; h < 2; ++h)
#pragma unroll
            for (int i = 0; i < 2; ++i) { const int rho = 128 * h + R[i]; const int tok = (u.i1 * 256 + rho < n) ? (rt[rho] >> 3) : 0; off[h][i] = (unsigned)(tok * 512 + C[i]) * 2u; }
    }
};
struct EpiGU {
    static constexpr int VM_MIN = 0; static constexpr bool PREFETCH = false;
    unsigned char* HMID;
    __device__ __forceinline__ void operator()(const AccT& acc, const Unit& u, int wr, int wc, int fr, int fq) const {
#pragma unroll
        for (int ai = 0; ai < 2; ++ai)
#pragma unroll
            for (int m = 0; m < 4; ++m) { v2u o; o.x = fp8x4(swiglu4(acc[ai][0][m][0] * GU_INV, acc[ai][1][m][0] * GU_INV) * HM_SCALE); o.y = fp8x4(swiglu4(acc[ai][0][m][1] * GU_INV, acc[ai][1][m][1] * GU_INV) * HM_SCALE);
                *(GAS v2u*)(HMID + (size_t)(u.i3 + ROWL(ai, m)) * 256 + 128 * u.i2 + 32 * wc + 8 * fq) = o; asm volatile("" ::: "memory"); }
    }
};
struct SchedExpertDown {
    static constexpr bool PREFETCH_A = false, FP8 = true;
    static constexpr bool SPLIT_B = false, DENSE_A = true, CONST_LDB = true;
    const char* HMID; const char* EDN; volatile LAS unsigned* pfx; int G, c;
    __device__ __forceinline__ bool next(int i, Unit& u) const { const unsigned cp = G == 256 ? (unsigned)(((c & 7) << 5) | ((c >> 5) << 2) | ((c >> 3) & 3)) : (unsigned)c;
        const unsigned L = (unsigned)(i * G) + cp; if (L >= 4u * lds_u(pfx + 64)) return false; const unsigned rbg = L >> 2; const int pn = L & 3, e = find_expert(pfx, rbg);
        u.A = HMID + (size_t)rbg * 256 * 256; u.B = EDN + ((size_t)e * 1024 + pn * 256) * 256; u.nt = 2; u.ldb = 128;     u.i0 = e; u.i1 = (int)(rbg - lds_u(pfx + e)); u.i2 = pn; u.i3 = i & 1; return true; }
    __device__ __forceinline__ void aoff(const Unit&, const int (&R)[2], const int (&C)[2], unsigned (&off)[2][2]) const { dense_aoff(128, R, C, off); }
};
struct EpiDown {
    static constexpr int VM_MIN = 0;  static constexpr bool PREFETCH = true;
    bf16* YS; const int* rtok; const float* rgate; volatile LAS unsigned* pfx; unsigned char* dummy;
    LAS unsigned char* desc;
    __device__ __forceinline__ void prefetch(const Unit& u, int wave) const {
        if (wave < 2) { const size_t tb = (size_t)u.i0 * ECAP + u.i1 * 256; const char* src = wave == 0 ? (const char*)(rtok + tb) : (const char*)(rgate + tb);
            __builtin_amdgcn_global_load_lds((const unsigned*)(src + lane_id_now() * 16), (LAS unsigned*)(desc + u.i3 * 2048 + wave * 1024), 16, 0, 0); }
    }
    __device__ __forceinline__ void operator()(const AccT& acc, const Unit& u, int wr, int wc, int fr, int fq) const {
        const int n = (int)lds_u(pfx + 128 + u.i0); const LAS int* dt = (const LAS int*)(desc + u.i3 * 2048); const LAS float* dg = (const LAS float*)(dt + 256);
#pragma unroll
        for (int ai = 0; ai < 2; ++ai)
#pragma unroll
            for (int m = 0; m < 4; ++m) { const int rho = ROWL(ai, m); const bool ok = u.i1 * 256 + rho < n; const int t = dt[rho]; const float g = dg[rho] * (YS_SCALE * DN_INV);
                const unsigned x0 = fp8x4(acc[ai][0][m][0] * g), y0 = fp8x4(acc[ai][0][m][1] * g), x1 = fp8x4(acc[ai][1][m][0] * g), y1 = fp8x4(acc[ai][1][m][1] * g);
                if (ok) *(GAS v4u*)((unsigned char*)YS + ((size_t)(t >> 3) * TOPK + (t & 7)) * DM + u.i2 * 256 + 64 * wc + 16 * fq) = (v4u){x0, y0, x1, y1};
                asm volatile("" ::: "memory"); }
    }
};
constexpr int NPHASES = 1 + 9 * DEPTH;
#ifndef PHMASK
#define PHMASK 0x3ff
#endif
#define PH_ON(k) ((PHMASK >> (k)) & 1)
#ifndef REPSEL
#define REPSEL -1
#endif
#ifndef REPPAR
#define REPPAR -1
#endif
#define NREP(k) ((REPSEL == (k) && (REPPAR < 0 || REPPAR == (l & 1))) ? 2 : 1)
#ifndef PHSUB
#define PHSUB 0xf
#endif
struct Args { const float* in[26]; float* out; unsigned char* ws; int ph_lo, ph_hi; };
static_assert(sizeof(Args) == 26 * 8 + 8 + 8 + 8, "Args has no padding");

__global__ void __launch_bounds__(NWAVES * 64, 2) fwd_kernel(Args args) {
    extern __shared__ __attribute__((aligned(16))) unsigned char lds_raw[];
    Frame F;
    F.lds = (LAS unsigned char*)lds_raw;
    F.MISC = (volatile LAS unsigned*)(F.lds + MISC_OFF);
    F.wave = __builtin_amdgcn_readfirstlane((int)threadIdx.x >> 6); F.lane = 0; F.tid = 0;
    F.G = gridDim.x; F.bx = blockIdx.x;
    F.ws = args.ws; F.out = args.out; F.ctl = (unsigned*)(args.ws + WS_CTL);
    F.in = args.in;
    for (int u = threadIdx.x; u < (LDS_BYTES - MISC_OFF) / 4; u += NWAVES * 64) F.MISC[u] = 0u;
    __syncthreads();
    const int lo = args.ph_lo, hi = args.ph_hi;
    const bool use_bar = (hi - lo) > 1;
    XcdBarrier bar; bar.bar = F.ctl + CW_BAR; bar.x = 0; bar.st = nullptr; bar.wave = F.wave;
    if (use_bar) bar = xcd_barrier_post(F.ctl + CW_BAR, F.MISC + 8);
#define IN(k) (lo <= (k) && (k) < hi)
#define SEAM(k) do { if (IN(k) && IN((k) + 1)) xcd_barrier(bar); } while (0)
    LAS unsigned char* ring = F.lds;
#define STEAL_IF_IDLE(total_units, layer, quota) do { const int rem_ = (total_units) % F.G; if ((layer) < DEPTH && rem_ != 0 && F.bx >= rem_) expert_convert_steal(F, (layer), (quota)); } while (0)
    const int gw = F.bx * NWAVES + F.wave, NGW = F.G * NWAVES;

    if (PH_ON(0) && IN(0)) { const int l = 0; for (int rep = 0; rep < NREP(0); ++rep) p0_prologue(F); }
    SEAM(0);
#ifdef PROBE_CHECK
    check_mod(F);
#endif

#pragma unroll 1
    for (int l = 0; l < DEPTH; ++l) {
        const int pb = 1 + 9 * l;
        const bool odd = (l & 1) != 0, lastl = (l == DEPTH - 1);
        const int e2 = l >> 1;
        const int nrows = lastl ? NX : NT;
        const float* modl = wsp<const float>(F, WS_MOD) + (size_t)l * 9 * MODW;

        if (PH_ON(1) && IN(pb + 0)) for (int rep = 0; rep < NREP(1); ++rep) {
            norm_phase(F, l, NT, l == 0, F.in[I_N1G] + l * DM, 0, 1, false, true);
        }
#ifdef PROBE_CHECK
        if (l == 0) { xcd_barrier(bar); check_norm(F, l, NT, true, F.in[I_N1G] + l * DM, 0, 1, 9); }
#endif
        SEAM(pb + 0);

        if (PH_ON(2) && IN(pb + 1)) for (int rep = 0; rep < NREP(2); ++rep) {
            if ((PHSUB & 1) && !odd) {
                SchedE1 S{(const char*)wsp<unsigned char>(F, WS_H8), (const char*)(wsp<unsigned char>(F, WS_EVUV) + (size_t)e2 * 1024 * 1024), (const char*)(wsp<unsigned char>(F, WS_EVF) + (size_t)e2 * 1024 * 1024), NT / 256, F.G, F.bx};
                EpiE1 E{wsp<bf16>(F, WS_PROJ + PJ_UV), wsp<bf16>(F, WS_PROJ + PJ_GT), wsp<bf16>(F, WS_PROJ + PJ_GTC)};
                pg8::gemm_phase(ring, F.wave, S, E);
                STEAL_IF_IDLE(2 * (NT / 256) * 4, l, 1);
            } else if ((PHSUB & 2) && odd) {
                SchedDenseT<true> S{(const char*)wsp<unsigned char>(F, WS_H8), (const char*)(wsp<unsigned char>(F, WS_ODIN) + (size_t)e2 * 2304 * 1024), NT / 256, 9, 512, 512, 8, F.G, F.bx};
                EpiOddIn E{wsp<bf16>(F, WS_PROJ + PJ_Q), wsp<bf16>(F, WS_PROJ + PJ_KV), wsp<bf16>(F, WS_PROJ + PJ_VT), wsp<bf16>(F, WS_PROJ + PJ_VTC), wsp<bf16>(F, WS_PROJ + PJ_GZ), wsp<bf16>(F, WS_PROJ + PJ_GO),
                           F.in[I_ODQG] + e2 * 64, F.in[I_ODKG] + e2 * 64, wsp<const float>(F, WS_ROPE)};
                pg8::gemm_phase(ring, F.wave, S, E);
                STEAL_IF_IDLE((NT / 256) * 9, l, 1);
            }
        }
#ifdef PROBE_CHECK
        if (l == 0) { xcd_barrier(bar); check_e1(F, e2); }
#endif
        SEAM(pb + 1);

        if (PH_ON(3) && IN(pb + 2)) for (int rep = 0; rep < NREP(3); ++rep) {
            if ((PHSUB & 1) && !odd) {
                SchedFourier<false> S{(const char*)wsp<bf16>(F, WS_DFT), (const char*)wsp<bf16>(F, WS_PROJ + PJ_GT), F.G, F.bx};
                EpiFourier<false> E{wsp<bf16>(F, WS_MIX), wsp<bf16>(F, WS_PROJ + PJ_PQ)};
                pg8::gemm_phase(ring, F.wave, S, E);
                SchedFourier<true> SC{(const char*)wsp<bf16>(F, WS_DFTC), (const char*)wsp<bf16>(F, WS_PROJ + PJ_GTC), F.G, (F.bx + 16) % F.G};
                EpiFourier<true> EC{wsp<bf16>(F, WS_MIX), wsp<bf16>(F, WS_PROJ + PJ_PQ)};
                pg8::gemm_phase(ring, F.wave, SC, EC);
                __syncthreads();
                if (PHSUB & 4) gmlp_phase(F, e2, NT / 128);
                fourier_nyq_phase(F, e2);
#ifdef REPG
                gmlp_phase(F, e2, NT / 128);
#endif
            } else if ((PHSUB & 2) && odd) {
#ifdef PROBE_ATTN
                attn_phase_naive(F, e2, !lastl);
#else
                attn_phase(F, e2, !lastl);
#endif
                if (PHSUB & 8) conv_phase(F, e2, nrows);
#ifdef REPC
                conv_phase(F, e2, nrows);
#endif
            }
        }
#ifdef PROBE_CHECK
        if (l == 0) { xcd_barrier(bar); check_gmlp(F, e2); check_fourier(F); }
#endif
        SEAM(pb + 2);
        if (!odd && PH_ON(3) && IN(pb + 2)) { fourier_combine_phase(F); if (IN(pb + 3)) xcd_barrier(bar); }

        if (PH_ON(4) && IN(pb + 3)) {
            const unsigned char* W = (odd ? wsp<unsigned char>(F, WS_ODOUT) : wsp<unsigned char>(F, WS_EVOUT)) + (size_t)e2 * 1024 * 1024;
            SchedDenseT<true> S{(const char*)wsp<unsigned char>(F, WS_MIX), (const char*)W, nrows / 256, 4, 512, 512, 8, F.G, F.bx};
            EpiResid<false> E{l == 0 ? F.in[I_X] : nullptr, l == 0 ? F.in[I_CTX] : nullptr, nullptr, wsp<bf16>(F, WS_XH), modl + 2 * DM, nullptr, (unsigned)(unsigned long)(F.lds + MISC_OFF + 4096)};
            pg8::gemm_phase(ring, F.wave, S, E);
            STEAL_IF_IDLE((nrows / 256) * 4, l, 1);
        }
#ifdef PROBE_CHECK
        if (l == 0) { xcd_barrier(bar); check_e4(F, l, e2); }
#endif
        SEAM(pb + 3);

        if (PH_ON(5) && IN(pb + 4)) for (int rep = 0; rep < NREP(5); ++rep) norm_phase(F, l, nrows, false, F.in[I_N2G] + l * DM, 3, 4, true, true);
#ifdef PROBE_CHECK
        if (l == 0) { xcd_barrier(bar); check_norm(F, l, nrows, false, F.in[I_N2G] + l * DM, 3, 4, 15); }
#endif
        SEAM(pb + 4);

        if (PH_ON(6) && IN(pb + 5)) {
            SchedDense S{(const char*)wsp<bf16>(F, WS_H), (const char*)(wsp<bf16>(F, WS_RS) + (size_t)l * 768 * 1024), nrows / 256, 3, 1024, 1024, 16, F.G, F.bx};
            EpiM1 E{wsp<bf16>(F, WS_HS), wsp<float>(F, WS_LOG)};
            for (int rep = 0; rep < NREP(6); ++rep) pg8::gemm_phase(ring, F.wave, S, E);
            VM_WAIT(); __syncthreads();
            Unit u;
            for (int i = 0; S.next(i, u); ++i) if (u.i1 == 2) topk_rows(F, l, u.i0 * 256);
            expert_convert_steal(F, l, -1);
        }
        SEAM(pb + 5);

        if (PH_ON(7) && IN(pb + 6)) for (int rep = 0; rep < NREP(7); ++rep) {
            build_expert_prefix(F, l);
            SchedExpertGU S{(const char*)wsp<unsigned char>(F, WS_H8), (const char*)wsp<bf16>(F, WS_EGU), wsp<const int>(F, WS_RTOK), F.ctl + CW_CNT + l * 64, F.MISC + 192, F.G, F.bx, F.lds + MISC_OFF + 4096};
            EpiGU E{wsp<unsigned char>(F, WS_PROJ)};
            pg8::gemm_phase(ring, F.wave, S, E);
        }
        SEAM(pb + 6);

        if (PH_ON(8) && IN(pb + 7)) for (int rep = 0; rep < NREP(8); ++rep) {
            build_expert_prefix(F, l);
            SchedExpertDown S{(const char*)wsp<bf16>(F, WS_PROJ), (const char*)wsp<bf16>(F, WS_EDN), F.MISC + 192, F.G, F.bx};
            EpiDown E{wsp<bf16>(F, WS_YS), wsp<const int>(F, WS_RTOK), wsp<const float>(F, WS_RGATE), F.MISC + 192, wsp<unsigned char>(F, WS_LOG) + (size_t)F.bx * 8192, F.lds + MISC_OFF + 4096};
            pg8::gemm_phase(ring, F.wave, S, E);
        }
#ifdef PROBE_CHECK
        stash_phase(F, l, nrows);
#endif
        SEAM(pb + 7);

        if (PH_ON(9) && IN(pb + 8)) {
            SchedDense S{(const char*)wsp<bf16>(F, WS_HS), (const char*)(wsp<bf16>(F, WS_SHDN) + (size_t)l * 1024 * 256), nrows / 256, 4, 256, 256, 4, F.G, F.bx};
            EpiResid<true> E{nullptr, nullptr, lastl ? F.out : nullptr, wsp<bf16>(F, WS_XH), modl + 5 * DM, wsp<const bf16>(F, WS_YS), 0u};
            pg8::gemm_phase(ring, F.wave, S, E);
            STEAL_IF_IDLE((nrows / 256) * 4, l + 1, 2);
        }
#ifdef PROBE_CHECK
        xcd_barrier(bar); check_moe(F, l, nrows); xcd_barrier(bar);
#else
        SEAM(pb + 8);
#endif
    }
#ifdef PROBE_CHECK
    xcd_barrier(bar); encode_phase(F, 16);
#endif
#undef IN
#undef SEAM
}

#ifndef MK_MULTI
#define MK_MULTI 0
#endif
extern "C" void kernel_launch(void* const* d_in, const int* in_sizes, int n_in, void* d_out, int out_size, void* d_ws, size_t ws_size, hipStream_t stream) {
    static int grid = 0;
    if (grid == 0) {
        if (n_in != 26 || out_size != NX * DM || ws_size < WS_END) { fprintf(stderr, "kernel_launch: unexpected shapes (n_in %d out %d ws %zu need %zu)\n", n_in, out_size, ws_size, (size_t)WS_END); grid = -1; return; }
        int dev = 0, cus = 0, per_cu = 0;
        if (hipGetDevice(&dev) != hipSuccess || hipDeviceGetAttribute(&cus, hipDeviceAttributeMultiprocessorCount, dev) != hipSuccess) { grid = -1; return; }
        if (hipFuncSetAttribute((const void*)fwd_kernel, hipFuncAttributeMaxDynamicSharedMemorySize, LDS_BYTES) != hipSuccess) { fprintf(stderr, "kernel_launch: hipFuncSetAttribute failed\n"); grid = -1; return; }
        if (hipOccupancyMaxActiveBlocksPerMultiprocessor(&per_cu, (const void*)fwd_kernel, NWAVES * 64, LDS_BYTES) != hipSuccess || per_cu < 1) fprintf(stderr, "kernel_launch: occupancy query says %d\n", per_cu);
        (void)hipGetLastError();
        grid = cus;
    }
    if (grid < 0) return;
    (void)hipMemsetAsync((char*)d_ws + WS_CTL, 0, CTL_ZERO_BYTES, stream);
    Args a{};
    for (int i = 0; i < 26; ++i) a.in[i] = (const float*)d_in[i];
    a.out = (float*)d_out; a.ws = (unsigned char*)d_ws;
#if MK_MULTI
    for (int p = 0; p < NPHASES; ++p) { a.ph_lo = p; a.ph_hi = p + 1; hipLaunchKernelGGL(fwd_kernel, dim3(grid), dim3(NWAVES * 64), LDS_BYTES, stream, a); }
#else
    a.ph_lo = 0; a.ph_hi = NPHASES;
    hipLaunchKernelGGL(fwd_kernel, dim3(grid), dim3(NWAVES * 64), LDS_BYTES, stream, a);
#endif
}
```

```cpp
#include <hip/hip_runtime.h>
#include <cstdio>
#include <cstdint>
namespace pg8 {
#define PG8_LAS __attribute__((address_space(3)))
typedef unsigned short bf16_t;
typedef short bf16x8 __attribute__((ext_vector_type(8)));
typedef float f32x4 __attribute__((ext_vector_type(4)));
typedef float f32x2 __attribute__((ext_vector_type(2)));
typedef unsigned u32x4 __attribute__((ext_vector_type(4)));
typedef unsigned u32x2 __attribute__((ext_vector_type(2)));
constexpr int BM = 256, BK = 64, HALF = 128, HTB = HALF * BK * 2  , STAGE_BYTES = 8 * HTB, NXCD = 8, WGM = 8;

__host__ __device__ __forceinline__ int lds_byte(int r, int c) { const int st = (r >> 4) * 2 + (c >> 5), rr = r & 15, cc = c & 31, ob = rr * 64 + cc * 2; return st * 1024 + (ob ^ (((ob >> 9) & 1) << 5)); }
__host__ __device__ __forceinline__ void stage_rc(int b, int& R, int& C) { const int st = b / 1024, sb = b % 1024, swz = sb ^ (((sb >> 9) & 1) << 5); R = (st >> 1) * 16 + swz / 64; C = (st & 1) * 32 + (swz % 64) / 2; }
__host__ __device__ __forceinline__ int perm32(int rho) { const int n = rho >> 4, i = rho & 15; return 8 * (i >> 2) + 4 * n + (i & 3); }

struct Unit { const char* A; const char* B; int nt, ldb; int i0, i1, i2, i3; const char* B1; int mir; };

__device__ __forceinline__ void tile_order(int L, int nM, int nN, int& pm, int& pn) {
    const int nwg = nM * nN; int wgid = L; { const int q = nwg / NXCD, r = nwg % NXCD, xcd = wgid % NXCD, off = wgid / NXCD; wgid = (xcd < r ? xcd * (q + 1) : r * (q + 1) + (xcd - r) * q) + off; }
    const int nig = WGM * nN, gid = wgid / nig, fm = gid * WGM, gsz = (nM - fm) < WGM ? (nM - fm) : WGM;
    pm = fm + ((wgid % nig) % gsz); pn = (wgid % nig) / gsz;
}

typedef _Float16 h16x8 __attribute__((ext_vector_type(8)));
typedef _Float16 h16x2v __attribute__((ext_vector_type(2)));
__device__ __forceinline__ unsigned cvt_pk_bf16(float lo, float hi) { f32x2 v = {lo, hi}; return __builtin_bit_cast(unsigned, __builtin_convertvector(v, h16x2v)); }

__device__ __forceinline__ void pg8_dma16(const char* base, unsigned off, unsigned ldsaddr) {
    asm volatile("s_mov_b32 m0, %2\n\ts_nop 0\n\tglobal_load_lds_dwordx4 %0, %1" :: "v"(off), "s"(base), "s"(ldsaddr) : "memory", "m0"); }
__device__ __forceinline__ unsigned pg8_mirror_off(unsigned off, int ldb) { unsigned o = off; asm volatile("" : "+v"(o)); return 127u * (unsigned)(ldb * 2) + 2u * (o & 127u) - o; }
__device__ __forceinline__ unsigned pg8_umin(unsigned a, unsigned b) { return a < b ? a : b; }
__device__ __forceinline__ void pg8_dma4(const char* base, unsigned off, unsigned ldsaddr) {
    asm volatile("s_mov_b32 m0, %2\n\ts_nop 0\n\tglobal_load_lds_dword %0, %1" :: "v"(off), "s"(base), "s"(ldsaddr) : "memory", "m0"); }
typedef int i32x8 __attribute__((ext_vector_type(8)));
typedef int i32x4 __attribute__((ext_vector_type(4)));
__device__ __forceinline__ i32x8 pg8_cat(bf16x8 lo, bf16x8 hi) { const i32x4 a = __builtin_bit_cast(i32x4, lo), b = __builtin_bit_cast(i32x4, hi); return (i32x8){a[0], a[1], a[2], a[3], b[0], b[1], b[2], b[3]}; }
__device__ __forceinline__ void pg8_mma8(f32x4& c, i32x8 a, i32x8 b) { asm("v_mfma_f32_16x16x128_f8f6f4 %0, %1, %2, %0" : "+v"(c) : "v"(a), "v"(b)); }
template <int N> __device__ __forceinline__ void pg8_wait_vm() { asm volatile("s_waitcnt vmcnt(%0)" :: "n"(N) : "memory"); }
template <class Epi, class Sched>
__device__ __forceinline__ void gemm_phase(PG8_LAS unsigned char* lds, int wave  , const Sched& S, const Epi& E) {
    unsigned z_ = 0u; asm volatile("" : "+v"(z_)); int lane_ = (int)__builtin_amdgcn_mbcnt_hi(~0u, __builtin_amdgcn_mbcnt_lo(~0u, z_));
    const int wid = wave, lane = lane_, tid = wid * 64 + lane, wr = wid >> 2, wc = wid & 3, fr = lane & 15, fq = lane >> 4;
    int RR[2], CC[2], RB[2]; unsigned voffB[2]; unsigned voffB1 = 0u; long dB1 = 0;
#pragma unroll
    for (int i = 0; i < 2; ++i) { int R, C; stage_rc(tid * 16 + i * 8192, R, C); RR[i] = R; CC[i] = C; RB[i] = (R & ~31) + perm32(R & 31); }
    const size_t kstep = (size_t)(BK * 2);
    size_t hstepB;
    const unsigned ldsw = (unsigned)wid * 1024u;
    const int aoff = Sched::FP8 ? lds_byte(wr * 64 + fr, fq * 16) : lds_byte(wr * 64 + fr, fq * 8), boff = Sched::FP8 ? lds_byte(wc * 32 + fr, fq * 16) : lds_byte(wc * 32 + fr, fq * 8);
    constexpr int KSTR = Sched::FP8 ? 16 : 1024;
#define PG8_SA(b, h) (((b) * 2 + (h)) * HTB)
#define PG8_SB(b, h) ((4 + (b) * 2 + (h)) * HTB)
#define PG8_LDSA(x) ((unsigned)(unsigned long)(lds + (x)))
#define PG8_STAGEB(bufoff, gbase) do { _Pragma("unroll") for (int _i = 0; _i < 2; ++_i) \
        pg8_dma16((const char*)(gbase) + _i * (hstepB >> 1), voffB[0], PG8_LDSA((bufoff) + ldsw + _i * 8192)); } while (0)
#define PG8_STAGEB1(bufoff, gbase) do { _Pragma("unroll") for (int _i = 0; _i < 2; ++_i) \
        pg8_dma16((const char*)(gbase), voffB1 + (unsigned)(_i * (int)dB1), PG8_LDSA((bufoff) + ldsw + _i * 8192)); } while (0)
#define PG8_STAGEA(bufoff, gbase, o0, o1) do { \
        pg8_dma16((const char*)(gbase), (o0), PG8_LDSA((bufoff) + ldsw)); \
        if constexpr (Sched::DENSE_A) pg8_dma16((const char*)(gbase) + (hstepA >> 1), (o0), PG8_LDSA((bufoff) + ldsw + 8192)); \
        else pg8_dma16((const char*)(gbase), (o1), PG8_LDSA((bufoff) + ldsw + 8192)); } while (0)
#define PG8_LDA(dst, b, h) do { _Pragma("unroll") for (int m = 0; m < 4; ++m) _Pragma("unroll") for (int k = 0; k < 2; ++k) dst[m][k] = *(const PG8_LAS bf16x8*)(lds + PG8_SA(b, h) + aoff + m * 2048 + k * KSTR); } while (0)
#define PG8_LDB(dst, b, h) do { _Pragma("unroll") for (int n = 0; n < 2; ++n) _Pragma("unroll") for (int k = 0; k < 2; ++k) dst[n][k] = *(const PG8_LAS bf16x8*)(lds + PG8_SB(b, h) + boff + n * 2048 + k * KSTR); } while (0)
#define PG8_MMA(ai, bj, At, Bt) do { __builtin_amdgcn_s_setprio(1); \
        if constexpr (Sched::FP8) { _Pragma("unroll") for (int m = 0; m < 4; ++m) _Pragma("unroll") for (int n = 0; n < 2; ++n) \
            pg8_mma8(acc[ai][bj][m][n], pg8_cat(Bt[n][0], Bt[n][1]), pg8_cat(At[m][0], At[m][1])); } \
        else { _Pragma("unroll") for (int m = 0; m < 4; ++m) _Pragma("unroll") for (int n = 0; n < 2; ++n) _Pragma("unroll") for (int k = 0; k < 2; ++k) \
            acc[ai][bj][m][n] = __builtin_amdgcn_mfma_f32_16x16x32_f16(__builtin_bit_cast(h16x8, Bt[n][k]), __builtin_bit_cast(h16x8, At[m][k]), acc[ai][bj][m][n], 0, 0, 0); } \
        __builtin_amdgcn_s_setprio(0); } while (0)
#define PG8_GOFF(tab, h, i) ((unsigned)(pg8_umin((unsigned)((tab)[128 * (h) + 64 * (i) + RR[0]]) >> 3, Sched::NROWS - 1u) * Sched::ROWB + (unsigned)CC[0] * 2u))
#define AO(tab, h, i) ({ unsigned o_; if constexpr (Sched::DENSE_A) o_ = oC[0][i]; else o_ = PG8_GOFF(tab, h, i); o_; })
#define BH1(bufoff, p0, p1) do { if constexpr (Sched::SPLIT_B) PG8_STAGEB1(bufoff, p1); else PG8_STAGEB(bufoff, (p0) + hstepB); } while (0)
#define AH1(p) (Sched::DENSE_A ? (p) + hstepA : (p))
#define PG8_WAIT_V(n) asm volatile("s_waitcnt vmcnt(" #n ")" ::: "memory")
#define PG8_WAIT_L(n) asm volatile("s_waitcnt lgkmcnt(" #n ")" ::: "memory")
#define PG8_BAR __builtin_amdgcn_s_barrier()
#define PG8_SCHED __builtin_amdgcn_sched_barrier(0)
    constexpr int VMX = 8 + (Epi::VM_MIN > 55 ? 55 : Epi::VM_MIN);
    Unit cur, nxt; int ui = 0;
    if (!S.next(0, cur)) return;
    f32x4 acc[2][2][4][2];
#pragma unroll
    for (int a = 0; a < 2; ++a)
#pragma unroll
        for (int b = 0; b < 2; ++b)
#pragma unroll
            for (int m = 0; m < 4; ++m)
#pragma unroll
                for (int n = 0; n < 2; ++n) acc[a][b][m][n] = (f32x4){0.f, 0.f, 0.f, 0.f};
    bf16x8 At[4][2], B0[2][2], B1[2][2];
    unsigned oC[2][2] = {{0u, 0u}, {0u, 0u}};
    const PG8_LAS int* tabC = nullptr; const PG8_LAS int* tabN = nullptr;
    if constexpr (Sched::PREFETCH_A) { S.prefetch_rows(cur, wave); PG8_WAIT_V(0); PG8_BAR; }
    if constexpr (Sched::DENSE_A) S.aoff(cur, RR, CC, oC); else tabC = S.table(cur);
    const size_t hstepA = Sched::DENSE_A ? (size_t)(unsigned)__builtin_amdgcn_readfirstlane((int)(oC[1][0] - oC[0][0])) : 0;
    const char* cA = cur.A; const char* cB = cur.B;
    voffB[0] = (unsigned)(RB[0] * cur.ldb + CC[0]) * 2u; voffB[1] = (unsigned)(RB[1] * cur.ldb + CC[1]) * 2u; hstepB = (size_t)HALF * cur.ldb * 2;
    const char* cB1 = cB;
    if constexpr (Sched::SPLIT_B) { cB1 = cur.B1; voffB1 = cur.mir ? pg8_mirror_off(voffB[0], cur.ldb) : voffB[0]; dB1 = cur.mir ? -(long)(64 * cur.ldb * 2) : (long)(64 * cur.ldb * 2); }
    PG8_STAGEB(PG8_SB(0, 0), cB); BH1(PG8_SB(0, 1), cB, cB1); PG8_STAGEA(PG8_SA(0, 0), cA, AO(tabC, 0, 0), AO(tabC, 0, 1)); PG8_STAGEA(PG8_SA(0, 1), AH1(cA), AO(tabC, 1, 0), AO(tabC, 1, 1));
    if (wr == 1) PG8_BAR;
    PG8_WAIT_V(2); PG8_BAR;
    PG8_STAGEB(PG8_SB(1, 0), cB + kstep); PG8_STAGEA(PG8_SA(1, 0), cA + kstep, AO(tabC, 0, 0), AO(tabC, 0, 1)); BH1(PG8_SB(1, 1), cB + kstep, cB1 + kstep);
    PG8_WAIT_V(6); PG8_BAR;
    for (;;) {
        const bool has_next = S.next(ui + 1, nxt);
        const char* nA = has_next ? nxt.A : cA; const char* nB = has_next ? nxt.B : cB;
        const char* nB1 = cB1; if constexpr (Sched::SPLIT_B) nB1 = has_next ? nxt.B1 : cB1;
        const int ntm2 = __builtin_amdgcn_readfirstlane(cur.nt - 2);
        if constexpr (Sched::PREFETCH_A) { if (has_next) S.prefetch_rows(nxt, wave); }
        if constexpr (!Sched::DENSE_A) tabN = has_next ? S.table(nxt) : tabC;
        if constexpr (Epi::PREFETCH) E.prefetch(cur, wave);
        for (int t = 0; t <= ntm2; t += 2) {
            const bool last = (t == ntm2);
            const bool fresh = (t == 0) && (ui > 0);
            const char* a1 = cA + (size_t)(t + 1) * kstep;
            const char* a2 = last ? nA : cA + (size_t)(t + 2) * kstep; const char* b2 = last ? nB : cB + (size_t)(t + 2) * kstep;
            const char* a3 = a2 + kstep; const char* b3 = b2 + kstep;
            const char* b21 = b2; const char* b31 = b3; if constexpr (Sched::SPLIT_B) { b21 = last ? nB1 : cB1 + (size_t)(t + 2) * kstep; b31 = b21 + kstep; }
            const PG8_LAS int* tabX = last ? tabN : tabC;
            if constexpr (Sched::SPLIT_B) { if (last && has_next) { voffB1 = nxt.mir ? pg8_mirror_off(voffB[0], nxt.ldb) : voffB[0]; dB1 = nxt.mir ? -(long)(64 * nxt.ldb * 2) : (long)(64 * nxt.ldb * 2); } }
            if constexpr (!Sched::CONST_LDB) { if (last && has_next) { voffB[0] = (unsigned)(RB[0] * nxt.ldb + CC[0]) * 2u; voffB[1] = (unsigned)(RB[1] * nxt.ldb + CC[1]) * 2u; hstepB = (size_t)HALF * nxt.ldb * 2; } }
            PG8_LDB(B0, 0, 0); PG8_LDB(B1, 0, 1); PG8_SCHED; PG8_LDA(At, 0, 0); PG8_STAGEA(PG8_SA(1, 1), AH1(a1), AO(tabC, 1, 0), AO(tabC, 1, 1));
            if (VMX > 8 && fresh) pg8_wait_vm<VMX>(); else PG8_WAIT_V(8);
            PG8_WAIT_L(0); PG8_BAR; PG8_MMA(0, 0, At, B0); PG8_MMA(0, 1, At, B1); PG8_BAR; PG8_SCHED;
            PG8_LDA(At, 0, 1); PG8_STAGEB(PG8_SB(0, 0), b2); BH1(PG8_SB(0, 1), b2, b21); PG8_STAGEA(PG8_SA(0, 0), a2, AO(tabX, 0, 0), AO(tabX, 0, 1));
            if (VMX > 8 && fresh) pg8_wait_vm<VMX>(); else PG8_WAIT_V(8);
            PG8_WAIT_L(0); PG8_BAR; PG8_MMA(1, 0, At, B0); PG8_MMA(1, 1, At, B1); PG8_BAR; PG8_SCHED;
            PG8_LDB(B0, 1, 0); PG8_LDB(B1, 1, 1); PG8_SCHED; PG8_LDA(At, 1, 0); PG8_STAGEA(PG8_SA(0, 1), AH1(a2), AO(tabX, 1, 0), AO(tabX, 1, 1));
            PG8_WAIT_V(8); PG8_WAIT_L(0); PG8_BAR; PG8_MMA(0, 0, At, B0); PG8_MMA(0, 1, At, B1); PG8_BAR; PG8_SCHED;
            PG8_LDA(At, 1, 1); PG8_STAGEB(PG8_SB(1, 0), b3); BH1(PG8_SB(1, 1), b3, b31); PG8_STAGEA(PG8_SA(1, 0), a3, AO(tabX, 0, 0), AO(tabX, 0, 1));
            PG8_WAIT_V(8); PG8_WAIT_L(0); PG8_BAR; PG8_MMA(1, 0, At, B0); PG8_MMA(1, 1, At, B1); PG8_BAR; PG8_SCHED;
        }
        if (wr == 0) PG8_BAR;
        if constexpr (Sched::FP8) asm volatile("s_nop 7\n\ts_nop 7\n\ts_nop 7" ::: "memory");
        { unsigned z2_ = 0u; asm volatile("" : "+v"(z2_)); const int l2_ = (int)__builtin_amdgcn_mbcnt_hi(~0u, __builtin_amdgcn_mbcnt_lo(~0u, z2_)); int fr_e = l2_ & 15, fq_e = l2_ >> 4;
          E(acc, cur, wr, wc, fr_e, fq_e); }
        if (!has_next) break;
#pragma unroll
        for (int a = 0; a < 2; ++a)
#pragma unroll
            for (int b = 0; b < 2; ++b)
#pragma unroll
                for (int m = 0; m < 4; ++m)
#pragma unroll
                    for (int n = 0; n < 2; ++n) acc[a][b][m][n] = (f32x4){0.f, 0.f, 0.f, 0.f};
        cur = nxt; cA = nA; cB = nB; cB1 = nB1; ++ui;
        tabC = tabN;
        if (wr == 1) PG8_BAR;
    }
    PG8_WAIT_V(0);
    PG8_BAR;
#undef PG8_SA
#undef PG8_SB
#undef PG8_STAGEA
#undef PG8_STAGEB
#undef PG8_STAGEB1
#undef BH1
#undef PG8_LDA
#undef PG8_LDB
#undef PG8_MMA
#undef OX
#undef OCH
#undef AH1
#undef PG8_WAIT_V
#undef PG8_WAIT_L
#undef PG8_BAR
#undef PG8_SCHED
}
}
constexpr int NWAVES = 8;
constexpr int NX = 32768, NC = 2048, NT = NX + NC, DM = 1024, NBATCH = 8, SEQ = 4096, LCTX = 256, DEPTH = 4;
constexpr int MODW = 6 * DM;
constexpr int NEXP = 64, TOPK = 6, DEXP = 256;
constexpr int ECAP = NT;
constexpr int PMAX = NT * TOPK + NEXP * 256;
constexpr float EPS_RMS = 1e-6f;
constexpr float QSCALE = 0.125f * 1.4426950408889634f;
constexpr float LOG2E = 1.4426950408889634f;

constexpr size_t al256(size_t x) { return (x + 255) & ~(size_t)255; }
constexpr size_t WS_CTL = 0;
constexpr size_t WS_MOD = 1u << 20;
constexpr size_t CTL_ZERO_BYTES = 2u << 20;
constexpr size_t WS_ROPE = CTL_ZERO_BYTES;
constexpr size_t WS_EVUV = WS_ROPE + 8192;
constexpr size_t WS_EVF = WS_EVUV + (size_t)2 * 1024 * 1024 * 2;
constexpr size_t WS_EVOUT = WS_EVF + (size_t)2 * 1024 * 1024 * 2;
constexpr size_t WS_EVWS = WS_EVOUT + (size_t)2 * 1024 * 1024 * 2;
constexpr size_t WS_ODIN = WS_EVWS + (size_t)2 * 4 * 128 * 128 * 2;
constexpr size_t WS_ODOUT = WS_ODIN + (size_t)2 * 2304 * 1024 * 2;
constexpr size_t WS_RS = WS_ODOUT + (size_t)2 * 1024 * 1024 * 2;
constexpr size_t WS_SHDN = WS_RS + (size_t)4 * 768 * 1024 * 2;
constexpr size_t WS_DFT = WS_SHDN + (size_t)4 * 1024 * 256 * 2;
constexpr size_t WS_DFTC = WS_DFT + (size_t)4096 * 8192 * 2;
constexpr size_t WS_EGU = WS_DFTC + (size_t)256 * 512 * 2;
constexpr size_t WS_EDN = WS_EGU + (size_t)64 * 512 * 1024 * 2;
constexpr size_t WS_XH = WS_EDN + (size_t)64 * 1024 * 256 * 2;
constexpr size_t WS_H = WS_XH + (size_t)NT * DM * 2;
constexpr size_t WS_PROJ = WS_H + (size_t)NT * DM * 2;
constexpr size_t PJ_UV = 0;
constexpr size_t PJ_GT = PJ_UV + (size_t)NT * 1024 * 2;
constexpr size_t PJ_GTC = PJ_GT + (size_t)8 * 1024 * 4096 * 2;
constexpr size_t PJ_PQ = PJ_GTC + (size_t)8 * 1024 * 256 * 2;
constexpr size_t PJ_NY = PJ_PQ + (size_t)8 * 2 * 2048 * 512 * 2;
constexpr size_t PJ_EVEN_END = PJ_NY + (size_t)8 * 512 * 4;
constexpr size_t PJ_Q = 0;
constexpr size_t PJ_KV = PJ_Q + (size_t)NT * 512 * 2;
constexpr size_t PJ_VT = PJ_KV + (size_t)NT * 256 * 2;
constexpr size_t PJ_VTC = PJ_VT + (size_t)8 * 2 * 64 * 4096 * 2;
constexpr size_t PJ_GZ = PJ_VTC + (size_t)8 * 2 * 64 * 256 * 2;
constexpr size_t PJ_GO = PJ_GZ + (size_t)NT * 512 * 2;
constexpr size_t PJ_ODD_END = PJ_GO + (size_t)NT * 512 * 2;
constexpr size_t PJ_HMID_END = (size_t)PMAX * 256 * 2;
constexpr size_t cmax(size_t a, size_t b) { return a > b ? a : b; }
constexpr size_t PROJ_BYTES = al256(cmax(cmax(PJ_EVEN_END, PJ_ODD_END), PJ_HMID_END));
constexpr size_t WS_LOG = WS_PROJ + PROJ_BYTES;
constexpr size_t WS_HS = WS_LOG + (size_t)NT * 64 * 4;
constexpr size_t WS_RTOK = WS_HS + (size_t)NT * 256 * 2;
constexpr size_t WS_RGATE = WS_RTOK + (size_t)NEXP * ECAP * 4;
constexpr size_t WS_YS = WS_RGATE + (size_t)NEXP * ECAP * 4;
constexpr size_t WS_H8 = WS_YS + (size_t)NT * TOPK * DM;
constexpr size_t WS_MIX = WS_YS;
constexpr size_t WS_END = WS_YS + (size_t)NT * TOPK * DM * 2;
static_assert(WS_END < (size_t)1040 * 1000 * 1000, "workspace budget");

constexpr int CW_TMO = 0;
constexpr int CW_BAR = 4096;
constexpr int CW_CNT = 16384;
constexpr int CW_CVQ = 17408;

constexpr int RING_BYTES = 131072;
constexpr int MISC_OFF = 139264;
constexpr int LDS_BYTES = 147456;

#define GAS __attribute__((address_space(1)))
#define LAS __attribute__((address_space(3)))
typedef unsigned short bf16;
typedef unsigned v4u __attribute__((ext_vector_type(4)));
typedef unsigned v2u __attribute__((ext_vector_type(2)));
typedef float f32x4 __attribute__((ext_vector_type(4)));
typedef float f32x2 __attribute__((ext_vector_type(2)));
typedef float f32x16 __attribute__((ext_vector_type(16)));
typedef short bf16x8 __attribute__((ext_vector_type(8)));
typedef short s16x4 __attribute__((ext_vector_type(4)));
typedef GAS unsigned gu32;
#define RLX_AGENT __ATOMIC_RELAXED, __HIP_MEMORY_SCOPE_AGENT
#define LDS_WAIT() asm volatile("s_waitcnt lgkmcnt(0)" ::: "memory")
#define VM_WAIT() asm volatile("s_waitcnt vmcnt(0)" ::: "memory")
typedef _Float16 h16x2 __attribute__((ext_vector_type(2)));
__device__ __forceinline__ unsigned f2bf(float f) { return (unsigned)__builtin_bit_cast(unsigned short, (_Float16)f); }
__device__ __forceinline__ unsigned pk2(float lo, float hi) { f32x2 v = {lo, hi}; return __builtin_bit_cast(unsigned, __builtin_convertvector(v, h16x2)); }
__device__ __forceinline__ float bf2f(unsigned short b) { return (float)__builtin_bit_cast(_Float16, b); }
__device__ __forceinline__ float bflo(unsigned w) { return (float)__builtin_bit_cast(h16x2, w)[0]; }
__device__ __forceinline__ float bfhi(unsigned w) { return (float)__builtin_bit_cast(h16x2, w)[1]; }
constexpr float YS_SCALE = 8.0f, YS_INV = 1.0f / 8.0f;
constexpr float HM_SCALE = 16.0f, WD_SCALE = 64.0f, DN_INV = 1.0f / (16.0f * 64.0f);
__device__ __forceinline__ float clamp8(float v) { return __builtin_amdgcn_fmed3f(v, -440.0f, 440.0f); }
__device__ __forceinline__ unsigned fp8x4(const f32x4 a) { unsigned x = 0u; x = __builtin_amdgcn_cvt_pk_fp8_f32(clamp8(a[0]), clamp8(a[1]), x, false); x = __builtin_amdgcn_cvt_pk_fp8_f32(clamp8(a[2]), clamp8(a[3]), x, true); return x; }
constexpr float WUV_SCALE = 64.0f, WF_SCALE = 32.0f, UV_INV = 1.0f / (4.0f * 64.0f), FO_INV = 1.0f / (4.0f * 32.0f);
constexpr float MIX_SCALE = 4.0f, WO_SCALE = 64.0f, MO_INV = 1.0f / (4.0f * 64.0f);
constexpr float WI_SCALE = 64.0f, OD_INV = 1.0f / (4.0f * 64.0f);
constexpr float DFT_SCALE = 8192.0f, FO_SCALE = 4.0f, PQ_INV = 1.0f / (8192.0f * 4.0f);
constexpr float H8_SCALE = 4.0f, WG_SCALE = 64.0f, GU_INV = 1.0f / (4.0f * 64.0f);
__device__ __forceinline__ unsigned mix8x4(float a, float b, float c, float d) { return fp8x4((f32x4){a, b, c, d} * MIX_SCALE); }
__device__ __forceinline__ float fast_exp2(float x) { return __builtin_amdgcn_exp2f(x); }
__device__ __forceinline__ float fast_rcp(float x) { return __builtin_amdgcn_rcpf(x); }
__device__ __forceinline__ float silu_f(float x) { return x * fast_rcp(1.0f + fast_exp2(-LOG2E * x)); }
__device__ __forceinline__ float sigmoid_f(float x) { return fast_rcp(1.0f + fast_exp2(-LOG2E * x)); }
__device__ __forceinline__ float gelu_f(float x) { const float z = 0.7978845608028654f * (x + 0.044715f * x * x * x); return x * fast_rcp(1.0f + fast_exp2(-2.0f * LOG2E * z)); }
template <int M> __device__ __forceinline__ float swz_xor(float v) { return __builtin_bit_cast(float, __builtin_amdgcn_ds_swizzle(__builtin_bit_cast(int, v), (M << 10) | 0x1f)); }
__device__ __forceinline__ float x32_other(float v) { unsigned z = 0u; asm volatile("" : "+v"(z)); const int l = (int)__builtin_amdgcn_mbcnt_hi(~0u, __builtin_amdgcn_mbcnt_lo(~0u, z)); return __builtin_bit_cast(float, __builtin_amdgcn_ds_bpermute((l ^ 32) << 2, __builtin_bit_cast(int, v))); }
__device__ __forceinline__ float x32_sum(float v) { return v + x32_other(v); }
__device__ __forceinline__ float x32_max(float v) { return fmaxf(v, x32_other(v)); }
__device__ __forceinline__ float wave_sum(float v) { v += swz_xor<1>(v); v += swz_xor<2>(v); v += swz_xor<4>(v); v += swz_xor<8>(v); v += swz_xor<16>(v); return x32_sum(v); }

__device__ __forceinline__ int lane_id_now() { unsigned z = 0u; asm volatile("" : "+v"(z)); return (int)__builtin_amdgcn_mbcnt_hi(~0u, __builtin_amdgcn_mbcnt_lo(~0u, z)); }
#define XB_TMO      128
#define XB_XCNT(j)  (256  + 64 * (j))
#define XB_XSUB(j)  (1280 + 64 * (j))
#define XB_XGEN(j)  (2304 + 64 * (j))
#define XB_TOP      3328
#define XB_TOPGEN   3392
#define XCD_BAR_WORDS 3456
#define XB_SPIN_CAP (1u << 18)
__device__ __forceinline__ unsigned xb_ld(unsigned* p)              { return __hip_atomic_load(p, __ATOMIC_RELAXED, __HIP_MEMORY_SCOPE_AGENT); }
__device__ __forceinline__ unsigned xb_add(unsigned* p, unsigned v) { return __hip_atomic_fetch_add(p, v, __ATOMIC_RELAXED, __HIP_MEMORY_SCOPE_AGENT); }
__device__ __forceinline__ unsigned xb_xcc_id() { return (unsigned)__builtin_amdgcn_s_getreg((3 << 11) | 20) & 0xFu; }
#define XB_SPIN(cond, bar) do { unsigned _sp = 0; while (cond) { __builtin_amdgcn_s_sleep(1); \
    if ((++_sp & 255u) == 0u) { if (xb_ld(&(bar)[XB_TMO])) break; if (_sp > XB_SPIN_CAP) { atomicAdd(&(bar)[XB_TMO], 1u); break; } } } } while (0)
struct XcdBarrier { unsigned* bar; unsigned x; volatile LAS unsigned* st; int wave; };
__device__ __forceinline__ XcdBarrier xcd_barrier_post(unsigned* bar, volatile LAS unsigned* st) {
    XcdBarrier b; b.bar = bar; b.x = xb_xcc_id(); b.st = st; b.wave = __builtin_amdgcn_readfirstlane((int)threadIdx.x >> 6);
    if (threadIdx.x == 0) (void)xb_add(&bar[XB_XCNT(b.x)], 1u);
    return b;
}
__device__ __forceinline__ void xcd_barrier_complete(unsigned* bar, unsigned x, unsigned& nloc, unsigned& nx) {
    const unsigned G = gridDim.x * gridDim.y * gridDim.z;
    unsigned sum, cnt, mine, sp = 0u;
    for (;;) {
        sum = 0u; cnt = 0u; mine = 0u;
#pragma unroll
        for (unsigned j = 0; j < 16; ++j) { const unsigned c = xb_ld(&bar[XB_XCNT(j)]); sum += c; cnt += (c > 0u) ? 1u : 0u; mine = (j == x) ? c : mine; }
        if (sum == G) break;
        __builtin_amdgcn_s_sleep(1);
        if ((++sp & 255u) == 0u) { if (xb_ld(&bar[XB_TMO])) break; if (sp > XB_SPIN_CAP) { atomicAdd(&bar[XB_TMO], 1u); break; } }
    }
    nloc = mine > 0u ? mine : 1u; nx = cnt > 0u ? cnt : 1u;
}
__device__ __forceinline__ void xcd_barrier(const XcdBarrier& b) {
    asm volatile("s_waitcnt vmcnt(0)" ::: "memory");
    __syncthreads();
    if (b.wave == 0 && lane_id_now() == 0) {
        unsigned* bar = b.bar; unsigned bx_ = b.x; asm volatile("" : "+s"(bar), "+s"(bx_));
        __builtin_amdgcn_s_waitcnt(0);
        unsigned nloc = b.st[0], nx = b.st[1];
        if (nloc == 0u) { xcd_barrier_complete(bar, bx_, nloc, nx); b.st[0] = nloc; b.st[1] = nx; }
        const unsigned old = xb_add(&bar[XB_XSUB(bx_)], 1u);
        const unsigned gen = old / nloc;
        if (old + 1u == (gen + 1u) * nloc) {
            __builtin_amdgcn_fence(__ATOMIC_RELEASE, "agent");
            asm volatile("s_waitcnt vmcnt(0)" ::: "memory");
            const unsigned og = xb_add(&bar[XB_TOP], 1u);
            const unsigned tg = og / nx;
            if (og + 1u == (tg + 1u) * nx) xb_add(&bar[XB_TOPGEN], 1u);
            else XB_SPIN(xb_ld(&bar[XB_TOPGEN]) == tg, bar);
            __builtin_amdgcn_fence(__ATOMIC_ACQUIRE, "agent");
            xb_add(&bar[XB_XGEN(bx_)], 1u);
            asm volatile("s_waitcnt vmcnt(0)" ::: "memory");
        } else {
            XB_SPIN(xb_ld(&bar[XB_XGEN(bx_)]) == gen, bar);
            __builtin_amdgcn_fence(__ATOMIC_ACQUIRE, "agent");
            asm volatile("s_waitcnt vmcnt(0)" ::: "memory");
        }
    }
    __syncthreads();
}

struct Frame {
    LAS unsigned char* lds;
    volatile LAS unsigned* MISC;
    unsigned* ctl;
    int tid, lane, wave, G, bx;
    const float* const* in;
    float* out; unsigned char* ws;
};
enum { I_X = 0, I_C, I_CTX, I_CCTX, I_ADAW, I_ADAB, I_N1G, I_N2G, I_EVWIN, I_EVWS, I_EVBS, I_EVWOUT, I_ODWIN, I_ODQG, I_ODKG, I_ODSINK, I_ODCONV, I_ODWOUT,
       I_RW, I_RB, I_EG, I_EU, I_ED, I_SG, I_SU, I_SD };
template <class T> __device__ __forceinline__ T* wsp(const Frame& F, size_t off) { return (T*)(F.ws + off); }
__device__ __forceinline__ int cond_of(int r) { return r < NX ? (r >> 12) : 8; }
__device__ __forceinline__ const float* modp(const Frame& F, int l, int cond, int piece) { return wsp<const float>(F, WS_MOD) + ((size_t)(l * 9 + cond) * MODW + piece * DM); }

#define PHASE_FRAME(Fp, F0) Frame Fp = F0; { int l_ = lane_id_now(); asm volatile("" : "+v"(l_)); Fp.lane = l_; Fp.tid = F0.wave * 64 + l_; }
__device__ __forceinline__ void cvt_tile64(const float* srcp, size_t spitch, bf16* dst, size_t dpitch, int j0, int k0, LAS float* scr, int lane_) {
    int lane = lane_; asm volatile("" : "+v"(lane));
    const int kq = lane >> 4, c4 = lane & 15;
    const float* p = srcp ? srcp + (size_t)(k0 + kq) * spitch : nullptr;
    LAS float* w = scr + kq * 65 + 4 * c4;
#pragma unroll
    for (int it = 0; it < 16; ++it) { f32x4 v = (f32x4){0.f, 0.f, 0.f, 0.f}; if (p) { v = *(const GAS f32x4*)p; p += 4 * spitch; }
        w[0] = v.x; w[1] = v.y; w[2] = v.z; w[3] = v.w; w += 4 * 65; }
    LDS_WAIT(); asm volatile("" ::: "memory");
    const int c = lane & 7;
#pragma unroll
    for (int i = 0; i < 8; ++i) { const int r = (lane >> 3) + 8 * i; const LAS float* s = scr + (8 * c) * 65 + r;
        v4u o; o.x = pk2(s[0], s[65]); o.y = pk2(s[130], s[195]); o.z = pk2(s[260], s[325]); o.w = pk2(s[390], s[455]);
        *(GAS v4u*)(dst + (size_t)(j0 + r) * dpitch + k0 + 8 * c) = o; }
    LDS_WAIT(); asm volatile("" ::: "memory");
}
__device__ __forceinline__ void cvt_tile64_f8(const float* srcp, size_t spitch, unsigned char* dst8, size_t dpitch, int j0, int k0, LAS float* scr, int lane_, float scale) {
    int lane = lane_; asm volatile("" : "+v"(lane));
    const int kq = lane >> 4, c4 = lane & 15;
    const float* p = srcp + (size_t)(k0 + kq) * spitch;
    LAS float* w = scr + kq * 65 + 4 * c4;
#pragma unroll
    for (int it = 0; it < 16; ++it) { const f32x4 v = *(const GAS f32x4*)p; p += 4 * spitch; w[0] = v.x; w[1] = v.y; w[2] = v.z; w[3] = v.w; w += 4 * 65; }
    LDS_WAIT(); asm volatile("" ::: "memory");
    const int c = lane & 3;
#pragma unroll
    for (int i = 0; i < 4; ++i) { const int r = (lane >> 2) + 16 * i; const LAS float* s = scr + (16 * c) * 65 + r; v4u o;
#pragma unroll
        for (int q = 0; q < 4; ++q) { unsigned x = 0u;
            x = __builtin_amdgcn_cvt_pk_fp8_f32(fminf(fmaxf(s[(4 * q) * 65] * scale, -440.f), 440.f), fminf(fmaxf(s[(4 * q + 1) * 65] * scale, -440.f), 440.f), x, false);
            x = __builtin_amdgcn_cvt_pk_fp8_f32(fminf(fmaxf(s[(4 * q + 2) * 65] * scale, -440.f), 440.f), fminf(fmaxf(s[(4 * q + 3) * 65] * scale, -440.f), 440.f), x, true); o[q] = x; }
        *(GAS v4u*)(dst8 + (size_t)(j0 + r) * dpitch + k0 + 16 * c) = o; }
    LDS_WAIT(); asm volatile("" ::: "memory");
}
__device__ __forceinline__ int odin_col(int j) {
    const int U = j >> 8, cpos = j & 255, bj = cpos >> 7, wc = (cpos >> 5) & 3, fq = (cpos >> 3) & 3, n = (cpos >> 2) & 1, e = cpos & 3;
    const int d = 32 * n + 16 * bj + 4 * fq + e;
    if (U < 2) return (4 * U + wc) * 64 + d;
    if (U == 2) return wc < 2 ? 512 + wc * 64 + d : 640 + (wc - 2) * 64 + d;
    if (U < 7) { const int ch = 128 * (U - 3) + (cpos & 127); return bj ? 1792 + ch : 768 + ch; }
    return 1280 + 256 * (U - 7) + cpos;
}
constexpr int CV_EVUV = 2 * 16 * 16, CV_EVOUT = 2 * 16 * 16, CV_ODIN = 2 * 36 * 16, CV_ODOUT = 2 * 16 * 16, CV_RS = 4 * 12 * 16, CV_SHDN = 4 * 16 * 4;
constexpr int CV_TOTAL = CV_EVUV + CV_EVOUT + CV_ODIN + CV_ODOUT + CV_RS + CV_SHDN;
__device__ __forceinline__ void p0_convert_item(const Frame& F, int it, LAS float* scr) {
    const int lane = F.lane;
    if (it < CV_EVUV) { const int e = it / 256, r = it % 256, jb = r / 16, kb = r % 16;
        cvt_tile64_f8(F.in[I_EVWIN] + (size_t)e * 1024 * 1536 + jb * 64 + 4 * (lane & 15), 1536, wsp<unsigned char>(F, WS_EVUV) + (size_t)e * 1024 * 1024, 1024, jb * 64, kb * 64, scr, lane, 64.0f); return; }
    it -= CV_EVUV;
    if (it < CV_EVOUT) { const int e = it / 256, r = it % 256, jb = r / 16, kb = r % 16;
        cvt_tile64_f8(F.in[I_EVWOUT] + (size_t)e * 1024 * 1024 + jb * 64 + 4 * (lane & 15), 1024, wsp<unsigned char>(F, WS_EVOUT) + (size_t)e * 1024 * 1024, 1024, jb * 64, kb * 64, scr, lane, 64.0f); return; }
    it -= CV_EVOUT;
    if (it < CV_ODIN) { const int o = it / 576, r = it % 576, jb = r / 16, kb = r % 16;
        cvt_tile64_f8(F.in[I_ODWIN] + (size_t)o * 1024 * 2304 + odin_col(jb * 64 + 4 * (lane & 15)), 2304, wsp<unsigned char>(F, WS_ODIN) + (size_t)o * 2304 * 1024, 1024, jb * 64, kb * 64, scr, lane, 64.0f); return; }
    it -= CV_ODIN;
    if (it < CV_ODOUT) { const int o = it / 256, r = it % 256, jb = r / 16, kb = r % 16;
        cvt_tile64_f8(F.in[I_ODWOUT] + (size_t)o * 1024 * 1024 + jb * 64 + 4 * (lane & 15), 1024, wsp<unsigned char>(F, WS_ODOUT) + (size_t)o * 1024 * 1024, 1024, jb * 64, kb * 64, scr, lane, 64.0f); return; }
    it -= CV_ODOUT;
    if (it < CV_RS) { const int l = it / 192, r = it % 192, jb = r / 16, kb = r % 16; const int j = jb * 64 + 4 * (lane & 15), t = j >> 8, cpos = j & 255, bj = cpos >> 7, cc = cpos & 127;
        const float* sp;
        if (t < 2) sp = (bj ? F.in[I_SU] : F.in[I_SG]) + (size_t)l * 1024 * 256 + 128 * t + cc;
        else sp = (cpos < 64) ? F.in[I_RW] + (size_t)l * 1024 * 64 + cpos : nullptr;
        cvt_tile64(sp, t < 2 ? 256 : 64, wsp<bf16>(F, WS_RS) + (size_t)l * 768 * 1024, 1024, jb * 64, kb * 64, scr, lane); return; }
    it -= CV_RS;
    { const int l = it / 64, r = it % 64, jb = r / 4, kb = r % 4;
        cvt_tile64(F.in[I_SD] + (size_t)l * 256 * 1024 + jb * 64 + 4 * (lane & 15), 1024, wsp<bf16>(F, WS_SHDN) + (size_t)l * 1024 * 256, 256, jb * 64, kb * 64, scr, lane); }
}
constexpr int CVX_GU = 64 * 8 * 16, CVX_DN = 64 * 16 * 4, CVX_TOTAL = CVX_GU + CVX_DN;
__device__ __forceinline__ void expert_convert_item(const Frame& F, int l, int it, LAS float* scr) {
    const int lane = F.lane;
    if (it < CVX_GU) { const int e = it / 128, r = it % 128, jb = r / 16, kb = r % 16; const int j = jb * 64 + 4 * (lane & 15), t = j >> 8, bj = (j >> 7) & 1, cc = j & 127;
        const float* sp = (bj ? F.in[I_EU] : F.in[I_EG]) + ((size_t)(l * 64 + e) * 1024) * 256 + 128 * t + cc;
        cvt_tile64_f8(sp, 256, wsp<unsigned char>(F, WS_EGU) + (size_t)e * 512 * 1024, 1024, jb * 64, kb * 64, scr, lane, 64.0f); return; }
    it -= CVX_GU;
    { const int e = it / 64, r = it % 64, jb = r / 4, kb = r % 4;
        cvt_tile64_f8(F.in[I_ED] + ((size_t)(l * 64 + e) * 256) * 1024 + jb * 64 + 4 * (lane & 15), 1024, wsp<unsigned char>(F, WS_EDN) + (size_t)e * 1024 * 256, 256, jb * 64, kb * 64, scr, lane, 64.0f); }
}
__device__ __forceinline__ void expert_convert_steal(const Frame& F0, int l, int quota_chunks) {
    PHASE_FRAME(F, F0);
    LAS float* scr = (LAS float*)(F.lds + F.wave * 16640);
    unsigned* ctr = F.ctl + CW_CVQ + 64 * l;
    for (int q = 0; quota_chunks < 0 || q < quota_chunks; ++q) {
        unsigned it0 = 0; if (F.lane == 0) it0 = atomicAdd(ctr, 4u);
        it0 = (unsigned)__builtin_amdgcn_readfirstlane((int)it0);
        if (it0 >= (unsigned)CVX_TOTAL) break;
#pragma unroll 1
        for (int j = 0; j < 4; ++j) if (it0 + j < (unsigned)CVX_TOTAL) expert_convert_item(F, l, (int)(it0 + j), scr);
    }
}
__device__ __forceinline__ void p0_fold_item(const Frame& F, int it, LAS float* scr) {
    const int lane = F.lane, e = it / 256, g = (it / 64) & 3, kb = it & 63;
    LAS float* wt = scr;
    LAS float* tab = scr + 2048;
    const float* src = F.in[I_EVWIN] + (size_t)e * 1024 * 1536 + (size_t)(kb * 16) * 1536 + 1024 + 128 * g;
#pragma unroll
    for (int i = 0; i < 32; ++i) { const int idx = i * 64 + lane, kk = idx >> 7, c = idx & 127; wt[idx] = src[(size_t)kk * 1536 + c]; }
#pragma unroll
    for (int i = 0; i < 2; ++i) { const int a = i * 64 + lane; tab[a] = __builtin_amdgcn_cosf((float)a * (1.0f / 128.0f)); tab[128 + a] = __builtin_amdgcn_sinf((float)a * (1.0f / 128.0f)); }
    LDS_WAIT(); asm volatile("" ::: "memory");
    bf16* dst = wsp<bf16>(F, WS_EVF) + (size_t)e * 1024 * 1024;
#pragma unroll 1
    for (int i = 0; i < 4; ++i) {
        const int ml = lane + 64 * i, k2 = ml >> 1, cs = ml & 1;
        float acc[16];
#pragma unroll
        for (int kk = 0; kk < 16; ++kk) acc[kk] = 0.f;
#pragma unroll 2
        for (int c = 0; c < 128; c += 4) { const float t0 = tab[cs * 128 + ((c * k2) & 127)], t1 = tab[cs * 128 + (((c + 1) * k2) & 127)], t2 = tab[cs * 128 + (((c + 2) * k2) & 127)], t3 = tab[cs * 128 + (((c + 3) * k2) & 127)];
#pragma unroll
            for (int kk = 0; kk < 16; ++kk) { const f32x4 w4 = *(const LAS f32x4*)(wt + kk * 128 + c); acc[kk] += (t0 * w4.x + t1 * w4.y) + (t2 * w4.z + t3 * w4.w); } }
        v4u o;
#pragma unroll
        for (int q = 0; q < 4; ++q) o[q] = fp8x4((f32x4){acc[4 * q], acc[4 * q + 1], acc[4 * q + 2], acc[4 * q + 3]} * WF_SCALE);
        *(GAS v4u*)(wsp<unsigned char>(F, WS_EVF) + (size_t)e * 1024 * 1024 + (size_t)(g * 256 + ml) * 1024 + kb * 16) = o;
    }
    LDS_WAIT(); asm volatile("" ::: "memory");
}
__device__ __forceinline__ void p0_mod_item(const Frame& F, int it) {
    const int l = it >> 6, cg = it & 63, tid = F.tid;
    LAS float* s = (LAS float*)F.lds;
    LAS float* red = (LAS float*)F.lds + 9 * 1024;
#pragma unroll
    for (int j = 0; j < 18; ++j) { const int idx = tid + 512 * j, i = idx >> 10, k = idx & 1023; const float v = i < 8 ? F.in[I_C][i * 1024 + k] : F.in[I_CCTX][k]; s[idx] = silu_f(v); }
    __syncthreads();
    if (tid < 384) {
        const int kl = tid / 24, c4 = tid % 24;
        const float* w = F.in[I_ADAW] + (size_t)l * 1024 * MODW + (size_t)cg * 96 + c4 * 4;
        f32x4 acc[9];
#pragma unroll
        for (int i = 0; i < 9; ++i) acc[i] = (f32x4){0.f, 0.f, 0.f, 0.f};
#pragma unroll 16
        for (int st = 0; st < 64; ++st) { const int k = st * 16 + kl; const f32x4 wv = *(const GAS f32x4*)(w + (size_t)k * MODW);
#pragma unroll
            for (int i = 0; i < 9; ++i) acc[i] += wv * s[i * 1024 + k]; }
#pragma unroll
        for (int i = 0; i < 9; ++i) *(LAS f32x4*)(red + (kl * 9 + i) * 96 + c4 * 4) = acc[i];
    }
    __syncthreads();
    for (int idx = tid; idx < 9 * 96; idx += 512) { const int i = idx / 96, c = idx % 96; float v = F.in[I_ADAB][l * MODW + cg * 96 + c];
#pragma unroll
        for (int kl = 0; kl < 16; ++kl) v += red[(kl * 9 + i) * 96 + c];
        wsp<float>(F, WS_MOD)[(size_t)(l * 9 + i) * MODW + cg * 96 + c] = v; }
    __syncthreads();
}
__device__ __forceinline__ void p0_prologue(const Frame& F0) {
    PHASE_FRAME(F, F0);
    for (int it = F.bx; it < 256; it += F.G) p0_mod_item(F, it);
    LAS float* scr = (LAS float*)(F.lds + F.wave * 16640);
    const int gw = F.bx * NWAVES + F.wave, NGW = F.G * NWAVES;
    for (int it = gw; it < CV_TOTAL + 512; it += NGW) { if (it < CV_TOTAL) p0_convert_item(F, it, scr); else p0_fold_item(F, it - CV_TOTAL, scr); }
    { const float* src = F.in[I_EVWS]; bf16* dst = wsp<bf16>(F, WS_EVWS);
      for (int i = F.bx * 512 + F.tid; i < 2 * 4 * 128 * 128 / 4; i += F.G * 512) { const f32x4 v = *(const GAS f32x4*)(src + (size_t)i * 4); v2u o; o.x = pk2(v.x, v.y); o.y = pk2(v.z, v.w); *(GAS v2u*)(dst + (size_t)i * 4) = o; } }
    { unsigned char* dst = wsp<unsigned char>(F, WS_DFT);     const float alpha = 0.0013810679320049757f;
      for (int i = F.bx * 512 + F.tid; i < 2048 * 4096 / 8; i += F.G * 512) { const int k1 = i >> 9, c0 = (i & 511) * 8, cs = c0 >> 11, n0 = c0 & 2047; float v[8];
#pragma unroll
          for (int j = 0; j < 8; ++j) { const float rev = (float)((k1 * (n0 + j)) & 4095) * (1.0f / 4096.0f); v[j] = cs ? -alpha * __builtin_amdgcn_sinf(rev) : alpha * __builtin_amdgcn_cosf(rev); }
          v2u o; o.x = fp8x4((f32x4){v[0], v[1], v[2], v[3]} * DFT_SCALE); o.y = fp8x4((f32x4){v[4], v[5], v[6], v[7]} * DFT_SCALE); *(GAS v2u*)(dst + (size_t)i * 8) = o; } }
    { bf16* dst = wsp<bf16>(F, WS_DFTC); const float alpha = 0.005524271728019903f;
      for (int i = F.bx * 512 + F.tid; i < 256 * 512 / 8; i += F.G * 512) { const int k1 = i >> 6, c0 = (i & 63) * 8, cs = c0 >> 8, n0 = c0 & 255; float v[8];
#pragma unroll
          for (int j = 0; j < 8; ++j) { const float rev = (float)((k1 * (n0 + j)) & 255) * (1.0f / 256.0f); v[j] = cs ? -alpha * __builtin_amdgcn_sinf(rev) : alpha * __builtin_amdgcn_cosf(rev); }
          v4u o; o.x = pk2(v[0], v[1]); o.y = pk2(v[2], v[3]); o.z = pk2(v[4], v[5]); o.w = pk2(v[6], v[7]); *(GAS v4u*)(dst + (size_t)i * 8) = o; } }
    if (F.bx == 0) for (int i = F.tid; i < 1024; i += 512) { const int P = i >> 4, f = i & 15; const float inv = fast_exp2(-(float)f * (2.0f / 32.0f) * 13.287712379549449f);
        float rev = (float)P * inv * 0.15915494309189535f; rev -= floorf(rev);
        wsp<float>(F, WS_ROPE)[i] = __builtin_amdgcn_cosf(rev); wsp<float>(F, WS_ROPE)[1024 + i] = __builtin_amdgcn_sinf(rev); }
}
__device__ __forceinline__ void norm_phase(const Frame& F0, int l, int nrows, bool first, const float* g, int piece_shift, int piece_scale, bool w16, bool f8out) {
    PHASE_FRAME(F, F0);
    const int gw = F.bx * NWAVES + F.wave, NGW = F.G * NWAVES, lane = F.lane;
    bf16* H = wsp<bf16>(F, WS_H); const bf16* XH = wsp<const bf16>(F, WS_XH);
    const int per = (nrows + NGW - 1) / NGW, r0 = gw * per, r1 = (r0 + per < nrows) ? r0 + per : nrows;
    f32x4 MA[2][2], MB[2][2]; int pc = -1;
#pragma unroll
    for (int j = 0; j < 2; ++j)
#pragma unroll
        for (int q = 0; q < 2; ++q) { MA[j][q] = (f32x4){0.f, 0.f, 0.f, 0.f}; MB[j][q] = MA[j][q]; }
    v4u nw[2] = {(v4u){0u, 0u, 0u, 0u}, (v4u){0u, 0u, 0u, 0u}};
    if (!first && r0 < r1) { const bf16* xr = XH + (size_t)r0 * DM + 8 * lane; nw[0] = *(const GAS v4u*)xr; nw[1] = *(const GAS v4u*)(xr + 512); }
    for (int rv = r0; rv < r1; ++rv) {
        const int r = __builtin_amdgcn_readfirstlane(rv);
        f32x4 v[2][2]; float s = 0.f;
        if (first) { const float* xr = (r < NX ? F.in[I_X] + (size_t)r * DM : F.in[I_CTX] + (size_t)(r - NX) * DM) + 8 * lane;
#pragma unroll
            for (int j = 0; j < 2; ++j) { v[j][0] = *(const GAS f32x4*)(xr + 512 * j); v[j][1] = *(const GAS f32x4*)(xr + 512 * j + 4); } }
        else {
#pragma unroll
            for (int j = 0; j < 2; ++j) { const v4u w = nw[j]; v[j][0] = (f32x4){bflo(w.x), bfhi(w.x), bflo(w.y), bfhi(w.y)}; v[j][1] = (f32x4){bflo(w.z), bfhi(w.z), bflo(w.w), bfhi(w.w)}; }
            if (rv + 1 < r1) { const bf16* xn = XH + (size_t)(r + 1) * DM + 8 * lane; nw[0] = *(const GAS v4u*)xn; nw[1] = *(const GAS v4u*)(xn + 512); } }
#pragma unroll
        for (int j = 0; j < 2; ++j)
#pragma unroll
            for (int q = 0; q < 2; ++q) s += (v[j][q].x * v[j][q].x + v[j][q].y * v[j][q].y) + (v[j][q].z * v[j][q].z + v[j][q].w * v[j][q].w);
        const float rstd = 1.0f / sqrtf(wave_sum(s) * (1.0f / DM) + EPS_RMS);
        const int cond = cond_of(r);
        if (cond != pc) { pc = cond;
            const float* gp = g + 8 * lane; const float* sh = modp(F, l, cond, piece_shift) + 8 * lane; const float* sc = modp(F, l, cond, piece_scale) + 8 * lane;
#pragma unroll
            for (int j = 0; j < 2; ++j)
#pragma unroll
                for (int q = 0; q < 2; ++q) { const f32x4 gg = *(const GAS f32x4*)(gp + 512 * j + 4 * q), a = *(const GAS f32x4*)(sc + 512 * j + 4 * q); MB[j][q] = *(const GAS f32x4*)(sh + 512 * j + 4 * q); MA[j][q] = gg * (a + 1.0f); } }
        bf16* orow = H + (size_t)r * DM + 8 * lane;
#pragma unroll
        for (int j = 0; j < 2; ++j) { f32x4 y[2];
#pragma unroll
            for (int q = 0; q < 2; ++q) y[q] = v[j][q] * rstd * MA[j][q] + MB[j][q];
            v4u o; o.x = pk2(y[0].x, y[0].y); o.y = pk2(y[0].z, y[0].w); o.z = pk2(y[1].x, y[1].y); o.w = pk2(y[1].z, y[1].w); if (w16) *(GAS v4u*)(orow + 512 * j) = o;
            if (f8out) { v2u o8; o8.x = fp8x4(y[0] * H8_SCALE); o8.y = fp8x4(y[1] * H8_SCALE); *(GAS v2u*)(wsp<unsigned char>(F, WS_H8) + (size_t)r * DM + 8 * lane + 512 * j) = o8; } }
    }
}

__device__ __forceinline__ void topk_rows(const Frame& F0, int l, int r0) {
    PHASE_FRAME(F, F0);
    volatile LAS unsigned* hist = F.MISC + 64; volatile LAS unsigned* base = F.MISC + 128;
    const int tid = F.tid;
    if (tid < 64) hist[tid] = 0u;
    __syncthreads();
    int ex[TOPK]; float gt[TOPK]; unsigned lp[TOPK];
    float lv[TOPK], ls[TOPK]; int li[TOPK];
    { const int half = tid >> 8, tok = tid & 255;
        const float* lg = wsp<const float>(F, WS_LOG) + (size_t)(r0 + tok) * 64 + 32 * half;
        const float* rb = F.in[I_RB] + l * 64 + 32 * half;
        float sc[32], bs[32];
#pragma unroll
        for (int q = 0; q < 8; ++q) { const f32x4 v = *(const GAS f32x4*)(lg + 4 * q); const f32x4 b = *(const GAS f32x4*)(rb + 4 * q);
            sc[4 * q + 0] = sigmoid_f(v.x); sc[4 * q + 1] = sigmoid_f(v.y); sc[4 * q + 2] = sigmoid_f(v.z); sc[4 * q + 3] = sigmoid_f(v.w);
            bs[4 * q + 0] = sc[4 * q + 0] + b.x; bs[4 * q + 1] = sc[4 * q + 1] + b.y; bs[4 * q + 2] = sc[4 * q + 2] + b.z; bs[4 * q + 3] = sc[4 * q + 3] + b.w; }
#pragma unroll
        for (int k = 0; k < TOPK; ++k) {
            float best = -3.0e38f; int bi = 0; float bsc = 0.f;
#pragma unroll
            for (int e = 0; e < 32; ++e) { const bool tk = bs[e] > best; best = tk ? bs[e] : best; bi = tk ? e : bi; bsc = tk ? sc[e] : bsc; }
#pragma unroll
            for (int e = 0; e < 32; ++e) bs[e] = (e == bi) ? -3.0e38f : bs[e];
            lv[k] = best; ls[k] = bsc; li[k] = bi + 32 * half;
        }
        LAS float* xch = (LAS float*)F.lds;
        if (half == 1) {
#pragma unroll
            for (int k = 0; k < TOPK; ++k) { xch[tok * 18 + k] = lv[k]; xch[tok * 18 + 6 + k] = ls[k]; xch[tok * 18 + 12 + k] = __builtin_bit_cast(float, li[k]); } }
    }
    __syncthreads();
    if (tid < 256) {
        const LAS float* xch = (const LAS float*)F.lds + tid * 18;
        float bv[TOPK], bsv_[TOPK]; int bix[TOPK];
#pragma unroll
        for (int k = 0; k < TOPK; ++k) { bv[k] = xch[k]; bsv_[k] = xch[6 + k]; bix[k] = __builtin_bit_cast(int, xch[12 + k]); }
        float gsum = 0.f; int ia = 0, ib = 0;
#pragma unroll
        for (int k = 0; k < TOPK; ++k) {
            float av = -3.0e38f, as_ = 0.f, bvv = -3.0e38f, bss = 0.f; int ai = 0, bi2 = 0;
#pragma unroll
            for (int q = 0; q < TOPK; ++q) { if (q == ia) { av = lv[q]; as_ = ls[q]; ai = li[q]; } if (q == ib) { bvv = bv[q]; bss = bsv_[q]; bi2 = bix[q]; } }
            const bool ta = av >= bvv;
            ex[k] = ta ? ai : bi2; gt[k] = ta ? as_ : bss; gsum += gt[k]; ia += ta ? 1 : 0; ib += ta ? 0 : 1;
        }
        const float inv = 2.5f / (gsum + 1e-20f);
#pragma unroll
        for (int k = 0; k < TOPK; ++k) { gt[k] *= inv; lp[k] = atomicAdd((unsigned*)(hist + ex[k]), 1u); }
    }
    __syncthreads();
    if (tid < 64) { const unsigned c = hist[tid]; base[tid] = c ? atomicAdd(F.ctl + CW_CNT + l * 64 + tid, c) : 0u; }
    __syncthreads();
    if (tid < 256) {
        int* rtok = wsp<int>(F, WS_RTOK); float* rgate = wsp<float>(F, WS_RGATE);
#pragma unroll
        for (int k = 0; k < TOPK; ++k) { const size_t p = (size_t)ex[k] * ECAP + base[ex[k]] + lp[k]; rtok[p] = (r0 + tid) * 8 + k; rgate[p] = gt[k]; }
    }
    __syncthreads();
}

__device__ __forceinline__ void conv_phase(const Frame& F0, int o, int nrows) {
    PHASE_FRAME(F, F0);
    const bf16* GZ = wsp<const bf16>(F, WS_PROJ + PJ_GZ); const bf16* GO = wsp<const bf16>(F, WS_PROJ + PJ_GO); bf16* MIX = wsp<bf16>(F, WS_MIX);
    const float* cw = F.in[I_ODCONV] + (size_t)o * 3 * 512;
    const int total = nrows * 64;
    for (int i = F.bx * 512 + F.tid; i < total; i += F.G * 512) {
        const int r = i >> 6, c0 = (i & 63) * 8;
        const int pos = r < NX ? (r & (SEQ - 1)) : ((r - NX) & (LCTX - 1)), L = r < NX ? SEQ : LCTX;
        const v4u z1 = *(const GAS v4u*)(GZ + (size_t)r * 512 + c0);
        v4u z0 = (v4u){0u, 0u, 0u, 0u}, z2 = (v4u){0u, 0u, 0u, 0u};
        if (pos > 0) z0 = *(const GAS v4u*)(GZ + (size_t)(r - 1) * 512 + c0);
        if (pos < L - 1) z2 = *(const GAS v4u*)(GZ + (size_t)(r + 1) * 512 + c0);
        const v4u go = *(const GAS v4u*)(GO + (size_t)r * 512 + c0);
        const f32x4 w0a = *(const GAS f32x4*)(cw + c0), w0b = *(const GAS f32x4*)(cw + c0 + 4);
        const f32x4 w1a = *(const GAS f32x4*)(cw + 512 + c0), w1b = *(const GAS f32x4*)(cw + 512 + c0 + 4);
        const f32x4 w2a = *(const GAS f32x4*)(cw + 1024 + c0), w2b = *(const GAS f32x4*)(cw + 1024 + c0 + 4);
        float y[8];
#pragma unroll
        for (int q = 0; q < 4; ++q) {
            const float wl0 = q < 2 ? w0a[2 * q] : w0b[2 * q - 4], wh0 = q < 2 ? w0a[2 * q + 1] : w0b[2 * q - 3];
            const float wl1 = q < 2 ? w1a[2 * q] : w1b[2 * q - 4], wh1 = q < 2 ? w1a[2 * q + 1] : w1b[2 * q - 3];
            const float wl2 = q < 2 ? w2a[2 * q] : w2b[2 * q - 4], wh2 = q < 2 ? w2a[2 * q + 1] : w2b[2 * q - 3];
            y[2 * q] = bflo(go[q]) * (wl0 * bflo(z0[q]) + wl1 * bflo(z1[q]) + wl2 * bflo(z2[q]));
            y[2 * q + 1] = bfhi(go[q]) * (wh0 * bfhi(z0[q]) + wh1 * bfhi(z1[q]) + wh2 * bfhi(z2[q]));
        }
        v2u ov; ov.x = mix8x4(y[0], y[1], y[2], y[3]); ov.y = mix8x4(y[4], y[5], y[6], y[7]);
        *(GAS v2u*)((unsigned char*)MIX + (size_t)r * DM + 512 + c0) = ov;
    }
}

__device__ __forceinline__ void gmlp_phase(const Frame& F0, int e, int nchunks) {
    PHASE_FRAME(F, F0);
    const bf16* UV = wsp<const bf16>(F, WS_PROJ + PJ_UV); bf16* MIX = wsp<bf16>(F, WS_MIX);
    const bf16* WSB = wsp<const bf16>(F, WS_EVWS) + (size_t)e * 4 * 128 * 128;
    const float* bsv = F.in[I_EVBS] + (size_t)e * 4 * 128;
    LAS bf16* VT = (LAS bf16*)F.lds;
    const int lane = F.lane, w = F.wave, fr = lane & 15, fq = lane >> 4;
    const bool bal = (F.G == 256 && nchunks * 4 == 1088);
    const int it0 = !bal ? F.bx : F.bx < 128 ? 5 * F.bx : F.bx < 240 ? 640 + 4 * (F.bx - 128) : 1088;
    const int itn = !bal ? nchunks * 4 : it0 + (F.bx < 128 ? 5 : F.bx < 240 ? 4 : 0), its = bal ? 1 : F.G;
    for (int it = it0; it < itn; it += its) {
        const int ch = it >> 2, g = it & 3, t0 = ch * 128;
        const int p = 16 * w + fr; const float bb = bsv[g * 128 + p]; v2u ug[8];
#pragma unroll
        for (int nt = 0; nt < 8; ++nt) ug[nt] = *(const GAS v2u*)(UV + (size_t)(t0 + p) * DM + 128 * g + 16 * nt + 4 * fq);
        { const int rs_ = lane >> 4, cl = lane & 15;
#pragma unroll
          for (int ps = 0; ps < 4; ++ps) { const int q = 16 * w + 4 * ps + rs_;
            const v4u pv = *(const GAS v4u*)(UV + (size_t)(t0 + q) * DM + 512 + 128 * g + 8 * cl);
            float x[8] = {bflo(pv.x), bfhi(pv.x), bflo(pv.y), bfhi(pv.y), bflo(pv.z), bfhi(pv.z), bflo(pv.w), bfhi(pv.w)};
            float s = ((x[0] + x[1]) + (x[2] + x[3])) + ((x[4] + x[5]) + (x[6] + x[7]));
            s += swz_xor<1>(s); s += swz_xor<2>(s); s += swz_xor<4>(s); s += swz_xor<8>(s);
            const float mu = s * (1.0f / 128.0f); float v2 = 0.f;
#pragma unroll
            for (int e = 0; e < 8; ++e) { x[e] -= mu; v2 += x[e] * x[e]; }
            v2 += swz_xor<1>(v2); v2 += swz_xor<2>(v2); v2 += swz_xor<4>(v2); v2 += swz_xor<8>(v2);
            const float rstd = 1.0f / sqrtf(v2 * (1.0f / 128.0f) + 1e-5f);
#pragma unroll
            for (int e = 0; e < 8; ++e) VT[(8 * cl + e) * 136 + q] = (bf16)f2bf(x[e] * rstd); } }
        __syncthreads();
        f32x4 acc[8];
#pragma unroll
        for (int nt = 0; nt < 8; ++nt) acc[nt] = (f32x4){0.f, 0.f, 0.f, 0.f};
        bf16x8 wf[4];
#pragma unroll
        for (int s = 0; s < 4; ++s) wf[s] = *(const GAS bf16x8*)(WSB + (size_t)(g * 128 + 16 * w + fr) * 128 + 32 * s + 8 * fq);
#pragma unroll
        for (int nt = 0; nt < 8; ++nt)
#pragma unroll
            for (int s = 0; s < 4; ++s) { const bf16x8 vf = *(const LAS bf16x8*)(VT + (16 * nt + fr) * 136 + 32 * s + 8 * fq);
                acc[nt] = __builtin_amdgcn_mfma_f32_16x16x32_f16(__builtin_bit_cast(pg8::h16x8, vf), __builtin_bit_cast(pg8::h16x8, wf[s]), acc[nt], 0, 0, 0); }
#pragma unroll
        for (int nt = 0; nt < 8; ++nt) { const size_t off = (size_t)(t0 + p) * DM + 128 * g + 16 * nt + 4 * fq; const v2u uu = ug[nt];
            *(GAS unsigned*)((unsigned char*)MIX + off) = mix8x4(bflo(uu.x) * (acc[nt][0] + bb), bfhi(uu.x) * (acc[nt][1] + bb), bflo(uu.y) * (acc[nt][2] + bb), bfhi(uu.y) * (acc[nt][3] + bb)); }
        __syncthreads();
    }
}
__device__ __forceinline__ void fourier_nyq_phase(const Frame& F0, int e) {
    PHASE_FRAME(F, F0);
    const unsigned char* WF = wsp<const unsigned char>(F, WS_EVF) + (size_t)e * 1024 * 1024; const unsigned char* H = wsp<const unsigned char>(F, WS_H8); float* NY = wsp<float>(F, WS_PROJ + PJ_NY);
    const int gw = F.bx * NWAVES + F.wave, NGW = F.G * NWAVES;
    for (int it = gw; it < 8 * 512; it += NGW) { const int b = it >> 9, n = it & 511;
        const v4u wv = *(const GAS v4u*)(WF + (size_t)(2 * n) * 1024 + 16 * F.lane), hv = *(const GAS v4u*)(H + (size_t)(b * SEQ + 2048) * DM + 16 * F.lane); float a = 0.f;
#pragma unroll
        for (int q = 0; q < 4; ++q) { const f32x2 w0 = __builtin_amdgcn_cvt_pk_f32_fp8((int)wv[q], false), w1 = __builtin_amdgcn_cvt_pk_f32_fp8((int)wv[q], true), h0 = __builtin_amdgcn_cvt_pk_f32_fp8((int)hv[q], false), h1 = __builtin_amdgcn_cvt_pk_f32_fp8((int)hv[q], true);
            a += (w0.x * h0.x + w0.y * h0.y) + (w1.x * h1.x + w1.y * h1.y); }
        a = wave_sum(a) * FO_INV;
        if (F.lane == 0) NY[it] = a; }
}
__device__ __forceinline__ void fourier_combine_phase(const Frame& F0) {
    PHASE_FRAME(F, F0);
    const bf16* PQ = wsp<const bf16>(F, WS_PROJ + PJ_PQ); bf16* MIX = wsp<bf16>(F, WS_MIX); const bf16* FO = wsp<const bf16>(F, WS_PROJ + PJ_GT); const float* NY = wsp<const float>(F, WS_PROJ + PJ_NY);
    const float alpha = 0.0013810679320049757f;
    const int NIT = 8 * 2048 * 64, STR = F.G * 512;
    for (int i0 = F.bx * 512 + F.tid; i0 < NIT; i0 += 4 * STR) {
        v4u pp[4], qq[4];
#pragma unroll
        for (int jj = 0; jj < 4; ++jj) { const int i = i0 + jj * STR; pp[jj] = (v4u){0u, 0u, 0u, 0u}; qq[jj] = pp[jj];
            if (i < NIT) { const int c8 = (i & 63) * 8, k1 = (i >> 6) & 2047, b = i >> 17;
                pp[jj] = *(const GAS v4u*)(PQ + ((size_t)(b * 2 + 0) * 2048 + k1) * 512 + c8); qq[jj] = *(const GAS v4u*)(PQ + ((size_t)(b * 2 + 1) * 2048 + k1) * 512 + c8); } }
        asm volatile("" ::: "memory");
#pragma unroll
        for (int jj = 0; jj < 4; ++jj) { const int i = i0 + jj * STR; if (i < NIT) { const int c8 = (i & 63) * 8, k1 = (i >> 6) & 2047, b = i >> 17; const v4u p = pp[jj], q = qq[jj];
        const float sg = (k1 & 1) ? -alpha : alpha; const f32x4 n0 = *(const GAS f32x4*)(NY + b * 512 + c8) * sg, n1 = *(const GAS f32x4*)(NY + b * 512 + c8 + 4) * sg;
        const float nyv[8] = {n0.x, n0.y, n0.z, n0.w, n1.x, n1.y, n1.z, n1.w};
        float sv[8], dv[8];
#pragma unroll
        for (int w = 0; w < 4; ++w) { const float pl = bflo(p[w]) + nyv[2 * w], ph = bfhi(p[w]) + nyv[2 * w + 1], ql = bflo(q[w]), qh = bfhi(q[w]); sv[2 * w] = pl + ql; sv[2 * w + 1] = ph + qh; dv[2 * w] = pl - ql; dv[2 * w + 1] = ph - qh; }
        v2u s, d; s.x = mix8x4(sv[0], sv[1], sv[2], sv[3]); s.y = mix8x4(sv[4], sv[5], sv[6], sv[7]); d.x = mix8x4(dv[0], dv[1], dv[2], dv[3]); d.y = mix8x4(dv[4], dv[5], dv[6], dv[7]);
        *(GAS v2u*)((unsigned char*)MIX + (size_t)(b * SEQ + k1) * DM + 512 + c8) = s;
        if (k1 > 0) *(GAS v2u*)((unsigned char*)MIX + (size_t)(b * SEQ + SEQ - k1) * DM + 512 + c8) = d; } }
    }
    const int gw = F.bx * NWAVES + F.wave, NGW = F.G * NWAVES;
    for (int it = gw; it < 8 * 512; it += NGW) { const int b = it >> 9, n = it & 511;
        const unsigned char* g = (const unsigned char*)FO + (size_t)(b * 512 + n) * 4096; float a = 0.f;
#pragma unroll
        for (int j = 0; j < 2; ++j) { const v4u v = *(const GAS v4u*)(g + (size_t)(j * 64 + F.lane) * 16);
#pragma unroll
            for (int w = 0; w < 4; ++w) { const f32x2 x0 = __builtin_amdgcn_cvt_pk_f32_fp8((int)v[w], false), x1 = __builtin_amdgcn_cvt_pk_f32_fp8((int)v[w], true); a += (x0.x - x0.y) + (x1.x - x1.y); } }
        a *= 1.0f / FO_SCALE;
        a = (wave_sum(a) + NY[it]) * alpha;
        if (F.lane == 0) ((unsigned char*)MIX)[(size_t)(b * SEQ + 2048) * DM + 512 + n] = (unsigned char)(mix8x4(a, 0.f, 0.f, 0.f) & 0xffu); }
}
__device__ __forceinline__ void attn_phase_frag(const Frame& F0, int o, bool ctx_queries) {
    PHASE_FRAME(F, F0);
    const bf16* Q = wsp<const bf16>(F, WS_PROJ + PJ_Q); const bf16* KB = wsp<const bf16>(F, WS_PROJ + PJ_KV);
    const bf16* VT = wsp<const bf16>(F, WS_PROJ + PJ_VT); const bf16* VTC = wsp<const bf16>(F, WS_PROJ + PJ_VTC);
    bf16* MIX = wsp<bf16>(F, WS_MIX);
    const int lane = F.lane, w = F.wave, r = lane & 31, hh = lane >> 5, g = w >> 1, half = w & 1;
    const int nunits = 512 + (ctx_queries ? 32 : 0);
    for (int u = F.bx; u < nunits; u += F.G) {
        int b, blk, hk, qrow0, qp0, nband, kt_lo;
        if (u < 512) { b = u >> 6; blk = (u >> 1) & 31; hk = u & 1; qp0 = blk * 128 + 64 * half; qrow0 = b * SEQ + qp0;
            kt_lo = qp0 >= 128 ? (qp0 - 128) >> 5 : 0; int kt_hi = ((qp0 + 191) >> 5) + 1; kt_hi = kt_hi > 128 ? 128 : kt_hi; nband = kt_hi - kt_lo; }
        else { const int v = u - 512; b = v >> 2; blk = (v >> 1) & 1; hk = v & 1; qp0 = 0; qrow0 = NX + b * LCTX + blk * 128 + 64 * half; nband = 0; kt_lo = 0; }
        const int h = hk * 4 + g;
        bf16x8 qf[2][4];
#pragma unroll
        for (int qg = 0; qg < 2; ++qg)
#pragma unroll
            for (int s = 0; s < 4; ++s) qf[qg][s] = *(const GAS bf16x8*)(Q + (size_t)(qrow0 + 32 * qg + r) * 512 + h * 64 + 16 * s + 8 * hh);
        const float sink2 = F.in[I_ODSINK][o * 8 + h] * LOG2E;
        float m[2] = {sink2, sink2}, lsum[2] = {hh == 0 ? 1.0f : 0.0f, hh == 0 ? 1.0f : 0.0f};
        f32x16 oacc[2][2];
#pragma unroll
        for (int qg = 0; qg < 2; ++qg)
#pragma unroll
            for (int dh = 0; dh < 2; ++dh)
#pragma unroll
                for (int i = 0; i < 16; ++i) oacc[qg][dh][i] = 0.f;
        const int ntiles = nband + 8;
#pragma unroll 1
        for (int ti = 0; ti < ntiles; ++ti) {
            const bool band = ti < nband;
            const int kpos0 = band ? (kt_lo + ti) * 32 : 0;
            const int krow = band ? b * SEQ + kpos0 : NX + b * LCTX + (ti - nband) * 32;
            const bf16* vbase = band ? VT + (size_t)((b * 2 + hk) * 64) * SEQ + kpos0 : VTC + (size_t)((b * 2 + hk) * 64) * LCTX + (ti - nband) * 32;
            const int vpitch = band ? SEQ : LCTX;
            f32x16 sacc[2];
#pragma unroll
            for (int qg = 0; qg < 2; ++qg)
#pragma unroll
                for (int i = 0; i < 16; ++i) sacc[qg][i] = 0.f;
#pragma unroll
            for (int s = 0; s < 4; ++s) { const bf16x8 kf = *(const GAS bf16x8*)(KB + (size_t)(krow + r) * 128 + hk * 64 + 16 * s + 8 * hh);
                sacc[0] = __builtin_amdgcn_mfma_f32_32x32x16_f16(__builtin_bit_cast(pg8::h16x8, kf), __builtin_bit_cast(pg8::h16x8, qf[0][s]), sacc[0], 0, 0, 0);
                sacc[1] = __builtin_amdgcn_mfma_f32_32x32x16_f16(__builtin_bit_cast(pg8::h16x8, kf), __builtin_bit_cast(pg8::h16x8, qf[1][s]), sacc[1], 0, 0, 0); }
            bf16x8 vf[2][2];
#pragma unroll
            for (int dh = 0; dh < 2; ++dh)
#pragma unroll
                for (int s2 = 0; s2 < 2; ++s2) { const bf16* vp = vbase + (size_t)(32 * dh + r) * vpitch + 16 * s2 + 4 * hh;
                    const s16x4 lo = *(const GAS s16x4*)vp, hi = *(const GAS s16x4*)(vp + 8);
                    vf[dh][s2] = (bf16x8){lo[0], lo[1], lo[2], lo[3], hi[0], hi[1], hi[2], hi[3]}; }
#pragma unroll
            for (int qg = 0; qg < 2; ++qg) {
                if (band && (kpos0 < qp0 - 65 || kpos0 > qp0 + 97)) { const int qpos = qp0 + 32 * qg + r;
#pragma unroll
                    for (int i = 0; i < 16; ++i) { const int kpos = kpos0 + (i & 3) + 8 * (i >> 2) + 4 * hh; const int dlt = kpos - qpos; sacc[qg][i] = (dlt > 128 || dlt < -128) ? -1.0e30f : sacc[qg][i]; } }
                float tm = sacc[qg][0];
#pragma unroll
                for (int i = 1; i < 16; ++i) tm = fmaxf(tm, sacc[qg][i]);
                tm = x32_max(tm);
                const float mn = fmaxf(m[qg], tm), alpha = fast_exp2(m[qg] - mn); const bool same = __all(mn == m[qg]); m[qg] = mn;
                float ps = 0.f; float p[16];
#pragma unroll
                for (int i = 0; i < 16; ++i) { p[i] = fast_exp2(sacc[qg][i] - mn); ps += p[i]; }
                lsum[qg] = lsum[qg] * alpha + ps;
                if (!same) {
#pragma unroll
                for (int dh = 0; dh < 2; ++dh)
#pragma unroll
                    for (int i = 0; i < 16; ++i) oacc[qg][dh][i] *= alpha; }
#pragma unroll
                for (int s2 = 0; s2 < 2; ++s2) {
                    unsigned pw[4];
#pragma unroll
                    for (int j = 0; j < 4; ++j) pw[j] = pk2(p[8 * s2 + 2 * j], p[8 * s2 + 2 * j + 1]);
                    const v4u pv4 = (v4u){pw[0], pw[1], pw[2], pw[3]}; const bf16x8 pf = __builtin_bit_cast(bf16x8, pv4);
                    oacc[qg][0] = __builtin_amdgcn_mfma_f32_32x32x16_f16(__builtin_bit_cast(pg8::h16x8, vf[0][s2]), __builtin_bit_cast(pg8::h16x8, pf), oacc[qg][0], 0, 0, 0);
                    oacc[qg][1] = __builtin_amdgcn_mfma_f32_32x32x16_f16(__builtin_bit_cast(pg8::h16x8, vf[1][s2]), __builtin_bit_cast(pg8::h16x8, pf), oacc[qg][1], 0, 0, 0);
                }
            }
        }
#pragma unroll
        for (int qg = 0; qg < 2; ++qg) {
            const float lt = x32_sum(lsum[qg]), inv = 1.0f / lt;
            bf16* orow = MIX + (size_t)(qrow0 + 32 * qg + r) * DM + h * 64;
#pragma unroll
            for (int dh = 0; dh < 2; ++dh)
#pragma unroll
                for (int t = 0; t < 4; ++t) { v2u ov; ov.x = pk2(oacc[qg][dh][4 * t] * inv, oacc[qg][dh][4 * t + 1] * inv); ov.y = pk2(oacc[qg][dh][4 * t + 2] * inv, oacc[qg][dh][4 * t + 3] * inv);
                    *(GAS v2u*)(orow + 32 * dh + 8 * t + 4 * hh) = ov; }
        }
    }
}
__device__ __forceinline__ float wave_max(float v) { v = fmaxf(v, swz_xor<1>(v)); v = fmaxf(v, swz_xor<2>(v)); v = fmaxf(v, swz_xor<4>(v)); v = fmaxf(v, swz_xor<8>(v)); v = fmaxf(v, swz_xor<16>(v)); return x32_max(v); }
__device__ __forceinline__ void attn_phase_naive(const Frame& F0, int o, bool ctx_queries) {
    PHASE_FRAME(F, F0);
    const bf16* Q = wsp<const bf16>(F, WS_PROJ + PJ_Q); const bf16* KB = wsp<const bf16>(F, WS_PROJ + PJ_KV);
    const bf16* VT = wsp<const bf16>(F, WS_PROJ + PJ_VT); const bf16* VTC = wsp<const bf16>(F, WS_PROJ + PJ_VTC);
    bf16* MIX = wsp<bf16>(F, WS_MIX);
    const int lane = F.lane;
    LAS float* pbuf = (LAS float*)F.lds + F.wave * 1024;
    LAS float* qbuf = pbuf + 768;
    const int gw = F.bx * NWAVES + F.wave, NGW = F.G * NWAVES;
    const int nq = (NX + (ctx_queries ? NC : 0)) * 8;
    for (int itv = gw; itv < nq; itv += NGW) {
        const int it = __builtin_amdgcn_readfirstlane(itv);
        const int row = it >> 3, h = it & 7, hk = h >> 2; const bool isx = row < NX;
        const int b = isx ? (row >> 12) : ((row - NX) >> 8), pos = row & 4095;
        int k0 = 0, nb = 0;
        if (isx) { k0 = pos >= 128 ? pos - 128 : 0; const int k1 = pos + 128 > 4095 ? 4095 : pos + 128; nb = k1 - k0 + 1; }
        const int total = nb + 256;
        qbuf[lane] = bf2f(Q[(size_t)row * 512 + h * 64 + lane]);
        LDS_WAIT(); asm volatile("" ::: "memory");
        const float sink2 = F.in[I_ODSINK][o * 8 + h] * LOG2E;
        float mx = sink2;
        for (int j = lane; j < total; j += 64) { const int krow = j < nb ? b * SEQ + k0 + j : NX + b * LCTX + (j - nb);
            const bf16* kp = KB + (size_t)krow * 128 + hk * 64; float s = 0.f;
#pragma unroll 8
            for (int d = 0; d < 64; ++d) s += qbuf[d] * bf2f(kp[d]);
            pbuf[j] = s; mx = fmaxf(mx, s); }
        mx = wave_max(mx);
        float ps = 0.f;
        for (int j = lane; j < total; j += 64) { const float p = fast_exp2(pbuf[j] - mx); pbuf[j] = p; ps += p; }
        const float den = wave_sum(ps) + fast_exp2(sink2 - mx);
        LDS_WAIT(); asm volatile("" ::: "memory");
        float ov = 0.f;
        const bf16* vb = VT + (size_t)((b * 2 + hk) * 64 + lane) * SEQ + k0; const bf16* vc = VTC + (size_t)((b * 2 + hk) * 64 + lane) * LCTX;
        for (int j = 0; j < nb; ++j) ov += pbuf[j] * bf2f(vb[j]);
        for (int j = 0; j < 256; ++j) ov += pbuf[nb + j] * bf2f(vc[j]);
        MIX[(size_t)row * DM + h * 64 + lane] = (bf16)f2bf(ov / den);
        LDS_WAIT(); asm volatile("" ::: "memory");
    }
}

__device__ __forceinline__ void attn_phase(const Frame& F0, int o, bool ctx_queries) {
    PHASE_FRAME(F, F0);
    const bf16* Q = wsp<const bf16>(F, WS_PROJ + PJ_Q); const bf16* KB = wsp<const bf16>(F, WS_PROJ + PJ_KV);
    const bf16* VT = wsp<const bf16>(F, WS_PROJ + PJ_VT); const bf16* VTC = wsp<const bf16>(F, WS_PROJ + PJ_VTC);
    bf16* MIX = wsp<bf16>(F, WS_MIX);
    const int lane = F.lane, w = F.wave, tid = F.tid, r = lane & 31, hh = lane >> 5, g = w >> 1, half = w & 1;
    const int nunits = 512 + (ctx_queries ? 32 : 0);
    float gq_ = fabsf(F.in[I_ODQG][o * 64 + lane]), gk_ = fabsf(F.in[I_ODKG][o * 64 + lane]);
    gq_ = fmaxf(gq_, swz_xor<1>(gq_)); gq_ = fmaxf(gq_, swz_xor<2>(gq_)); gq_ = fmaxf(gq_, swz_xor<4>(gq_)); gq_ = fmaxf(gq_, swz_xor<8>(gq_)); gq_ = fmaxf(gq_, swz_xor<16>(gq_)); gq_ = x32_max(gq_);
    gk_ = fmaxf(gk_, swz_xor<1>(gk_)); gk_ = fmaxf(gk_, swz_xor<2>(gk_)); gk_ = fmaxf(gk_, swz_xor<4>(gk_)); gk_ = fmaxf(gk_, swz_xor<8>(gk_)); gk_ = fmaxf(gk_, swz_xor<16>(gk_)); gk_ = x32_max(gk_);
    const float M0 = fmaxf(0.0f, 8.0f * LOG2E * gq_ * gk_ - 14.0f);
    const bool ldk = tid < 256; const int lt = ldk ? tid : tid - 256;
    for (int u = F.bx; u < nunits; u += F.G) {
        int b, blk, hk, qrow0, qp0, nband, kt_lo;
        if (u < 512) { b = u >> 6; blk = (u >> 1) & 31; hk = u & 1; qp0 = blk * 128 + 64 * half; qrow0 = b * SEQ + qp0;
            kt_lo = blk >= 1 ? blk * 4 - 4 : 0; int kt_hi = blk * 4 + 8; kt_hi = kt_hi > 128 ? 128 : kt_hi; nband = kt_hi - kt_lo; }
        else { const int v = u - 512; b = v >> 2; blk = (v >> 1) & 1; hk = v & 1; qp0 = 0; qrow0 = NX + b * LCTX + blk * 128 + 64 * half; nband = 0; kt_lo = 0; }
        const int h = hk * 4 + g;
        bf16x8 qf[2][4];
#pragma unroll
        for (int qg = 0; qg < 2; ++qg)
#pragma unroll
            for (int s = 0; s < 4; ++s) qf[qg][s] = *(const GAS bf16x8*)(Q + (size_t)(qrow0 + 32 * qg + r) * 512 + h * 64 + 16 * s + 8 * hh);
        const float sink2 = F.in[I_ODSINK][o * 8 + h] * LOG2E;
        const float sk_ = hh == 0 ? fast_exp2(sink2 - M0) : 0.0f; float lsum[2] = {sk_, sk_};
        f32x16 oacc[2][2];
#pragma unroll
        for (int qg = 0; qg < 2; ++qg)
#pragma unroll
            for (int dh = 0; dh < 2; ++dh)
#pragma unroll
                for (int i = 0; i < 16; ++i) oacc[qg][dh][i] = 0.f;
        const int ntiles = nband + 8;
#define ATT_SRC(ti_) ((ti_) < nband ? (ldk ? KB + (size_t)(b * SEQ + (kt_lo + (ti_)) * 32 + (lt >> 3)) * 128 + hk * 64 + 8 * (lt & 7) \
                                            : VT + (size_t)((b * 2 + hk) * 64 + (lt >> 2)) * SEQ + (kt_lo + (ti_)) * 32 + 8 * (lt & 3)) \
                                    : (ldk ? KB + (size_t)(NX + b * LCTX + ((ti_) - nband) * 32 + (lt >> 3)) * 128 + hk * 64 + 8 * (lt & 7) \
                                            : VTC + (size_t)((b * 2 + hk) * 64 + (lt >> 2)) * LCTX + ((ti_) - nband) * 32 + 8 * (lt & 3)))
        const int ldst = ldk ? (lt >> 3) * 144 + (lt & 7) * 16 : 4608 + (lt >> 2) * 80 + (lt & 3) * 16;
        __syncthreads();
        { const v4u pc = *(const GAS v4u*)ATT_SRC(0); *(LAS v4u*)(F.lds + ldst) = pc; }
        v4u nx = (v4u){0u, 0u, 0u, 0u}; if (ntiles > 1) nx = *(const GAS v4u*)ATT_SRC(1);
        __syncthreads();
#pragma unroll 1
        for (int ti = 0; ti < ntiles; ++ti) {
            const bool band = ti < nband;
            const int kpos0 = band ? (kt_lo + ti) * 32 : 0;
            v4u nx2 = (v4u){0u, 0u, 0u, 0u}; const bool more = ti + 1 < ntiles;
            if (ti + 2 < ntiles) nx2 = *(const GAS v4u*)ATT_SRC(ti + 2);
            const LAS unsigned char* set = F.lds + (ti & 1) * 10240;
            const bool mine = !band || (kpos0 + 31 >= qp0 - 128 && kpos0 <= qp0 + 191);
            if (mine) {
                f32x16 sacc[2];
#pragma unroll
                for (int qg = 0; qg < 2; ++qg)
#pragma unroll
                    for (int i = 0; i < 16; ++i) sacc[qg][i] = -M0;
#pragma unroll
                for (int s = 0; s < 4; ++s) { const bf16x8 kf = *(const LAS bf16x8*)(set + r * 144 + (16 * s + 8 * hh) * 2);
                    sacc[0] = __builtin_amdgcn_mfma_f32_32x32x16_f16(__builtin_bit_cast(pg8::h16x8, kf), __builtin_bit_cast(pg8::h16x8, qf[0][s]), sacc[0], 0, 0, 0);
                    sacc[1] = __builtin_amdgcn_mfma_f32_32x32x16_f16(__builtin_bit_cast(pg8::h16x8, kf), __builtin_bit_cast(pg8::h16x8, qf[1][s]), sacc[1], 0, 0, 0); }
                bf16x8 vf[2][2];
#pragma unroll
                for (int dh = 0; dh < 2; ++dh)
#pragma unroll
                    for (int s2 = 0; s2 < 2; ++s2) { const LAS unsigned char* vp = set + 4608 + (32 * dh + r) * 80 + (16 * s2 + 4 * hh) * 2;
                        const s16x4 lo = *(const LAS s16x4*)vp, hi = *(const LAS s16x4*)(vp + 16);
                        vf[dh][s2] = (bf16x8){lo[0], lo[1], lo[2], lo[3], hi[0], hi[1], hi[2], hi[3]}; }
#pragma unroll
                for (int qg = 0; qg < 2; ++qg) {
                    if (band && (kpos0 < qp0 - 65 || kpos0 > qp0 + 97)) { const int qpos = qp0 + 32 * qg + r;
#pragma unroll
                        for (int i = 0; i < 16; ++i) { const int kpos = kpos0 + (i & 3) + 8 * (i >> 2) + 4 * hh; const int dlt = kpos - qpos; sacc[qg][i] = (dlt > 128 || dlt < -128) ? -1.0e30f : sacc[qg][i]; } }
                    float ps = 0.f; float p[16];
#pragma unroll
                    for (int i = 0; i < 16; ++i) { p[i] = fast_exp2(sacc[qg][i]); ps += p[i]; }
                    lsum[qg] += ps;
#pragma unroll
                    for (int s2 = 0; s2 < 2; ++s2) {
                        unsigned pw[4];
#pragma unroll
                        for (int j = 0; j < 4; ++j) pw[j] = pk2(p[8 * s2 + 2 * j], p[8 * s2 + 2 * j + 1]);
                        const v4u pv4 = (v4u){pw[0], pw[1], pw[2], pw[3]}; const bf16x8 pf = __builtin_bit_cast(bf16x8, pv4);
                        oacc[qg][0] = __builtin_amdgcn_mfma_f32_32x32x16_f16(__builtin_bit_cast(pg8::h16x8, vf[0][s2]), __builtin_bit_cast(pg8::h16x8, pf), oacc[qg][0], 0, 0, 0);
                        oacc[qg][1] = __builtin_amdgcn_mfma_f32_32x32x16_f16(__builtin_bit_cast(pg8::h16x8, vf[1][s2]), __builtin_bit_cast(pg8::h16x8, pf), oacc[qg][1], 0, 0, 0);
                    }
                }
            }
            if (more) *(LAS v4u*)(F.lds + ((ti + 1) & 1) * 10240 + ldst) = nx;
            __syncthreads();
            nx = nx2;
        }
#undef ATT_SRC
#pragma unroll
        for (int qg = 0; qg < 2; ++qg) {
            const float lt2 = x32_sum(lsum[qg]), inv = 1.0f / lt2;
            unsigned char* orow = (unsigned char*)MIX + (size_t)(qrow0 + 32 * qg + r) * DM + h * 64;
#pragma unroll
            for (int dh = 0; dh < 2; ++dh)
#pragma unroll
                for (int t = 0; t < 4; ++t) *(GAS unsigned*)(orow + 32 * dh + 8 * t + 4 * hh) = mix8x4(oacc[qg][dh][4 * t] * inv, oacc[qg][dh][4 * t + 1] * inv, oacc[qg][dh][4 * t + 2] * inv, oacc[qg][dh][4 * t + 3] * inv);
        }
    }
}
using pg8::Unit;
typedef pg8::f32x4 (AccT)[2][2][4][2];
#define ROWL(ai, m) (128 * (ai) + 64 * wr + 16 * (m) + fr)
#define COL8(bj) (128 * (bj) + 32 * wc + 8 * fq)
__device__ __forceinline__ v4u pack8(const f32x4 a, const f32x4 b) { v4u w; w.x = pg8::cvt_pk_bf16(a[0], a[1]); w.y = pg8::cvt_pk_bf16(a[2], a[3]); w.z = pg8::cvt_pk_bf16(b[0], b[1]); w.w = pg8::cvt_pk_bf16(b[2], b[3]); return w; }
__device__ __forceinline__ void dense_aoff(int lda, const int (&R)[2], const int (&C)[2], unsigned (&off)[2][2]) {
#pragma unroll
    for (int h = 0; h < 2; ++h)
#pragma unroll
        for (int i = 0; i < 2; ++i) off[h][i] = (unsigned)((128 * h + R[i]) * lda + C[i]) * 2u;
}
__device__ __forceinline__ unsigned swz16u(unsigned v) { return (unsigned)__builtin_amdgcn_ds_swizzle((int)v, (16 << 10) | 0x1f); }
template <bool F8> struct SchedDenseT {
    static constexpr bool PREFETCH_A = false, FP8 = F8;
    static constexpr bool SPLIT_B = false, DENSE_A = true, CONST_LDB = true;
    const char* A; const char* B; int nM, nN, lda, ldbv, nt, G, c;
    __device__ __forceinline__ bool next(int i, Unit& u) const { const int L = i * G + c; if (L >= nM * nN) return false; int pm, pn; pg8::tile_order(L, nM, nN, pm, pn);
        u.A = A + (size_t)pm * 256 * lda * 2; u.B = B + (size_t)pn * 256 * ldbv * 2; u.nt = nt; u.ldb = ldbv; u.i0 = pm; u.i1 = pn; u.i2 = 0; u.i3 = 0; return true; }
    __device__ __forceinline__ void aoff(const Unit&, const int (&R)[2], const int (&C)[2], unsigned (&off)[2][2]) const { dense_aoff(lda, R, C, off); }
};
using SchedDense = SchedDenseT<false>;
struct SchedE1 {
    static constexpr bool PREFETCH_A = false, FP8 = true;
    static constexpr bool SPLIT_B = true, DENSE_A = true, CONST_LDB = true;
    const char* H; const char* WUV; const char* WF; int nMt  , G, c;
    __device__ __forceinline__ bool next(int i, Unit& u) const { int L = i * G + c; const int n0 = nMt * 4; if (L >= n0 + 512 + 32) return false; int pm, pn; u.nt = 8; u.ldb = 512; u.i3 = 0; u.mir = 0;
        if (L < n0) { pg8::tile_order(L, nMt, 4, pm, pn); u.A = H + (size_t)pm * 256 * 1024; u.B = WUV + (size_t)pn * 256 * 1024; u.B1 = u.B + (size_t)128 * 1024; u.i2 = 0; }
        else if (L < n0 + 512) { pg8::tile_order(L - n0, 4, 128, pm, pn); const int b = pn >> 4, j0 = (pn & 15) * 128;
            u.A = WF + (size_t)pm * 256 * 1024; u.B = H + (size_t)(b * SEQ + j0) * 1024; u.B1 = H + (size_t)(b * SEQ + SEQ - j0 - 127) * 1024; u.mir = 1; u.i2 = 2; }
        else { const int v = L - n0 - 512; pm = v & 3; pn = 128 + (v >> 2); u.A = WF + (size_t)pm * 256 * 1024; u.B = H + (size_t)pn * 256 * 1024; u.B1 = u.B + (size_t)128 * 1024; u.i2 = 1; }
        u.i0 = pm; u.i1 = pn; return true; }
    __device__ __forceinline__ void aoff(const Unit&, const int (&R)[2], const int (&C)[2], unsigned (&off)[2][2]) const { dense_aoff(512, R, C, off); }
};
struct EpiE1 {
    static constexpr int VM_MIN = 0; static constexpr bool PREFETCH = false;
    bf16* UV; bf16* FO; bf16* GTC;
    __device__ __forceinline__ void operator()(const AccT& acc, const Unit& u, int wr, int wc, int fr, int fq) const {
        if (u.i2 == 0) {
#pragma unroll
            for (int ai = 0; ai < 2; ++ai)
#pragma unroll
                for (int m = 0; m < 4; ++m) { bf16* rowp = UV + (size_t)(u.i0 * 256 + ROWL(ai, m)) * DM + u.i1 * 256;
#pragma unroll
                    for (int bj = 0; bj < 2; ++bj) { f32x4 a = acc[ai][bj][m][0], b = acc[ai][bj][m][1];
#pragma unroll
                        for (int j = 0; j < 4; ++j) { a[j] = gelu_f(a[j] * UV_INV); b[j] = gelu_f(b[j] * UV_INV); }
                        *(GAS v4u*)(rowp + COL8(bj)) = pack8(a, b); } }
        } else if (u.i2 == 2) {
            const int b = u.i1 >> 4, j0 = (u.i1 & 15) * 128, c = 32 * wc + 8 * fq;
            const bool cs = (fr & 1) != 0;
#pragma unroll
            for (int ai = 0; ai < 2; ++ai)
#pragma unroll
                for (int m = 0; m < 4; ++m) { const int mp = u.i0 * 256 + ROWL(ai, m);
                    f32x4 a = acc[ai][0][m][0], bq = acc[ai][0][m][1]; const f32x4 ma = acc[ai][1][m][0], mb = acc[ai][1][m][1];
                    if (cs) { a -= ma; bq -= mb; } else { a += ma; bq += mb; }
                    if (j0 + c == 0) a[0] = cs ? 0.f : acc[ai][0][m][0][0];
                    a *= FO_INV * FO_SCALE; bq *= FO_INV * FO_SCALE;
                    { v2u o8; o8.x = fp8x4(a); o8.y = fp8x4(bq); *(GAS v2u*)((unsigned char*)FO + ((size_t)(b * 512 + (mp >> 1)) * 4096 + (cs ? 2048 : 0) + j0 + c)) = o8; } }
        } else {
            bf16* base = GTC + (size_t)(u.i1 - 128) * 1024 * LCTX;
#pragma unroll
            for (int ai = 0; ai < 2; ++ai)
#pragma unroll
                for (int m = 0; m < 4; ++m) { bf16* rowp = base + (size_t)(u.i0 * 256 + ROWL(ai, m)) * LCTX;
#pragma unroll
                    for (int bj = 0; bj < 2; ++bj) *(GAS v4u*)(rowp + COL8(bj)) = pack8(acc[ai][bj][m][0] * FO_INV, acc[ai][bj][m][1] * FO_INV); }
        }
    }
};
template <bool CTX> struct SchedFourier {
    static constexpr bool PREFETCH_A = false, FP8 = !CTX;
    static constexpr bool SPLIT_B = false, DENSE_A = true, CONST_LDB = true;
    const char* DFT; const char* GT; int G, c;
    __device__ __forceinline__ bool next(int i, Unit& u) const { const int L = i * G + c; u.i3 = 0;
        if (!CTX) { if (L >= 256) return false; const int b = L & 7, j = L >> 3, pq = j & 1, pn = (j >> 1) & 1, pm = j >> 2;
            u.A = DFT + ((size_t)pm * 256 * 4096 + (size_t)pq * 2048); u.B = GT + (((size_t)b * 512 + (size_t)pn * 256) * 4096 + (size_t)pq * 2048); u.nt = 16; u.ldb = 2048;
            u.i0 = (b * 2 + pq) * 2048 + pm * 256; u.i1 = pn; u.i2 = 1; return true; }
        else { if (L >= 16) return false; const int b = L >> 1, pn = L & 1; u.A = DFT; u.B = GT + ((size_t)b * 1024 * LCTX + (size_t)pn * 256 * 512) * 2; u.nt = 8; u.ldb = 512; u.i0 = NX + b * LCTX; u.i1 = pn; u.i2 = 0; return true; } }
    __device__ __forceinline__ void aoff(const Unit&, const int (&R)[2], const int (&C)[2], unsigned (&off)[2][2]) const { dense_aoff(CTX ? 512 : 2048, R, C, off); }
};
template <bool CTX> struct EpiFourier {
    static constexpr int VM_MIN = 0; static constexpr bool PREFETCH = false;
    bf16* MIX; bf16* PQ;
    __device__ __forceinline__ void operator()(const AccT& acc, const Unit& u, int wr, int wc, int fr, int fq) const {
        if constexpr (!CTX) { bf16* base = PQ + (size_t)u.i0 * 512 + u.i1 * 256;
#pragma unroll
            for (int ai = 0; ai < 2; ++ai)
#pragma unroll
                for (int m = 0; m < 4; ++m) { bf16* rowp = base + (size_t)ROWL(ai, m) * 512;
#pragma unroll
                    for (int bj = 0; bj < 2; ++bj) *(GAS v4u*)(rowp + COL8(bj)) = pack8(acc[ai][bj][m][0] * PQ_INV, acc[ai][bj][m][1] * PQ_INV); }
        } else { unsigned char* base = (unsigned char*)MIX + (size_t)u.i0 * DM + 512 + u.i1 * 256;
#pragma unroll
            for (int ai = 0; ai < 2; ++ai)
#pragma unroll
                for (int m = 0; m < 4; ++m) { unsigned char* rowp = base + (size_t)ROWL(ai, m) * DM;
#pragma unroll
                    for (int bj = 0; bj < 2; ++bj) { v2u o; o.x = fp8x4(acc[ai][bj][m][0] * MIX_SCALE); o.y = fp8x4(acc[ai][bj][m][1] * MIX_SCALE); *(GAS v2u*)(rowp + COL8(bj)) = o; } }
        }
    }
};
template <bool MOE> struct EpiResid {
    static constexpr int VM_MIN = 0; static constexpr bool PREFETCH = !MOE;
    const float* srcf_x; const float* srcf_c;
    float* dstf;
    bf16* XH;
    const float* mod;
    const bf16* YS;
    unsigned pfl;
    __device__ __forceinline__ void prefetch(const Unit& u, int wave) const {
        if (pfl != 0u && srcf_x == nullptr) { const char* base = (const char*)(XH + (size_t)u.i0 * 256 * DM + u.i1 * 256); const int t = wave * 64 + lane_id_now();
#pragma unroll
            for (int j = 0; j < 2; ++j) { const int li = t + 512 * j; pg8::pg8_dma4(base, (unsigned)((li >> 2) * (DM * 2) + (li & 3) * 128), pfl + (unsigned)wave * 256u); } }
    }
    __device__ __forceinline__ void operator()(const AccT& acc, const Unit& u, int wr, int wc, int fr, int fq) const {
        const int row0 = u.i0 * 256; const bool isx = row0 < NX;
        const int cond = isx ? (row0 >> 12) : 8;
        const float* gatep = mod + (size_t)cond * MODW + u.i1 * 256;
        const float* sfb = srcf_x ? (isx ? srcf_x + (size_t)row0 * DM : srcf_c + (size_t)(row0 - NX) * DM) + u.i1 * 256 : nullptr;
        bf16* xhb = XH + (size_t)row0 * DM + u.i1 * 256;
        float* dfb = dstf ? dstf + (size_t)row0 * DM + u.i1 * 256 : nullptr;
        if constexpr (!MOE) {
        f32x4 gv[2][2];
#pragma unroll
        for (int bj = 0; bj < 2; ++bj)
#pragma unroll
            for (int n = 0; n < 2; ++n) gv[bj][n] = *(const GAS f32x4*)(gatep + COL8(bj) + 4 * n) * MO_INV;
#pragma unroll
        for (int ai = 0; ai < 2; ++ai) {
            f32x4 xo[4][2][2];
#pragma unroll
            for (int m = 0; m < 4; ++m)
#pragma unroll
                for (int bj = 0; bj < 2; ++bj) { const size_t o = (size_t)ROWL(ai, m) * DM + COL8(bj);
                    if (sfb) { xo[m][bj][0] = *(const GAS f32x4*)(sfb + o); xo[m][bj][1] = *(const GAS f32x4*)(sfb + o + 4); }
                    else { const v4u w = *(const GAS v4u*)(xhb + o); xo[m][bj][0] = (f32x4){bflo(w.x), bfhi(w.x), bflo(w.y), bfhi(w.y)}; xo[m][bj][1] = (f32x4){bflo(w.z), bfhi(w.z), bflo(w.w), bfhi(w.w)}; } }
#pragma unroll
            for (int m = 0; m < 4; ++m)
#pragma unroll
                for (int bj = 0; bj < 2; ++bj) { const size_t o = (size_t)ROWL(ai, m) * DM + COL8(bj);
                    const f32x4 r0 = xo[m][bj][0] + gv[bj][0] * acc[ai][bj][m][0], r1 = xo[m][bj][1] + gv[bj][1] * acc[ai][bj][m][1];
                    if (dfb) { *(GAS f32x4*)(dfb + o) = r0; *(GAS f32x4*)(dfb + o + 4) = r1; } else *(GAS v4u*)(xhb + o) = pack8(r0, r1); }
            asm volatile("" ::: "memory"); }
        } else {
#pragma unroll
        for (int ai = 0; ai < 2; ++ai)
#pragma unroll
            for (int m = 0; m < 4; ++m) { const int rl = ROWL(ai, m);
                {
                  const unsigned char* yp = (const unsigned char*)YS + (size_t)(row0 + rl) * (TOPK * DM) + u.i1 * 256 + 64 * wc + 16 * fq;
                  float sm[16];
#pragma unroll
                  for (int q = 0; q < 16; ++q) sm[q] = 0.f;
#pragma unroll
                  for (int k = 0; k < TOPK; ++k) { const v4u y = *(const GAS v4u*)(yp + (size_t)k * DM);
#pragma unroll
                      for (int w = 0; w < 4; ++w) { const f32x2 p0 = __builtin_amdgcn_cvt_pk_f32_fp8((int)y[w], false), p1 = __builtin_amdgcn_cvt_pk_f32_fp8((int)y[w], true);
                          sm[4 * w] += p0.x; sm[4 * w + 1] += p0.y; sm[4 * w + 2] += p1.x; sm[4 * w + 3] += p1.y; } }
                  f32x4 r[2][2];
#pragma unroll
                  for (int q = 0; q < 4; ++q) { r[0][0][q] = sm[q]; r[0][1][q] = sm[4 + q]; r[1][0][q] = sm[8 + q]; r[1][1][q] = sm[12 + q]; }
#pragma unroll
                  for (int bj = 0; bj < 2; ++bj) { const size_t o = (size_t)rl * DM + COL8(bj);
                    const f32x4 a = acc[ai][bj][m][0] + r[bj][0] * YS_INV, b = acc[ai][bj][m][1] + r[bj][1] * YS_INV;
                    const v4u w = *(const GAS v4u*)(xhb + o); const f32x4 g0 = *(const GAS f32x4*)(gatep + COL8(bj)), g1 = *(const GAS f32x4*)(gatep + COL8(bj) + 4);
                    const f32x4 r0 = (f32x4){bflo(w.x), bfhi(w.x), bflo(w.y), bfhi(w.y)} + g0 * a, r1 = (f32x4){bflo(w.z), bfhi(w.z), bflo(w.w), bfhi(w.w)} + g1 * b;
                    if (dfb) { *(GAS f32x4*)(dfb + o) = r0; *(GAS f32x4*)(dfb + o + 4) = r1; } else *(GAS v4u*)(xhb + o) = pack8(r0, r1); } }
                asm volatile("" ::: "memory"); }
        }
    }
};
struct EpiOddIn {
    static constexpr int VM_MIN = 0; static constexpr bool PREFETCH = false;
    bf16* Q; bf16* KB; bf16* VT; bf16* VTC; bf16* GZ; bf16* GO; const float* qg; const float* kg; const float* rope;
    __device__ __forceinline__ void operator()(const AccT& acc, const Unit& u, int wr, int wc, int fr, int fq) const {
        const int pn = u.i1, row0 = u.i0 * 256; const bool isx = row0 < NX;
        if (pn < 2 || (pn == 2 && wc < 2)) {
            const bool isq = pn < 2; const float* gp = isq ? qg : kg;
            f32x4 gn[2][2];
#pragma unroll
            for (int bj = 0; bj < 2; ++bj)
#pragma unroll
                for (int n = 0; n < 2; ++n) gn[bj][n] = *(const GAS f32x4*)(gp + 32 * n + 16 * bj + 4 * fq);
            const float osc = isq ? QSCALE : 1.0f;
#pragma unroll
            for (int ai = 0; ai < 2; ++ai)
#pragma unroll
                for (int m = 0; m < 4; ++m) { const int row = row0 + ROWL(ai, m);
                    float ss = 0.f;
#pragma unroll
                    for (int bj = 0; bj < 2; ++bj)
#pragma unroll
                        for (int n = 0; n < 2; ++n) { const f32x4 v = (acc[ai][bj][m][n] * OD_INV); ss += (v[0] * v[0] + v[1] * v[1]) + (v[2] * v[2] + v[3] * v[3]); }
                    ss += swz_xor<16>(ss); ss = x32_sum(ss);
                    const float rstd = osc / sqrtf(ss * (1.0f / 64.0f) + EPS_RMS);
                    f32x4 y[2][2];
#pragma unroll
                    for (int bj = 0; bj < 2; ++bj)
#pragma unroll
                        for (int n = 0; n < 2; ++n) y[bj][n] = (acc[ai][bj][m][n] * OD_INV) * rstd * gn[bj][n];
                    if (isx) { const int pos = row & (SEQ - 1);
#pragma unroll
                        for (int n = 0; n < 2; ++n) { const int P = n == 0 ? (pos >> 6) : (pos & 63);
                            const f32x4 cs = *(const GAS f32x4*)(rope + P * 16 + 4 * fq), sn = *(const GAS f32x4*)(rope + 1024 + P * 16 + 4 * fq);
                            const f32x4 x1 = y[0][n], x2 = y[1][n]; y[0][n] = x1 * cs - x2 * sn; y[1][n] = x2 * cs + x1 * sn; } }
                    bf16* dst = isq ? Q + (size_t)row * 512 + (4 * pn + wc) * 64 : KB + (size_t)row * 128 + wc * 64;
#pragma unroll
                    for (int bj = 0; bj < 2; ++bj)
#pragma unroll
                        for (int n = 0; n < 2; ++n) { v2u o; o.x = pg8::cvt_pk_bf16(y[bj][n][0], y[bj][n][1]); o.y = pg8::cvt_pk_bf16(y[bj][n][2], y[bj][n][3]); *(GAS v2u*)(dst + 32 * n + 16 * bj + 4 * fq) = o; }
                    asm volatile("" ::: "memory"); }
        } else if (pn == 2) {
            const int hk = wc & 1;
            const int L = isx ? SEQ : LCTX;
            bf16* ubase = isx ? VT + (size_t)(((row0 >> 12) * 2 + hk) * 64) * SEQ + (row0 & (SEQ - 1)) : VTC + (size_t)((((row0 - NX) >> 8) * 2 + hk) * 64) * LCTX;
#pragma unroll
            for (int ai = 0; ai < 2; ++ai)
#pragma unroll
                for (int m = 0; m < 4; ++m) { bf16* base = ubase + ROWL(ai, m);
#pragma unroll
                    for (int bj = 0; bj < 2; ++bj)
#pragma unroll
                        for (int n = 0; n < 2; ++n)
#pragma unroll
                            for (int e = 0; e < 4; ++e) base[(size_t)(32 * n + 16 * bj + 4 * fq + e) * L] = (bf16)f2bf((acc[ai][bj][m][n] * OD_INV)[e]);
                    asm volatile("" ::: "memory"); }
        } else if (pn < 7) {
#pragma unroll
            for (int ai = 0; ai < 2; ++ai)
#pragma unroll
                for (int m = 0; m < 4; ++m) { const int row = row0 + ROWL(ai, m);
                    *(GAS v4u*)(GZ + (size_t)row * 512 + 128 * (pn - 3) + 32 * wc + 8 * fq) = pack8(acc[ai][0][m][0] * acc[ai][1][m][0] * (OD_INV * OD_INV), acc[ai][0][m][1] * acc[ai][1][m][1] * (OD_INV * OD_INV)); }
        } else {
#pragma unroll
            for (int ai = 0; ai < 2; ++ai)
#pragma unroll
                for (int m = 0; m < 4; ++m) { bf16* rowp = GO + (size_t)(row0 + ROWL(ai, m)) * 512 + 256 * (pn - 7);
#pragma unroll
                    for (int bj = 0; bj < 2; ++bj) *(GAS v4u*)(rowp + COL8(bj)) = pack8(acc[ai][bj][m][0] * OD_INV, acc[ai][bj][m][1] * OD_INV); }
        }
    }
};
__device__ __forceinline__ f32x4 swiglu4(const f32x4 g, const f32x4 u) { f32x4 r; r[0] = silu_f(g[0]) * u[0]; r[1] = silu_f(g[1]) * u[1]; r[2] = silu_f(g[2]) * u[2]; r[3] = silu_f(g[3]) * u[3]; return r; }
struct EpiM1 {
    static constexpr int VM_MIN = 0; static constexpr bool PREFETCH = false;
    bf16* HS; float* LOG;
    __device__ __forceinline__ void operator()(const AccT& acc, const Unit& u, int wr, int wc, int fr, int fq) const {
        const int pn = u.i1, row0 = u.i0 * 256;
        if (pn < 2) {
#pragma unroll
            for (int ai = 0; ai < 2; ++ai)
#pragma unroll
                for (int m = 0; m < 4; ++m) *(GAS v4u*)(HS + (size_t)(row0 + ROWL(ai, m)) * 256 + 128 * pn + 32 * wc + 8 * fq) = pack8(swiglu4(acc[ai][0][m][0], acc[ai][1][m][0]), swiglu4(acc[ai][0][m][1], acc[ai][1][m][1]));
        } else if (wc < 2) {
#pragma unroll
            for (int ai = 0; ai < 2; ++ai)
#pragma unroll
                for (int m = 0; m < 4; ++m) { float* lp = LOG + (size_t)(row0 + ROWL(ai, m)) * 64 + 32 * wc + 8 * fq; *(GAS f32x4*)lp = acc[ai][0][m][0]; *(GAS f32x4*)(lp + 4) = acc[ai][0][m][1]; }
        }
    }
};
__device__ __forceinline__ void build_expert_prefix(const Frame& F0, int l) {
    PHASE_FRAME(F, F0);
    volatile LAS unsigned* pfx = F.MISC + 192;
    if (F.wave == 0) { const int e = F.lane; const unsigned c = __hip_atomic_load(F.ctl + CW_CNT + l * 64 + e, RLX_AGENT); pfx[128 + e] = c;
        const unsigned b = (c + 255u) >> 8; unsigned s = b;
#pragma unroll
        for (int d = 1; d < 64; d <<= 1) { const unsigned t = (unsigned)__builtin_amdgcn_ds_bpermute(((e - d) & 63) << 2, (int)s); s += (e >= d) ? t : 0u; }
        pfx[e] = s - b; if (e == 63) pfx[64] = s; }
    __syncthreads();
}
__device__ __forceinline__ unsigned lds_u(volatile LAS unsigned* p) { return (unsigned)__builtin_amdgcn_readfirstlane((int)*p); }
__device__ __forceinline__ int find_expert(volatile LAS unsigned* pfx, unsigned rbg) { int e = 0;
#pragma unroll
    for (int s = 32; s >= 1; s >>= 1) e += (lds_u(pfx + e + s) <= rbg) ? s : 0;
    return e; }
struct SchedExpertGU {
    static constexpr bool SPLIT_B = false, DENSE_A = false, CONST_LDB = true;
    const char* H; const char* EGU; const int* rtok; const unsigned* cnt; volatile LAS unsigned* pfx; int G, c; LAS unsigned char* desc;
    static constexpr bool PREFETCH_A = true, FP8 = true;
    static constexpr unsigned ROWB = 1024u, NROWS = (unsigned)NT;
    __device__ __forceinline__ const LAS int* table(const Unit& u) const { return (const LAS int*)(desc + u.mir * 1024); }

    __device__ __forceinline__ void prefetch_rows(const Unit& u, int wave) const {
        if (wave == 0) __builtin_amdgcn_global_load_lds((const unsigned*)((const char*)(rtok + (size_t)u.i0 * ECAP + u.i1 * 256) + lane_id_now() * 16), (LAS unsigned*)(desc + u.mir * 1024), 16, 0, 0); }
    __device__ __forceinline__ bool next(int i, Unit& u) const { const unsigned cp = G == 256 ? (unsigned)(((c & 7) << 5) | ((c >> 4) << 1) | ((c >> 3) & 1)) : (unsigned)c;
        const unsigned L = (unsigned)(i * G) + cp; if (L >= 2u * lds_u(pfx + 64)) return false; const unsigned rbg = L >> 1; const int t = L & 1, e = find_expert(pfx, rbg);
        u.A = H; u.B = EGU + ((size_t)e * 512 + t * 256) * 1024; u.nt = 8; u.ldb = 512;     u.i0 = e; u.i1 = (int)(rbg - lds_u(pfx + e)); u.i2 = t; u.i3 = (int)rbg * 256; u.mir = i & 1; return true; }
    __device__ __forceinline__ void aoff(const Unit& u, const int (&R)[2], const int (&C)[2], unsigned (&off)[2][2]) const {
        const int n = (int)lds_u(pfx + 128 + u.i0); const LAS int* rt = (const LAS int*)(desc + u.mir * 1024);
#pragma unroll
        for (int h = 0; h < 2; ++h)
#pragma unroll
            for (int i = 0; i < 2; ++i) { const int rho = 128 * h + R[i]; const int tok = (u.i1 * 256 + rho < n) ? (rt[rho] >> 3) : 0; off[h][i] = (unsigned)(tok * 512 + C[i]) * 2u; }
    }
};
struct EpiGU {
    static constexpr int VM_MIN = 0; static constexpr bool PREFETCH = false;
    unsigned char* HMID;
    __device__ __forceinline__ void operator()(const AccT& acc, const Unit& u, int wr, int wc, int fr, int fq) const {
#pragma unroll
        for (int ai = 0; ai < 2; ++ai)
#pragma unroll
            for (int m = 0; m < 4; ++m) { v2u o; o.x = fp8x4(swiglu4(acc[ai][0][m][0] * GU_INV, acc[ai][1][m][0] * GU_INV) * HM_SCALE); o.y = fp8x4(swiglu4(acc[ai][0][m][1] * GU_INV, acc[ai][1][m][1] * GU_INV) * HM_SCALE);
                *(GAS v2u*)(HMID + (size_t)(u.i3 + ROWL(ai, m)) * 256 + 128 * u.i2 + 32 * wc + 8 * fq) = o; asm volatile("" ::: "memory"); }
    }
};
struct SchedExpertDown {
    static constexpr bool PREFETCH_A = false, FP8 = true;
    static constexpr bool SPLIT_B = false, DENSE_A = true, CONST_LDB = true;
    const char* HMID; const char* EDN; volatile LAS unsigned* pfx; int G, c;
    __device__ __forceinline__ bool next(int i, Unit& u) const { const unsigned cp = G == 256 ? (unsigned)(((c & 7) << 5) | ((c >> 5) << 2) | ((c >> 3) & 3)) : (unsigned)c;
        const unsigned L = (unsigned)(i * G) + cp; if (L >= 4u * lds_u(pfx + 64)) return false; const unsigned rbg = L >> 2; const int pn = L & 3, e = find_expert(pfx, rbg);
        u.A = HMID + (size_t)rbg * 256 * 256; u.B = EDN + ((size_t)e * 1024 + pn * 256) * 256; u.nt = 2; u.ldb = 128;     u.i0 = e; u.i1 = (int)(rbg - lds_u(pfx + e)); u.i2 = pn; u.i3 = i & 1; return true; }
    __device__ __forceinline__ void aoff(const Unit&, const int (&R)[2], const int (&C)[2], unsigned (&off)[2][2]) const { dense_aoff(128, R, C, off); }
};
struct EpiDown {
    static constexpr int VM_MIN = 0;  static constexpr bool PREFETCH = true;
    bf16* YS; const int* rtok; const float* rgate; volatile LAS unsigned* pfx; unsigned char* dummy;
    LAS unsigned char* desc;
    __device__ __forceinline__ void prefetch(const Unit& u, int wave) const {
        if (wave < 2) { const size_t tb = (size_t)u.i0 * ECAP + u.i1 * 256; const char* src = wave == 0 ? (const char*)(rtok + tb) : (const char*)(rgate + tb);
            __builtin_amdgcn_global_load_lds((const unsigned*)(src + lane_id_now() * 16), (LAS unsigned*)(desc + u.i3 * 2048 + wave * 1024), 16, 0, 0); }
    }
    __device__ __forceinline__ void operator()(const AccT& acc, const Unit& u, int wr, int wc, int fr, int fq) const {
        const int n = (int)lds_u(pfx + 128 + u.i0); const LAS int* dt = (const LAS int*)(desc + u.i3 * 2048); const LAS float* dg = (const LAS float*)(dt + 256);
#pragma unroll
        for (int ai = 0; ai < 2; ++ai)
#pragma unroll
            for (int m = 0; m < 4; ++m) { const int rho = ROWL(ai, m); const bool ok = u.i1 * 256 + rho < n; const int t = dt[rho]; const float g = dg[rho] * (YS_SCALE * DN_INV);
                const unsigned x0 = fp8x4(acc[ai][0][m][0] * g), y0 = fp8x4(acc[ai][0][m][1] * g), x1 = fp8x4(acc[ai][1][m][0] * g), y1 = fp8x4(acc[ai][1][m][1] * g);
                if (ok) *(GAS v4u*)((unsigned char*)YS + ((size_t)(t >> 3) * TOPK + (t & 7)) * DM + u.i2 * 256 + 64 * wc + 16 * fq) = (v4u){x0, y0, x1, y1};
                asm volatile("" ::: "memory"); }
    }
};
constexpr int NPHASES = 1 + 9 * DEPTH;
#ifndef PHMASK
#define PHMASK 0x3ff
#endif
#define PH_ON(k) ((PHMASK >> (k)) & 1)
#ifndef REPSEL
#define REPSEL -1
#endif
#ifndef REPPAR
#define REPPAR -1
#endif
#define NREP(k) ((REPSEL == (k) && (REPPAR < 0 || REPPAR == (l & 1))) ? 2 : 1)
#ifndef PHSUB
#define PHSUB 0xf
#endif
struct Args { const float* in[26]; float* out; unsigned char* ws; int ph_lo, ph_hi; };
static_assert(sizeof(Args) == 26 * 8 + 8 + 8 + 8, "Args has no padding");

__global__ void __launch_bounds__(NWAVES * 64, 2) fwd_kernel(Args args) {
    extern __shared__ __attribute__((aligned(16))) unsigned char lds_raw[];
    Frame F;
    F.lds = (LAS unsigned char*)lds_raw;
    F.MISC = (volatile LAS unsigned*)(F.lds + MISC_OFF);
    F.wave = __builtin_amdgcn_readfirstlane((int)threadIdx.x >> 6); F.lane = 0; F.tid = 0;
    F.G = gridDim.x; F.bx = blockIdx.x;
    F.ws = args.ws; F.out = args.out; F.ctl = (unsigned*)(args.ws + WS_CTL);
    F.in = args.in;
    for (int u = threadIdx.x; u < (LDS_BYTES - MISC_OFF) / 4; u += NWAVES * 64) F.MISC[u] = 0u;
    __syncthreads();
    const int lo = args.ph_lo, hi = args.ph_hi;
    const bool use_bar = (hi - lo) > 1;
    XcdBarrier bar; bar.bar = F.ctl + CW_BAR; bar.x = 0; bar.st = nullptr; bar.wave = F.wave;
    if (use_bar) bar = xcd_barrier_post(F.ctl + CW_BAR, F.MISC + 8);
#define IN(k) (lo <= (k) && (k) < hi)
#define SEAM(k) do { if (IN(k) && IN((k) + 1)) xcd_barrier(bar); } while (0)
    LAS unsigned char* ring = F.lds;
#define STEAL_IF_IDLE(total_units, layer, quota) do { const int rem_ = (total_units) % F.G; if ((layer) < DEPTH && rem_ != 0 && F.bx >= rem_) expert_convert_steal(F, (layer), (quota)); } while (0)
    const int gw = F.bx * NWAVES + F.wave, NGW = F.G * NWAVES;

    if (PH_ON(0) && IN(0)) { const int l = 0; for (int rep = 0; rep < NREP(0); ++rep) p0_prologue(F); }
    SEAM(0);
#ifdef PROBE_CHECK
    check_mod(F);
#endif

#pragma unroll 1
    for (int l = 0; l < DEPTH; ++l) {
        const int pb = 1 + 9 * l;
        const bool odd = (l & 1) != 0, lastl = (l == DEPTH - 1);
        const int e2 = l >> 1;
        const int nrows = lastl ? NX : NT;
        const float* modl = wsp<const float>(F, WS_MOD) + (size_t)l * 9 * MODW;

        if (PH_ON(1) && IN(pb + 0)) for (int rep = 0; rep < NREP(1); ++rep) {
            norm_phase(F, l, NT, l == 0, F.in[I_N1G] + l * DM, 0, 1, false, true);
        }
#ifdef PROBE_CHECK
        if (l == 0) { xcd_barrier(bar); check_norm(F, l, NT, true, F.in[I_N1G] + l * DM, 0, 1, 9); }
#endif
        SEAM(pb + 0);

        if (PH_ON(2) && IN(pb + 1)) for (int rep = 0; rep < NREP(2); ++rep) {
            if ((PHSUB & 1) && !odd) {
                SchedE1 S{(const char*)wsp<unsigned char>(F, WS_H8), (const char*)(wsp<unsigned char>(F, WS_EVUV) + (size_t)e2 * 1024 * 1024), (const char*)(wsp<unsigned char>(F, WS_EVF) + (size_t)e2 * 1024 * 1024), NT / 256, F.G, F.bx};
                EpiE1 E{wsp<bf16>(F, WS_PROJ + PJ_UV), wsp<bf16>(F, WS_PROJ + PJ_GT), wsp<bf16>(F, WS_PROJ + PJ_GTC)};
                pg8::gemm_phase(ring, F.wave, S, E);
                STEAL_IF_IDLE(2 * (NT / 256) * 4, l, 1);
            } else if ((PHSUB & 2) && odd) {
                SchedDenseT<true> S{(const char*)wsp<unsigned char>(F, WS_H8), (const char*)(wsp<unsigned char>(F, WS_ODIN) + (size_t)e2 * 2304 * 1024), NT / 256, 9, 512, 512, 8, F.G, F.bx};
                EpiOddIn E{wsp<bf16>(F, WS_PROJ + PJ_Q), wsp<bf16>(F, WS_PROJ + PJ_KV), wsp<bf16>(F, WS_PROJ + PJ_VT), wsp<bf16>(F, WS_PROJ + PJ_VTC), wsp<bf16>(F, WS_PROJ + PJ_GZ), wsp<bf16>(F, WS_PROJ + PJ_GO),
                           F.in[I_ODQG] + e2 * 64, F.in[I_ODKG] + e2 * 64, wsp<const float>(F, WS_ROPE)};
                pg8::gemm_phase(ring, F.wave, S, E);
                STEAL_IF_IDLE((NT / 256) * 9, l, 1);
            }
        }
#ifdef PROBE_CHECK
        if (l == 0) { xcd_barrier(bar); check_e1(F, e2); }
#endif
        SEAM(pb + 1);

        if (PH_ON(3) && IN(pb + 2)) for (int rep = 0; rep < NREP(3); ++rep) {
            if ((PHSUB & 1) && !odd) {
                SchedFourier<false> S{(const char*)wsp<bf16>(F, WS_DFT), (const char*)wsp<bf16>(F, WS_PROJ + PJ_GT), F.G, F.bx};
                EpiFourier<false> E{wsp<bf16>(F, WS_MIX), wsp<bf16>(F, WS_PROJ + PJ_PQ)};
                pg8::gemm_phase(ring, F.wave, S, E);
                SchedFourier<true> SC{(const char*)wsp<bf16>(F, WS_DFTC), (const char*)wsp<bf16>(F, WS_PROJ + PJ_GTC), F.G, (F.bx + 16) % F.G};
                EpiFourier<true> EC{wsp<bf16>(F, WS_MIX), wsp<bf16>(F, WS_PROJ + PJ_PQ)};
                pg8::gemm_phase(ring, F.wave, SC, EC);
                __syncthreads();
                if (PHSUB & 4) gmlp_phase(F, e2, NT / 128);
                fourier_nyq_phase(F, e2);
#ifdef REPG
                gmlp_phase(F, e2, NT / 128);
#endif
            } else if ((PHSUB & 2) && odd) {
#ifdef PROBE_ATTN
                attn_phase_naive(F, e2, !lastl);
#else
                attn_phase(F, e2, !lastl);
#endif
                if (PHSUB & 8) conv_phase(F, e2, nrows);
#ifdef REPC
                conv_phase(F, e2, nrows);
#endif
            }
        }
#ifdef PROBE_CHECK
        if (l == 0) { xcd_barrier(bar); check_gmlp(F, e2); check_fourier(F); }
#endif
        SEAM(pb + 2);
        if (!odd && PH_ON(3) && IN(pb + 2)) { fourier_combine_phase(F); if (IN(pb + 3)) xcd_barrier(bar); }

        if (PH_ON(4) && IN(pb + 3)) {
            const unsigned char* W = (odd ? wsp<unsigned char>(F, WS_ODOUT) : wsp<unsigned char>(F, WS_EVOUT)) + (size_t)e2 * 1024 * 1024;
            SchedDenseT<true> S{(const char*)wsp<unsigned char>(F, WS_MIX), (const char*)W, nrows / 256, 4, 512, 512, 8, F.G, F.bx};
            EpiResid<false> E{l == 0 ? F.in[I_X] : nullptr, l == 0 ? F.in[I_CTX] : nullptr, nullptr, wsp<bf16>(F, WS_XH), modl + 2 * DM, nullptr, (unsigned)(unsigned long)(F.lds + MISC_OFF + 4096)};
            pg8::gemm_phase(ring, F.wave, S, E);
            STEAL_IF_IDLE((nrows / 256) * 4, l, 1);
        }
#ifdef PROBE_CHECK
        if (l == 0) { xcd_barrier(bar); check_e4(F, l, e2); }
#endif
        SEAM(pb + 3);

        if (PH_ON(5) && IN(pb + 4)) for (int rep = 0; rep < NREP(5); ++rep) norm_phase(F, l, nrows, false, F.in[I_N2G] + l * DM, 3, 4, true, true);
#ifdef PROBE_CHECK
        if (l == 0) { xcd_barrier(bar); check_norm(F, l, nrows, false, F.in[I_N2G] + l * DM, 3, 4, 15); }
#endif
        SEAM(pb + 4);

        if (PH_ON(6) && IN(pb + 5)) {
            SchedDense S{(const char*)wsp<bf16>(F, WS_H), (const char*)(wsp<bf16>(F, WS_RS) + (size_t)l * 768 * 1024), nrows / 256, 3, 1024, 1024, 16, F.G, F.bx};
            EpiM1 E{wsp<bf16>(F, WS_HS), wsp<float>(F, WS_LOG)};
            for (int rep = 0; rep < NREP(6); ++rep) pg8::gemm_phase(ring, F.wave, S, E);
            VM_WAIT(); __syncthreads();
            Unit u;
            for (int i = 0; S.next(i, u); ++i) if (u.i1 == 2) topk_rows(F, l, u.i0 * 256);
            expert_convert_steal(F, l, -1);
        }
        SEAM(pb + 5);

        if (PH_ON(7) && IN(pb + 6)) for (int rep = 0; rep < NREP(7); ++rep) {
            build_expert_prefix(F, l);
            SchedExpertGU S{(const char*)wsp<unsigned char>(F, WS_H8), (const char*)wsp<bf16>(F, WS_EGU), wsp<const int>(F, WS_RTOK), F.ctl + CW_CNT + l * 64, F.MISC + 192, F.G, F.bx, F.lds + MISC_OFF + 4096};
            EpiGU E{wsp<unsigned char>(F, WS_PROJ)};
            pg8::gemm_phase(ring, F.wave, S, E);
        }
        SEAM(pb + 6);

        if (PH_ON(8) && IN(pb + 7)) for (int rep = 0; rep < NREP(8); ++rep) {
            build_expert_prefix(F, l);
            SchedExpertDown S{(const char*)wsp<bf16>(F, WS_PROJ), (const char*)wsp<bf16>(F, WS_EDN), F.MISC + 192, F.G, F.bx};
            EpiDown E{wsp<bf16>(F, WS_YS), wsp<const int>(F, WS_RTOK), wsp<const float>(F, WS_RGATE), F.MISC + 192, wsp<unsigned char>(F, WS_LOG) + (size_t)F.bx * 8192, F.lds + MISC_OFF + 4096};
            pg8::gemm_phase(ring, F.wave, S, E);
        }
#ifdef PROBE_CHECK
        stash_phase(F, l, nrows);
#endif
        SEAM(pb + 7);

        if (PH_ON(9) && IN(pb + 8)) {
            SchedDense S{(const char*)wsp<bf16>(F, WS_HS), (const char*)(wsp<bf16>(F, WS_SHDN) + (size_t)l * 1024 * 256), nrows / 256, 4, 256, 256, 4, F.G, F.bx};
            EpiResid<true> E{nullptr, nullptr, lastl ? F.out : nullptr, wsp<bf16>(F, WS_XH), modl + 5 * DM, wsp<const bf16>(F, WS_YS), 0u};
            pg8::gemm_phase(ring, F.wave, S, E);
            STEAL_IF_IDLE((nrows / 256) * 4, l + 1, 2);
        }
#ifdef PROBE_CHECK
        xcd_barrier(bar); check_moe(F, l, nrows); xcd_barrier(bar);
#else
        SEAM(pb + 8);
#endif
    }
#ifdef PROBE_CHECK
    xcd_barrier(bar); encode_phase(F, 16);
#endif
#undef IN
#undef SEAM
}

#ifndef MK_MULTI
#define MK_MULTI 0
#endif
extern "C" void kernel_launch(void* const* d_in, const int* in_sizes, int n_in, void* d_out, int out_size, void* d_ws, size_t ws_size, hipStream_t stream) {
    static int grid = 0;
    if (grid == 0) {
        if (n_in != 26 || out_size != NX * DM || ws_size < WS_END) { fprintf(stderr, "kernel_launch: unexpected shapes (n_in %d out %d ws %zu need %zu)\n", n_in, out_size, ws_size, (size_t)WS_END); grid = -1; return; }
        int dev = 0, cus = 0, per_cu = 0;
        if (hipGetDevice(&dev) != hipSuccess || hipDeviceGetAttribute(&cus, hipDeviceAttributeMultiprocessorCount, dev) != hipSuccess) { grid = -1; return; }
        if (hipFuncSetAttribute((const void*)fwd_kernel, hipFuncAttributeMaxDynamicSharedMemorySize, LDS_BYTES) != hipSuccess) { fprintf(stderr, "kernel_launch: hipFuncSetAttribute failed\n"); grid = -1; return; }
        if (hipOccupancyMaxActiveBlocksPerMultiprocessor(&per_cu, (const void*)fwd_kernel, NWAVES * 64, LDS_BYTES) != hipSuccess || per_cu < 1) fprintf(stderr, "kernel_launch: occupancy query says %d\n", per_cu);
        (void)hipGetLastError();
        grid = cus;
    }
    if (grid < 0) return;
    (void)hipMemsetAsync((char*)d_ws + WS_CTL, 0, CTL_ZERO_BYTES, stream);
    Args a{};
    for (int i = 0; i < 26; ++i) a.in[i] = (const float*)d_in[i];
    a.out = (float*)d_out; a.ws = (unsigned char*)d_ws;
#if MK_MULTI
    for (int p = 0; p < NPHASES; ++p) { a.ph_lo = p; a.ph_hi = p + 1; hipLaunchKernelGGL(fwd_kernel, dim3(grid), dim3(NWAVES * 64), LDS_BYTES, stream, a); }
#else
    a.ph_lo = 0; a.ph_hi = NPHASES;
    hipLaunchKernelGGL(fwd_kernel, dim3(grid), dim3(NWAVES * 64), LDS_BYTES, stream, a);
#endif
}
```

```cpp
#include <hip/hip_runtime.h>
#include <cstdio>
#include <cstdint>
namespace pg8 {
#define PG8_LAS __attribute__((address_space(3)))
typedef unsigned short bf16_t;
typedef short bf16x8 __attribute__((ext_vector_type(8)));
typedef float f32x4 __attribute__((ext_vector_type(4)));
typedef float f32x2 __attribute__((ext_vector_type(2)));
typedef unsigned u32x4 __attribute__((ext_vector_type(4)));
typedef unsigned u32x2 __attribute__((ext_vector_type(2)));
constexpr int BM = 256, BK = 64, HALF = 128, HTB = HALF * BK * 2  , STAGE_BYTES = 8 * HTB, NXCD = 8, WGM = 8;

__host__ __device__ __forceinline__ int lds_byte(int r, int c) { const int st = (r >> 4) * 2 + (c >> 5), rr = r & 15, cc = c & 31, ob = rr * 64 + cc * 2; return st * 1024 + (ob ^ (((ob >> 9) & 1) << 5)); }
__host__ __device__ __forceinline__ void stage_rc(int b, int& R, int& C) { const int st = b / 1024, sb = b % 1024, swz = sb ^ (((sb >> 9) & 1) << 5); R = (st >> 1) * 16 + swz / 64; C = (st & 1) * 32 + (swz % 64) / 2; }
__host__ __device__ __forceinline__ int perm32(int rho) { const int n = rho >> 4, i = rho & 15; return 8 * (i >> 2) + 4 * n + (i & 3); }

struct Unit { const char* A; const char* B; int nt, ldb; int i0, i1, i2, i3; const char* B1; int mir; };

__device__ __forceinline__ void tile_order(int L, int nM, int nN, int& pm, int& pn) {
    const int nwg = nM * nN; int wgid = L; { const int q = nwg / NXCD, r = nwg % NXCD, xcd = wgid % NXCD, off = wgid / NXCD; wgid = (xcd < r ? xcd * (q + 1) : r * (q + 1) + (xcd - r) * q) + off; }
    const int nig = WGM * nN, gid = wgid / nig, fm = gid * WGM, gsz = (nM - fm) < WGM ? (nM - fm) : WGM;
    pm = fm + ((wgid % nig) % gsz); pn = (wgid % nig) / gsz;
}

typedef _Float16 h16x8 __attribute__((ext_vector_type(8)));
typedef _Float16 h16x2v __attribute__((ext_vector_type(2)));
__device__ __forceinline__ unsigned cvt_pk_bf16(float lo, float hi) { f32x2 v = {lo, hi}; return __builtin_bit_cast(unsigned, __builtin_convertvector(v, h16x2v)); }

__device__ __forceinline__ void pg8_dma16(const char* base, unsigned off, unsigned ldsaddr) {
    asm volatile("s_mov_b32 m0, %2\n\ts_nop 0\n\tglobal_load_lds_dwordx4 %0, %1" :: "v"(off), "s"(base), "s"(ldsaddr) : "memory", "m0"); }
__device__ __forceinline__ unsigned pg8_mirror_off(unsigned off, int ldb) { unsigned o = off; asm volatile("" : "+v"(o)); return 127u * (unsigned)(ldb * 2) + 2u * (o & 127u) - o; }
__device__ __forceinline__ unsigned pg8_umin(unsigned a, unsigned b) { return a < b ? a : b; }
__device__ __forceinline__ void pg8_dma4(const char* base, unsigned off, unsigned ldsaddr) {
    asm volatile("s_mov_b32 m0, %2\n\ts_nop 0\n\tglobal_load_lds_dword %0, %1" :: "v"(off), "s"(base), "s"(ldsaddr) : "memory", "m0"); }
typedef int i32x8 __attribute__((ext_vector_type(8)));
typedef int i32x4 __attribute__((ext_vector_type(4)));
__device__ __forceinline__ i32x8 pg8_cat(bf16x8 lo, bf16x8 hi) { const i32x4 a = __builtin_bit_cast(i32x4, lo), b = __builtin_bit_cast(i32x4, hi); return (i32x8){a[0], a[1], a[2], a[3], b[0], b[1], b[2], b[3]}; }
__device__ __forceinline__ void pg8_mma8(f32x4& c, i32x8 a, i32x8 b) { asm("v_mfma_f32_16x16x128_f8f6f4 %0, %1, %2, %0" : "+v"(c) : "v"(a), "v"(b)); }
template <int N> __device__ __forceinline__ void pg8_wait_vm() { asm volatile("s_waitcnt vmcnt(%0)" :: "n"(N) : "memory"); }
template <class Epi, class Sched>
__device__ __forceinline__ void gemm_phase(PG8_LAS unsigned char* lds, int wave  , const Sched& S, const Epi& E) {
    unsigned z_ = 0u; asm volatile("" : "+v"(z_)); int lane_ = (int)__builtin_amdgcn_mbcnt_hi(~0u, __builtin_amdgcn_mbcnt_lo(~0u, z_));
    const int wid = wave, lane = lane_, tid = wid * 64 + lane, wr = wid >> 2, wc = wid & 3, fr = lane & 15, fq = lane >> 4;
    int RR[2], CC[2], RB[2]; unsigned voffB[2]; unsigned voffB1 = 0u; long dB1 = 0;
#pragma unroll
    for (int i = 0; i < 2; ++i) { int R, C; stage_rc(tid * 16 + i * 8192, R, C); RR[i] = R; CC[i] = C; RB[i] = (R & ~31) + perm32(R & 31); }
    const size_t kstep = (size_t)(BK * 2);
    size_t hstepB;
    const unsigned ldsw = (unsigned)wid * 1024u;
    const int aoff = Sched::FP8 ? lds_byte(wr * 64 + fr, fq * 16) : lds_byte(wr * 64 + fr, fq * 8), boff = Sched::FP8 ? lds_byte(wc * 32 + fr, fq * 16) : lds_byte(wc * 32 + fr, fq * 8);
    constexpr int KSTR = Sched::FP8 ? 16 : 1024;
#define PG8_SA(b, h) (((b) * 2 + (h)) * HTB)
#define PG8_SB(b, h) ((4 + (b) * 2 + (h)) * HTB)
#define PG8_LDSA(x) ((unsigned)(unsigned long)(lds + (x)))
#define PG8_STAGEB(bufoff, gbase) do { _Pragma("unroll") for (int _i = 0; _i < 2; ++_i) \
        pg8_dma16((const char*)(gbase) + _i * (hstepB >> 1), voffB[0], PG8_LDSA((bufoff) + ldsw + _i * 8192)); } while (0)
#define PG8_STAGEB1(bufoff, gbase) do { _Pragma("unroll") for (int _i = 0; _i < 2; ++_i) \
        pg8_dma16((const char*)(gbase), voffB1 + (unsigned)(_i * (int)dB1), PG8_LDSA((bufoff) + ldsw + _i * 8192)); } while (0)
#define PG8_STAGEA(bufoff, gbase, o0, o1) do { \
        pg8_dma16((const char*)(gbase), (o0), PG8_LDSA((bufoff) + ldsw)); \
        if constexpr (Sched::DENSE_A) pg8_dma16((const char*)(gbase) + (hstepA >> 1), (o0), PG8_LDSA((bufoff) + ldsw + 8192)); \
        else pg8_dma16((const char*)(gbase), (o1), PG8_LDSA((bufoff) + ldsw + 8192)); } while (0)
#define PG8_LDA(dst, b, h) do { _Pragma("unroll") for (int m = 0; m < 4; ++m) _Pragma("unroll") for (int k = 0; k < 2; ++k) dst[m][k] = *(const PG8_LAS bf16x8*)(lds + PG8_SA(b, h) + aoff + m * 2048 + k * KSTR); } while (0)
#define PG8_LDB(dst, b, h) do { _Pragma("unroll") for (int n = 0; n < 2; ++n) _Pragma("unroll") for (int k = 0; k < 2; ++k) dst[n][k] = *(const PG8_LAS bf16x8*)(lds + PG8_SB(b, h) + boff + n * 2048 + k * KSTR); } while (0)
#define PG8_MMA(ai, bj, At, Bt) do { __builtin_amdgcn_s_setprio(1); \
        if constexpr (Sched::FP8) { _Pragma("unroll") for (int m = 0; m < 4; ++m) _Pragma("unroll") for (int n = 0; n < 2; ++n) \
            pg8_mma8(acc[ai][bj][m][n], pg8_cat(Bt[n][0], Bt[n][1]), pg8_cat(At[m][0], At[m][1])); } \
        else { _Pragma("unroll") for (int m = 0; m < 4; ++m) _Pragma("unroll") for (int n = 0; n < 2; ++n) _Pragma("unroll") for (int k = 0; k < 2; ++k) \
            acc[ai][bj][m][n] = __builtin_amdgcn_mfma_f32_16x16x32_f16(__builtin_bit_cast(h16x8, Bt[n][k]), __builtin_bit_cast(h16x8, At[m][k]), acc[ai][bj][m][n], 0, 0, 0); } \
        __builtin_amdgcn_s_setprio(0); } while (0)
#define PG8_GOFF(tab, h, i) ((unsigned)(pg8_umin((unsigned)((tab)[128 * (h) + 64 * (i) + RR[0]]) >> 3, Sched::NROWS - 1u) * Sched::ROWB + (unsigned)CC[0] * 2u))
#define AO(tab, h, i) ({ unsigned o_; if constexpr (Sched::DENSE_A) o_ = oC[0][i]; else o_ = PG8_GOFF(tab, h, i); o_; })
#define BH1(bufoff, p0, p1) do { if constexpr (Sched::SPLIT_B) PG8_STAGEB1(bufoff, p1); else PG8_STAGEB(bufoff, (p0) + hstepB); } while (0)
#define AH1(p) (Sched::DENSE_A ? (p) + hstepA : (p))
#define PG8_WAIT_V(n) asm volatile("s_waitcnt vmcnt(" #n ")" ::: "memory")
#define PG8_WAIT_L(n) asm volatile("s_waitcnt lgkmcnt(" #n ")" ::: "memory")
#define PG8_BAR __builtin_amdgcn_s_barrier()
#define PG8_SCHED __builtin_amdgcn_sched_barrier(0)
    constexpr int VMX = 8 + (Epi::VM_MIN > 55 ? 55 : Epi::VM_MIN);
    Unit cur, nxt; int ui = 0;
    if (!S.next(0, cur)) return;
    f32x4 acc[2][2][4][2];
#pragma unroll
    for (int a = 0; a < 2; ++a)
#pragma unroll
        for (int b = 0; b < 2; ++b)
#pragma unroll
            for (int m = 0; m < 4; ++m)
#pragma unroll
                for (int n = 0; n < 2; ++n) acc[a][b][m][n] = (f32x4){0.f, 0.f, 0.f, 0.f};
    bf16x8 At[4][2], B0[2][2], B1[2][2];
    unsigned oC[2][2] = {{0u, 0u}, {0u, 0u}};
    const PG8_LAS int* tabC = nullptr; const PG8_LAS int* tabN = nullptr;
    if constexpr (Sched::PREFETCH_A) { S.prefetch_rows(cur, wave); PG8_WAIT_V(0); PG8_BAR; }
    if constexpr (Sched::DENSE_A) S.aoff(cur, RR, CC, oC); else tabC = S.table(cur);
    const size_t hstepA = Sched::DENSE_A ? (size_t)(unsigned)__builtin_amdgcn_readfirstlane((int)(oC[1][0] - oC[0][0])) : 0;
    const char* cA = cur.A; const char* cB = cur.B;
    voffB[0] = (unsigned)(RB[0] * cur.ldb + CC[0]) * 2u; voffB[1] = (unsigned)(RB[1] * cur.ldb + CC[1]) * 2u; hstepB = (size_t)HALF * cur.ldb * 2;
    const char* cB1 = cB;
    if constexpr (Sched::SPLIT_B) { cB1 = cur.B1; voffB1 = cur.mir ? pg8_mirror_off(voffB[0], cur.ldb) : voffB[0]; dB1 = cur.mir ? -(long)(64 * cur.ldb * 2) : (long)(64 * cur.ldb * 2); }
    PG8_STAGEB(PG8_SB(0, 0), cB); BH1(PG8_SB(0, 1), cB, cB1); PG8_STAGEA(PG8_SA(0, 0), cA, AO(tabC, 0, 0), AO(tabC, 0, 1)); PG8_STAGEA(PG8_SA(0, 1), AH1(cA), AO(tabC, 1, 0), AO(tabC, 1, 1));
    if (wr == 1) PG8_BAR;
    PG8_WAIT_V(2); PG8_BAR;
    PG8_STAGEB(PG8_SB(1, 0), cB + kstep); PG8_STAGEA(PG8_SA(1, 0), cA + kstep, AO(tabC, 0, 0), AO(tabC, 0, 1)); BH1(PG8_SB(1, 1), cB + kstep, cB1 + kstep);
    PG8_WAIT_V(6); PG8_BAR;
    for (;;) {
        const bool has_next = S.next(ui + 1, nxt);
        const char* nA = has_next ? nxt.A : cA; const char* nB = has_next ? nxt.B : cB;
        const char* nB1 = cB1; if constexpr (Sched::SPLIT_B) nB1 = has_next ? nxt.B1 : cB1;
        const int ntm2 = __builtin_amdgcn_readfirstlane(cur.nt - 2);
        if constexpr (Sched::PREFETCH_A) { if (has_next) S.prefetch_rows(nxt, wave); }
        if constexpr (!Sched::DENSE_A) tabN = has_next ? S.table(nxt) : tabC;
        if constexpr (Epi::PREFETCH) E.prefetch(cur, wave);
        for (int t = 0; t <= ntm2; t += 2) {
            const bool last = (t == ntm2);
            const bool fresh = (t == 0) && (ui > 0);
            const char* a1 = cA + (size_t)(t + 1) * kstep;
            const char* a2 = last ? nA : cA + (size_t)(t + 2) * kstep; const char* b2 = last ? nB : cB + (size_t)(t + 2) * kstep;
            const char* a3 = a2 + kstep; const char* b3 = b2 + kstep;
            const char* b21 = b2; const char* b31 = b3; if constexpr (Sched::SPLIT_B) { b21 = last ? nB1 : cB1 + (size_t)(t + 2) * kstep; b31 = b21 + kstep; }
            const PG8_LAS int* tabX = last ? tabN : tabC;
            if constexpr (Sched::SPLIT_B) { if (last && has_next) { voffB1 = nxt.mir ? pg8_mirror_off(voffB[0], nxt.ldb) : voffB[0]; dB1 = nxt.mir ? -(long)(64 * nxt.ldb * 2) : (long)(64 * nxt.ldb * 2); } }
            if constexpr (!Sched::CONST_LDB) { if (last && has_next) { voffB[0] = (unsigned)(RB[0] * nxt.ldb + CC[0]) * 2u; voffB[1] = (unsigned)(RB[1] * nxt.ldb + CC[1]) * 2u; hstepB = (size_t)HALF * nxt.ldb * 2; } }
            PG8_LDB(B0, 0, 0); PG8_LDB(B1, 0, 1); PG8_SCHED; PG8_LDA(At, 0, 0); PG8_STAGEA(PG8_SA(1, 1), AH1(a1), AO(tabC, 1, 0), AO(tabC, 1, 1));
            if (VMX > 8 && fresh) pg8_wait_vm<VMX>(); else PG8_WAIT_V(8);
            PG8_WAIT_L(0); PG8_BAR; PG8_MMA(0, 0, At, B0); PG8_MMA(0, 1, At, B1); PG8_BAR; PG8_SCHED;
            PG8_LDA(At, 0, 1); PG8_STAGEB(PG8_SB(0, 0), b2); BH1(PG8_SB(0, 1), b2, b21); PG8_STAGEA(PG8_SA(0, 0), a2, AO(tabX, 0, 0), AO(tabX, 0, 1));
            if (VMX > 8 && fresh) pg8_wait_vm<VMX>(); else PG8_WAIT_V(8);
            PG8_WAIT_L(0); PG8_BAR; PG8_MMA(1, 0, At, B0); PG8_MMA(1, 1, At, B1); PG8_BAR; PG8_SCHED;
            PG8_LDB(B0, 1, 0); PG8_LDB(B1, 1, 1); PG8_SCHED; PG8_LDA(At, 1, 0); PG8_STAGEA(PG8_SA(0, 1), AH1(a2), AO(tabX, 1, 0), AO(tabX, 1, 1));
            PG8_WAIT_V(8); PG8_WAIT_L(0); PG8_BAR; PG8_MMA(0, 0, At, B0); PG8_MMA(0, 1, At, B1); PG8_BAR; PG8_SCHED;
            PG8_LDA(At, 1, 1); PG8_STAGEB(PG8_SB(1, 0), b3); BH1(PG8_SB(1, 1), b3, b31); PG8_STAGEA(PG8_SA(1, 0), a3, AO(tabX, 0, 0), AO(tabX, 0, 1));
            PG8_WAIT_V(8); PG8_WAIT_L(0); PG8_BAR; PG8_MMA(1, 0, At, B0); PG8_MMA(1, 1, At, B1); PG8_BAR; PG8_SCHED;
        }
        if (wr == 0) PG8_BAR;
        if constexpr (Sched::FP8) asm volatile("s_nop 7\n\ts_nop 7\n\ts_nop 7" ::: "memory");
        { unsigned z2_ = 0u; asm volatile("" : "+v"(z2_)); const int l2_ = (int)__builtin_amdgcn_mbcnt_hi(~0u, __builtin_amdgcn_mbcnt_lo(~0u, z2_)); int fr_e = l2_ & 15, fq_e = l2_ >> 4;
          E(acc, cur, wr, wc, fr_e, fq_e); }
        if (!has_next) break;
#pragma unroll
        for (int a = 0; a < 2; ++a)
#pragma unroll
            for (int b = 0; b < 2; ++b)
#pragma unroll
                for (int m = 0; m < 4; ++m)
#pragma unroll
                    for (int n = 0; n < 2; ++n) acc[a][b][m][n] = (f32x4){0.f, 0.f, 0.f, 0.f};
        cur = nxt; cA = nA; cB = nB; cB1 = nB1; ++ui;
        tabC = tabN;
        if (wr == 1) PG8_BAR;
    }
    PG8_WAIT_V(0);
    PG8_BAR;
#undef PG8_SA
#undef PG8_SB
#undef PG8_STAGEA
#undef PG8_STAGEB
#undef PG8_STAGEB1
#undef BH1
#undef PG8_LDA
#undef PG8_LDB
#undef PG8_MMA
#undef OX
#undef OCH
#undef AH1
#undef PG8_WAIT_V
#undef PG8_WAIT_L
#undef PG8_BAR
#undef PG8_SCHED
}
}
constexpr int NWAVES = 8;
constexpr int NX = 32768, NC = 2048, NT = NX + NC, DM = 1024, NBATCH = 8, SEQ = 4096, LCTX = 256, DEPTH = 4;
constexpr int MODW = 6 * DM;
constexpr int NEXP = 64, TOPK = 6, DEXP = 256;
constexpr int ECAP = NT;
constexpr int PMAX = NT * TOPK + NEXP * 256;
constexpr float EPS_RMS = 1e-6f;
constexpr float QSCALE = 0.125f * 1.4426950408889634f;
constexpr float LOG2E = 1.4426950408889634f;

constexpr size_t al256(size_t x) { return (x + 255) & ~(size_t)255; }
constexpr size_t WS_CTL = 0;
constexpr size_t WS_MOD = 1u << 20;
constexpr size_t CTL_ZERO_BYTES = 2u << 20;
constexpr size_t WS_ROPE = CTL_ZERO_BYTES;
constexpr size_t WS_EVUV = WS_ROPE + 8192;
constexpr size_t WS_EVF = WS_EVUV + (size_t)2 * 1024 * 1024 * 2;
constexpr size_t WS_EVOUT = WS_EVF + (size_t)2 * 1024 * 1024 * 2;
constexpr size_t WS_EVWS = WS_EVOUT + (size_t)2 * 1024 * 1024 * 2;
constexpr size_t WS_ODIN = WS_EVWS + (size_t)2 * 4 * 128 * 128 * 2;
constexpr size_t WS_ODOUT = WS_ODIN + (size_t)2 * 2304 * 1024 * 2;
constexpr size_t WS_RS = WS_ODOUT + (size_t)2 * 1024 * 1024 * 2;
constexpr size_t WS_SHDN = WS_RS + (size_t)4 * 768 * 1024 * 2;
constexpr size_t WS_DFT = WS_SHDN + (size_t)4 * 1024 * 256 * 2;
constexpr size_t WS_DFTC = WS_DFT + (size_t)4096 * 8192 * 2;
constexpr size_t WS_EGU = WS_DFTC + (size_t)256 * 512 * 2;
constexpr size_t WS_EDN = WS_EGU + (size_t)64 * 512 * 1024 * 2;
constexpr size_t WS_XH = WS_EDN + (size_t)64 * 1024 * 256 * 2;
constexpr size_t WS_H = WS_XH + (size_t)NT * DM * 2;
constexpr size_t WS_PROJ = WS_H + (size_t)NT * DM * 2;
constexpr size_t PJ_UV = 0;
constexpr size_t PJ_GT = PJ_UV + (size_t)NT * 1024 * 2;
constexpr size_t PJ_GTC = PJ_GT + (size_t)8 * 1024 * 4096 * 2;
constexpr size_t PJ_PQ = PJ_GTC + (size_t)8 * 1024 * 256 * 2;
constexpr size_t PJ_NY = PJ_PQ + (size_t)8 * 2 * 2048 * 512 * 2;
constexpr size_t PJ_EVEN_END = PJ_NY + (size_t)8 * 512 * 4;
constexpr size_t PJ_Q = 0;
constexpr size_t PJ_KV = PJ_Q + (size_t)NT * 512 * 2;
constexpr size_t PJ_VT = PJ_KV + (size_t)NT * 256 * 2;
constexpr size_t PJ_VTC = PJ_VT + (size_t)8 * 2 * 64 * 4096 * 2;
constexpr size_t PJ_GZ = PJ_VTC + (size_t)8 * 2 * 64 * 256 * 2;
constexpr size_t PJ_GO = PJ_GZ + (size_t)NT * 512 * 2;
constexpr size_t PJ_ODD_END = PJ_GO + (size_t)NT * 512 * 2;
constexpr size_t PJ_HMID_END = (size_t)PMAX * 256 * 2;
constexpr size_t cmax(size_t a, size_t b) { return a > b ? a : b; }
constexpr size_t PROJ_BYTES = al256(cmax(cmax(PJ_EVEN_END, PJ_ODD_END), PJ_HMID_END));
constexpr size_t WS_LOG = WS_PROJ + PROJ_BYTES;
constexpr size_t WS_HS = WS_LOG + (size_t)NT * 64 * 4;
constexpr size_t WS_RTOK = WS_HS + (size_t)NT * 256 * 2;
constexpr size_t WS_RGATE = WS_RTOK + (size_t)NEXP * ECAP * 4;
constexpr size_t WS_YS = WS_RGATE + (size_t)NEXP * ECAP * 4;
constexpr size_t WS_H8 = WS_YS + (size_t)NT * TOPK * DM;
constexpr size_t WS_MIX = WS_YS;
constexpr size_t WS_END = WS_YS + (size_t)NT * TOPK * DM * 2;
static_assert(WS_END < (size_t)1040 * 1000 * 1000, "workspace budget");

constexpr int CW_TMO = 0;
constexpr int CW_BAR = 4096;
constexpr int CW_CNT = 16384;
constexpr int CW_CVQ = 17408;

constexpr int RING_BYTES = 131072;
constexpr int MISC_OFF = 139264;
constexpr int LDS_BYTES = 147456;

#define GAS __attribute__((address_space(1)))
#define LAS __attribute__((address_space(3)))
typedef unsigned short bf16;
typedef unsigned v4u __attribute__((ext_vector_type(4)));
typedef unsigned v2u __attribute__((ext_vector_type(2)));
typedef float f32x4 __attribute__((ext_vector_type(4)));
typedef float f32x2 __attribute__((ext_vector_type(2)));
typedef float f32x16 __attribute__((ext_vector_type(16)));
typedef short bf16x8 __attribute__((ext_vector_type(8)));
typedef short s16x4 __attribute__((ext_vector_type(4)));
typedef GAS unsigned gu32;
#define RLX_AGENT __ATOMIC_RELAXED, __HIP_MEMORY_SCOPE_AGENT
#define LDS_WAIT() asm volatile("s_waitcnt lgkmcnt(0)" ::: "memory")
#define VM_WAIT() asm volatile("s_waitcnt vmcnt(0)" ::: "memory")
typedef _Float16 h16x2 __attribute__((ext_vector_type(2)));
__device__ __forceinline__ unsigned f2bf(float f) { return (unsigned)__builtin_bit_cast(unsigned short, (_Float16)f); }
__device__ __forceinline__ unsigned pk2(float lo, float hi) { f32x2 v = {lo, hi}; return __builtin_bit_cast(unsigned, __builtin_convertvector(v, h16x2)); }
__device__ __forceinline__ float bf2f(unsigned short b) { return (float)__builtin_bit_cast(_Float16, b); }
__device__ __forceinline__ float bflo(unsigned w) { return (float)__builtin_bit_cast(h16x2, w)[0]; }
__device__ __forceinline__ float bfhi(unsigned w) { return (float)__builtin_bit_cast(h16x2, w)[1]; }
constexpr float YS_SCALE = 8.0f, YS_INV = 1.0f / 8.0f;
constexpr float HM_SCALE = 16.0f, WD_SCALE = 64.0f, DN_INV = 1.0f / (16.0f * 64.0f);
__device__ __forceinline__ float clamp8(float v) { return __builtin_amdgcn_fmed3f(v, -440.0f, 440.0f); }
__device__ __forceinline__ unsigned fp8x4(const f32x4 a) { unsigned x = 0u; x = __builtin_amdgcn_cvt_pk_fp8_f32(clamp8(a[0]), clamp8(a[1]), x, false); x = __builtin_amdgcn_cvt_pk_fp8_f32(clamp8(a[2]), clamp8(a[3]), x, true); return x; }
constexpr float WUV_SCALE = 64.0f, WF_SCALE = 32.0f, UV_INV = 1.0f / (4.0f * 64.0f), FO_INV = 1.0f / (4.0f * 32.0f);
constexpr float MIX_SCALE = 4.0f, WO_SCALE = 64.0f, MO_INV = 1.0f / (4.0f * 64.0f);
constexpr float WI_SCALE = 64.0f, OD_INV = 1.0f / (4.0f * 64.0f);
constexpr float DFT_SCALE = 8192.0f, FO_SCALE = 4.0f, PQ_INV = 1.0f / (8192.0f * 4.0f);
constexpr float H8_SCALE = 4.0f, WG_SCALE = 64.0f, GU_INV = 1.0f / (4.0f * 64.0f);
__device__ __forceinline__ unsigned mix8x4(float a, float b, float c, float d) { return fp8x4((f32x4){a, b, c, d} * MIX_SCALE); }
__device__ __forceinline__ float fast_exp2(float x) { return __builtin_amdgcn_exp2f(x); }
__device__ __forceinline__ float fast_rcp(float x) { return __builtin_amdgcn_rcpf(x); }
__device__ __forceinline__ float silu_f(float x) { return x * fast_rcp(1.0f + fast_exp2(-LOG2E * x)); }
__device__ __forceinline__ float sigmoid_f(float x) { return fast_rcp(1.0f + fast_exp2(-LOG2E * x)); }
__device__ __forceinline__ float gelu_f(float x) { const float z = 0.7978845608028654f * (x + 0.044715f * x * x * x); return x * fast_rcp(1.0f + fast_exp2(-2.0f * LOG2E * z)); }
template <int M> __device__ __forceinline__ float swz_xor(float v) { return __builtin_bit_cast(float, __builtin_amdgcn_ds_swizzle(__builtin_bit_cast(int, v), (M << 10) | 0x1f)); }
__device__ __forceinline__ float x32_other(float v) { unsigned z = 0u; asm volatile("" : "+v"(z)); const int l = (int)__builtin_amdgcn_mbcnt_hi(~0u, __builtin_amdgcn_mbcnt_lo(~0u, z)); return __builtin_bit_cast(float, __builtin_amdgcn_ds_bpermute((l ^ 32) << 2, __builtin_bit_cast(int, v))); }
__device__ __forceinline__ float x32_sum(float v) { return v + x32_other(v); }
__device__ __forceinline__ float x32_max(float v) { return fmaxf(v, x32_other(v)); }
__device__ __forceinline__ float wave_sum(float v) { v += swz_xor<1>(v); v += swz_xor<2>(v); v += swz_xor<4>(v); v += swz_xor<8>(v); v += swz_xor<16>(v); return x32_sum(v); }

__device__ __forceinline__ int lane_id_now() { unsigned z = 0u; asm volatile("" : "+v"(z)); return (int)__builtin_amdgcn_mbcnt_hi(~0u, __builtin_amdgcn_mbcnt_lo(~0u, z)); }
#define XB_TMO      128
#define XB_XCNT(j)  (256  + 64 * (j))
#define XB_XSUB(j)  (1280 + 64 * (j))
#define XB_XGEN(j)  (2304 + 64 * (j))
#define XB_TOP      3328
#define XB_TOPGEN   3392
#define XCD_BAR_WORDS 3456
#define XB_SPIN_CAP (1u << 18)
__device__ __forceinline__ unsigned xb_ld(unsigned* p)              { return __hip_atomic_load(p, __ATOMIC_RELAXED, __HIP_MEMORY_SCOPE_AGENT); }
__device__ __forceinline__ unsigned xb_add(unsigned* p, unsigned v) { return __hip_atomic_fetch_add(p, v, __ATOMIC_RELAXED, __HIP_MEMORY_SCOPE_AGENT); }
__device__ __forceinline__ unsigned xb_xcc_id() { return (unsigned)__builtin_amdgcn_s_getreg((3 << 11) | 20) & 0xFu; }
#define XB_SPIN(cond, bar) do { unsigned _sp = 0; while (cond) { __builtin_amdgcn_s_sleep(1); \
    if ((++_sp & 255u) == 0u) { if (xb_ld(&(bar)[XB_TMO])) break; if (_sp > XB_SPIN_CAP) { atomicAdd(&(bar)[XB_TMO], 1u); break; } } } } while (0)
struct XcdBarrier { unsigned* bar; unsigned x; volatile LAS unsigned* st; int wave; };
__device__ __forceinline__ XcdBarrier xcd_barrier_post(unsigned* bar, volatile LAS unsigned* st) {
    XcdBarrier b; b.bar = bar; b.x = xb_xcc_id(); b.st = st; b.wave = __builtin_amdgcn_readfirstlane((int)threadIdx.x >> 6);
    if (threadIdx.x == 0) (void)xb_add(&bar[XB_XCNT(b.x)], 1u);
    return b;
}
__device__ __forceinline__ void xcd_barrier_complete(unsigned* bar, unsigned x, unsigned& nloc, unsigned& nx) {
    const unsigned G = gridDim.x * gridDim.y * gridDim.z;
    unsigned sum, cnt, mine, sp = 0u;
    for (;;) {
        sum = 0u; cnt = 0u; mine = 0u;
#pragma unroll
        for (unsigned j = 0; j < 16; ++j) { const unsigned c = xb_ld(&bar[XB_XCNT(j)]); sum += c; cnt += (c > 0u) ? 1u : 0u; mine = (j == x) ? c : mine; }
        if (sum == G) break;
        __builtin_amdgcn_s_sleep(1);
        if ((++sp & 255u) == 0u) { if (xb_ld(&bar[XB_TMO])) break; if (sp > XB_SPIN_CAP) { atomicAdd(&bar[XB_TMO], 1u); break; } }
    }
    nloc = mine > 0u ? mine : 1u; nx = cnt > 0u ? cnt : 1u;
}
__device__ __forceinline__ void xcd_barrier(const XcdBarrier& b) {
    asm volatile("s_waitcnt vmcnt(0)" ::: "memory");
    __syncthreads();
    if (b.wave == 0 && lane_id_now() == 0) {
        unsigned* bar = b.bar; unsigned bx_ = b.x; asm volatile("" : "+s"(bar), "+s"(bx_));
        __builtin_amdgcn_s_waitcnt(0);
        unsigned nloc = b.st[0], nx = b.st[1];
        if (nloc == 0u) { xcd_barrier_complete(bar, bx_, nloc, nx); b.st[0] = nloc; b.st[1] = nx; }
        const unsigned old = xb_add(&bar[XB_XSUB(bx_)], 1u);
        const unsigned gen = old / nloc;
        if (old + 1u == (gen + 1u) * nloc) {
            __builtin_amdgcn_fence(__ATOMIC_RELEASE, "agent");
            asm volatile("s_waitcnt vmcnt(0)" ::: "memory");
            const unsigned og = xb_add(&bar[XB_TOP], 1u);
            const unsigned tg = og / nx;
            if (og + 1u == (tg + 1u) * nx) xb_add(&bar[XB_TOPGEN], 1u);
            else XB_SPIN(xb_ld(&bar[XB_TOPGEN]) == tg, bar);
            __builtin_amdgcn_fence(__ATOMIC_ACQUIRE, "agent");
            xb_add(&bar[XB_XGEN(bx_)], 1u);
            asm volatile("s_waitcnt vmcnt(0)" ::: "memory");
        } else {
            XB_SPIN(xb_ld(&bar[XB_XGEN(bx_)]) == gen, bar);
            __builtin_amdgcn_fence(__ATOMIC_ACQUIRE, "agent");
            asm volatile("s_waitcnt vmcnt(0)" ::: "memory");
        }
    }
    __syncthreads();
}

struct Frame {
    LAS unsigned char* lds;
    volatile LAS unsigned* MISC;
    unsigned* ctl;
    int tid, lane, wave, G, bx;
    const float* const* in;
    float* out; unsigned char* ws;
};
enum { I_X = 0, I_C, I_CTX, I_CCTX, I_ADAW, I_ADAB, I_N1G, I_N2G, I_EVWIN, I_EVWS, I_EVBS, I_EVWOUT, I_ODWIN, I_ODQG, I_ODKG, I_ODSINK, I_ODCONV, I_ODWOUT,
       I_RW, I_RB, I_EG, I_EU, I_ED, I_SG, I_SU, I_SD };
template <class T> __device__ __forceinline__ T* wsp(const Frame& F, size_t off) { return (T*)(F.ws + off); }
__device__ __forceinline__ int cond_of(int r) { return r < NX ? (r >> 12) : 8; }
__device__ __forceinline__ const float* modp(const Frame& F, int l, int cond, int piece) { return wsp<const float>(F, WS_MOD) + ((size_t)(l * 9 + cond) * MODW + piece * DM); }

#define PHASE_FRAME(Fp, F0) Frame Fp = F0; { int l_ = lane_id_now(); asm volatile("" : "+v"(l_)); Fp.lane = l_; Fp.tid = F0.wave * 64 + l_; }
__device__ __forceinline__ void cvt_tile64(const float* srcp, size_t spitch, bf16* dst, size_t dpitch, int j0, int k0, LAS float* scr, int lane_) {
    int lane = lane_; asm volatile("" : "+v"(lane));
    const int kq = lane >> 4, c4 = lane & 15;
    const float* p = srcp ? srcp + (size_t)(k0 + kq) * spitch : nullptr;
    LAS float* w = scr + kq * 65 + 4 * c4;
#pragma unroll
    for (int it = 0; it < 16; ++it) { f32x4 v = (f32x4){0.f, 0.f, 0.f, 0.f}; if (p) { v = *(const GAS f32x4*)p; p += 4 * spitch; }
        w[0] = v.x; w[1] = v.y; w[2] = v.z; w[3] = v.w; w += 4 * 65; }
    LDS_WAIT(); asm volatile("" ::: "memory");
    const int c = lane & 7;
#pragma unroll
    for (int i = 0; i < 8; ++i) { const int r = (lane >> 3) + 8 * i; const LAS float* s = scr + (8 * c) * 65 + r;
        v4u o; o.x = pk2(s[0], s[65]); o.y = pk2(s[130], s[195]); o.z = pk2(s[260], s[325]); o.w = pk2(s[390], s[455]);
        *(GAS v4u*)(dst + (size_t)(j0 + r) * dpitch + k0 + 8 * c) = o; }
    LDS_WAIT(); asm volatile("" ::: "memory");
}
__device__ __forceinline__ void cvt_tile64_f8(const float* srcp, size_t spitch, unsigned char* dst8, size_t dpitch, int j0, int k0, LAS float* scr, int lane_, float scale) {
    int lane = lane_; asm volatile("" : "+v"(lane));
    const int kq = lane >> 4, c4 = lane & 15;
    const float* p = srcp + (size_t)(k0 + kq) * spitch;
    LAS float* w = scr + kq * 65 + 4 * c4;
#pragma unroll
    for (int it = 0; it < 16; ++it) { const f32x4 v = *(const GAS f32x4*)p; p += 4 * spitch; w[0] = v.x; w[1] = v.y; w[2] = v.z; w[3] = v.w; w += 4 * 65; }
    LDS_WAIT(); asm volatile("" ::: "memory");
    const int c = lane & 3;
#pragma unroll
    for (int i = 0; i < 4; ++i) { const int r = (lane >> 2) + 16 * i; const LAS float* s = scr + (16 * c) * 65 + r; v4u o;
#pragma unroll
        for (int q = 0; q < 4; ++q) { unsigned x = 0u;
            x = __builtin_amdgcn_cvt_pk_fp8_f32(fminf(fmaxf(s[(4 * q) * 65] * scale, -440.f), 440.f), fminf(fmaxf(s[(4 * q + 1) * 65] * scale, -440.f), 440.f), x, false);
            x = __builtin_amdgcn_cvt_pk_fp8_f32(fminf(fmaxf(s[(4 * q + 2) * 65] * scale, -440.f), 440.f), fminf(fmaxf(s[(4 * q + 3) * 65] * scale, -440.f), 440.f), x, true); o[q] = x; }
        *(GAS v4u*)(dst8 + (size_t)(j0 + r) * dpitch + k0 + 16 * c) = o; }
    LDS_WAIT(); asm volatile("" ::: "memory");
}
__device__ __forceinline__ int odin_col(int j) {
    const int U = j >> 8, cpos = j & 255, bj = cpos >> 7, wc = (cpos >> 5) & 3, fq = (cpos >> 3) & 3, n = (cpos >> 2) & 1, e = cpos & 3;
    const int d = 32 * n + 16 * bj + 4 * fq + e;
    if (U < 2) return (4 * U + wc) * 64 + d;
    if (U == 2) return wc < 2 ? 512 + wc * 64 + d : 640 + (wc - 2) * 64 + d;
    if (U < 7) { const int ch = 128 * (U - 3) + (cpos & 127); return bj ? 1792 + ch : 768 + ch; }
    return 1280 + 256 * (U - 7) + cpos;
}
constexpr int CV_EVUV = 2 * 16 * 16, CV_EVOUT = 2 * 16 * 16, CV_ODIN = 2 * 36 * 16, CV_ODOUT = 2 * 16 * 16, CV_RS = 4 * 12 * 16, CV_SHDN = 4 * 16 * 4;
constexpr int CV_TOTAL = CV_EVUV + CV_EVOUT + CV_ODIN + CV_ODOUT + CV_RS + CV_SHDN;
__device__ __forceinline__ void p0_convert_item(const Frame& F, int it, LAS float* scr) {
    const int lane = F.lane;
    if (it < CV_EVUV) { const int e = it / 256, r = it % 256, jb = r / 16, kb = r % 16;
        cvt_tile64_f8(F.in[I_EVWIN] + (size_t)e * 1024 * 1536 + jb * 64 + 4 * (lane & 15), 1536, wsp<unsigned char>(F, WS_EVUV) + (size_t)e * 1024 * 1024, 1024, jb * 64, kb * 64, scr, lane, 64.0f); return; }
    it -= CV_EVUV;
    if (it < CV_EVOUT) { const int e = it / 256, r = it % 256, jb = r / 16, kb = r % 16;
        cvt_tile64_f8(F.in[I_EVWOUT] + (size_t)e * 1024 * 1024 + jb * 64 + 4 * (lane & 15), 1024, wsp<unsigned char>(F, WS_EVOUT) + (size_t)e * 1024 * 1024, 1024, jb * 64, kb * 64, scr, lane, 64.0f); return; }
    it -= CV_EVOUT;
    if (it < CV_ODIN) { const int o = it / 576, r = it % 576, jb = r / 16, kb = r % 16;
        cvt_tile64_f8(F.in[I_ODWIN] + (size_t)o * 1024 * 2304 + odin_col(jb * 64 + 4 * (lane & 15)), 2304, wsp<unsigned char>(F, WS_ODIN) + (size_t)o * 2304 * 1024, 1024, jb * 64, kb * 64, scr, lane, 64.0f); return; }
    it -= CV_ODIN;
    if (it < CV_ODOUT) { const int o = it / 256, r = it % 256, jb = r / 16, kb = r % 16;
        cvt_tile64_f8(F.in[I_ODWOUT] + (size_t)o * 1024 * 1024 + jb * 64 + 4 * (lane & 15), 1024, wsp<unsigned char>(F, WS_ODOUT) + (size_t)o * 1024 * 1024, 1024, jb * 64, kb * 64, scr, lane, 64.0f); return; }
    it -= CV_ODOUT;
    if (it < CV_RS) { const int l = it / 192, r = it % 192, jb = r / 16, kb = r % 16; const int j = jb * 64 + 4 * (lane & 15), t = j >> 8, cpos = j & 255, bj = cpos >> 7, cc = cpos & 127;
        const float* sp;
        if (t < 2) sp = (bj ? F.in[I_SU] : F.in[I_SG]) + (size_t)l * 1024 * 256 + 128 * t + cc;
        else sp = (cpos < 64) ? F.in[I_RW] + (size_t)l * 1024 * 64 + cpos : nullptr;
        cvt_tile64(sp, t < 2 ? 256 : 64, wsp<bf16>(F, WS_RS) + (size_t)l * 768 * 1024, 1024, jb * 64, kb * 64, scr, lane); return; }
    it -= CV_RS;
    { const int l = it / 64, r = it % 64, jb = r / 4, kb = r % 4;
        cvt_tile64(F.in[I_SD] + (size_t)l * 256 * 1024 + jb * 64 + 4 * (lane & 15), 1024, wsp<bf16>(F, WS_SHDN) + (size_t)l * 1024 * 256, 256, jb * 64, kb * 64, scr, lane); }
}
constexpr int CVX_GU = 64 * 8 * 16, CVX_DN = 64 * 16 * 4, CVX_TOTAL = CVX_GU + CVX_DN;
__device__ __forceinline__ void expert_convert_item(const Frame& F, int l, int it, LAS float* scr) {
    const int lane = F.lane;
    if (it < CVX_GU) { const int e = it / 128, r = it % 128, jb = r / 16, kb = r % 16; const int j = jb * 64 + 4 * (lane & 15), t = j >> 8, bj = (j >> 7) & 1, cc = j & 127;
        const float* sp = (bj ? F.in[I_EU] : F.in[I_EG]) + ((size_t)(l * 64 + e) * 1024) * 256 + 128 * t + cc;
        cvt_tile64_f8(sp, 256, wsp<unsigned char>(F, WS_EGU) + (size_t)e * 512 * 1024, 1024, jb * 64, kb * 64, scr, lane, 64.0f); return; }
    it -= CVX_GU;
    { const int e = it / 64, r = it % 64, jb = r / 4, kb = r % 4;
        cvt_tile64_f8(F.in[I_ED] + ((size_t)(l * 64 + e) * 256) * 1024 + jb * 64 + 4 * (lane & 15), 1024, wsp<unsigned char>(F, WS_EDN) + (size_t)e * 1024 * 256, 256, jb * 64, kb * 64, scr, lane, 64.0f); }
}
__device__ __forceinline__ void expert_convert_steal(const Frame& F0, int l, int quota_chunks) {
    PHASE_FRAME(F, F0);
    LAS float* scr = (LAS float*)(F.lds + F.wave * 16640);
    unsigned* ctr = F.ctl + CW_CVQ + 64 * l;
    for (int q = 0; quota_chunks < 0 || q < quota_chunks; ++q) {
        unsigned it0 = 0; if (F.lane == 0) it0 = atomicAdd(ctr, 4u);
        it0 = (unsigned)__builtin_amdgcn_readfirstlane((int)it0);
        if (it0 >= (unsigned)CVX_TOTAL) break;
#pragma unroll 1
        for (int j = 0; j < 4; ++j) if (it0 + j < (unsigned)CVX_TOTAL) expert_convert_item(F, l, (int)(it0 + j), scr);
    }
}
__device__ __forceinline__ void p0_fold_item(const Frame& F, int it, LAS float* scr) {
    const int lane = F.lane, e = it / 256, g = (it / 64) & 3, kb = it & 63;
    LAS float* wt = scr;
    LAS float* tab = scr + 2048;
    const float* src = F.in[I_EVWIN] + (size_t)e * 1024 * 1536 + (size_t)(kb * 16) * 1536 + 1024 + 128 * g;
#pragma unroll
    for (int i = 0; i < 32; ++i) { const int idx = i * 64 + lane, kk = idx >> 7, c = idx & 127; wt[idx] = src[(size_t)kk * 1536 + c]; }
#pragma unroll
    for (int i = 0; i < 2; ++i) { const int a = i * 64 + lane; tab[a] = __builtin_amdgcn_cosf((float)a * (1.0f / 128.0f)); tab[128 + a] = __builtin_amdgcn_sinf((float)a * (1.0f / 128.0f)); }
    LDS_WAIT(); asm volatile("" ::: "memory");
    bf16* dst = wsp<bf16>(F, WS_EVF) + (size_t)e * 1024 * 1024;
#pragma unroll 1
    for (int i = 0; i < 4; ++i) {
        const int ml = lane + 64 * i, k2 = ml >> 1, cs = ml & 1;
        float acc[16];
#pragma unroll
        for (int kk = 0; kk < 16; ++kk) acc[kk] = 0.f;
#pragma unroll 2
        for (int c = 0; c < 128; c += 4) { const float t0 = tab[cs * 128 + ((c * k2) & 127)], t1 = tab[cs * 128 + (((c + 1) * k2) & 127)], t2 = tab[cs * 128 + (((c + 2) * k2) & 127)], t3 = tab[cs * 128 + (((c + 3) * k2) & 127)];
#pragma unroll
            for (int kk = 0; kk < 16; ++kk) { const f32x4 w4 = *(const LAS f32x4*)(wt + kk * 128 + c); acc[kk] += (t0 * w4.x + t1 * w4.y) + (t2 * w4.z + t3 * w4.w); } }
        v4u o;
#pragma unroll
        for (int q = 0; q < 4; ++q) o[q] = fp8x4((f32x4){acc[4 * q], acc[4 * q + 1], acc[4 * q + 2], acc[4 * q + 3]} * WF_SCALE);
        *(GAS v4u*)(wsp<unsigned char>(F, WS_EVF) + (size_t)e * 1024 * 1024 + (size_t)(g * 256 + ml) * 1024 + kb * 16) = o;
    }
    LDS_WAIT(); asm volatile("" ::: "memory");
}
__device__ __forceinline__ void p0_mod_item(const Frame& F, int it) {
    const int l = it >> 6, cg = it & 63, tid = F.tid;
    LAS float* s = (LAS float*)F.lds;
    LAS float* red = (LAS float*)F.lds + 9 * 1024;
#pragma unroll
    for (int j = 0; j < 18; ++j) { const int idx = tid + 512 * j, i = idx >> 10, k = idx & 1023; const float v = i < 8 ? F.in[I_C][i * 1024 + k] : F.in[I_CCTX][k]; s[idx] = silu_f(v); }
    __syncthreads();
    if (tid < 384) {
        const int kl = tid / 24, c4 = tid % 24;
        const float* w = F.in[I_ADAW] + (size_t)l * 1024 * MODW + (size_t)cg * 96 + c4 * 4;
        f32x4 acc[9];
#pragma unroll
        for (int i = 0; i < 9; ++i) acc[i] = (f32x4){0.f, 0.f, 0.f, 0.f};
#pragma unroll 16
        for (int st = 0; st < 64; ++st) { const int k = st * 16 + kl; const f32x4 wv = *(const GAS f32x4*)(w + (size_t)k * MODW);
#pragma unroll
            for (int i = 0; i < 9; ++i) acc[i] += wv * s[i * 1024 + k]; }
#pragma unroll
        for (int i = 0; i < 9; ++i) *(LAS f32x4*)(red + (kl * 9 + i) * 96 + c4 * 4) = acc[i];
    }
    __syncthreads();
    for (int idx = tid; idx < 9 * 96; idx += 512) { const int i = idx / 96, c = idx % 96; float v = F.in[I_ADAB][l * MODW + cg * 96 + c];
#pragma unroll
        for (int kl = 0; kl < 16; ++kl) v += red[(kl * 9 + i) * 96 + c];
        wsp<float>(F, WS_MOD)[(size_t)(l * 9 + i) * MODW + cg * 96 + c] = v; }
    __syncthreads();
}
__device__ __forceinline__ void p0_prologue(const Frame& F0) {
    PHASE_FRAME(F, F0);
    for (int it = F.bx; it < 256; it += F.G) p0_mod_item(F, it);
    LAS float* scr = (LAS float*)(F.lds + F.wave * 16640);
    const int gw = F.bx * NWAVES + F.wave, NGW = F.G * NWAVES;
    for (int it = gw; it < CV_TOTAL + 512; it += NGW) { if (it < CV_TOTAL) p0_convert_item(F, it, scr); else p0_fold_item(F, it - CV_TOTAL, scr); }
    { const float* src = F.in[I_EVWS]; bf16* dst = wsp<bf16>(F, WS_EVWS);
      for (int i = F.bx * 512 + F.tid; i < 2 * 4 * 128 * 128 / 4; i += F.G * 512) { const f32x4 v = *(const GAS f32x4*)(src + (size_t)i * 4); v2u o; o.x = pk2(v.x, v.y); o.y = pk2(v.z, v.w); *(GAS v2u*)(dst + (size_t)i * 4) = o; } }
    { unsigned char* dst = wsp<unsigned char>(F, WS_DFT);     const float alpha = 0.0013810679320049757f;
      for (int i = F.bx * 512 + F.tid; i < 2048 * 4096 / 8; i += F.G * 512) { const int k1 = i >> 9, c0 = (i & 511) * 8, cs = c0 >> 11, n0 = c0 & 2047; float v[8];
#pragma unroll
          for (int j = 0; j < 8; ++j) { const float rev = (float)((k1 * (n0 + j)) & 4095) * (1.0f / 4096.0f); v[j] = cs ? -alpha * __builtin_amdgcn_sinf(rev) : alpha * __builtin_amdgcn_cosf(rev); }
          v2u o; o.x = fp8x4((f32x4){v[0], v[1], v[2], v[3]} * DFT_SCALE); o.y = fp8x4((f32x4){v[4], v[5], v[6], v[7]} * DFT_SCALE); *(GAS v2u*)(dst + (size_t)i * 8) = o; } }
    { bf16* dst = wsp<bf16>(F, WS_DFTC); const float alpha = 0.005524271728019903f;
      for (int i = F.bx * 512 + F.tid; i < 256 * 512 / 8; i += F.G * 512) { const int k1 = i >> 6, c0 = (i & 63) * 8, cs = c0 >> 8, n0 = c0 & 255; float v[8];
#pragma unroll
          for (int j = 0; j < 8; ++j) { const float rev = (float)((k1 * (n0 + j)) & 255) * (1.0f / 256.0f); v[j] = cs ? -alpha * __builtin_amdgcn_sinf(rev) : alpha * __builtin_amdgcn_cosf(rev); }
          v4u o; o.x = pk2(v[0], v[1]); o.y = pk2(v[2], v[3]); o.z = pk2(v[4], v[5]); o.w = pk2(v[6], v[7]); *(GAS v4u*)(dst + (size_t)i * 8) = o; } }
    if (F.bx == 0) for (int i = F.tid; i < 1024; i += 512) { const int P = i >> 4, f = i & 15; const float inv = fast_exp2(-(float)f * (2.0f / 32.0f) * 13.287712379549449f);
        float rev = (float)P * inv * 0.15915494309189535f; rev -= floorf(rev);
        wsp<float>(F, WS_ROPE)[i] = __builtin_amdgcn_cosf(rev); wsp<float>(F, WS_ROPE)[1024 + i] = __builtin_amdgcn_sinf(rev); }
}
__device__ __forceinline__ void norm_phase(const Frame& F0, int l, int nrows, bool first, const float* g, int piece_shift, int piece_scale, bool w16, bool f8out) {
    PHASE_FRAME(F, F0);
    const int gw = F.bx * NWAVES + F.wave, NGW = F.G * NWAVES, lane = F.lane;
    bf16* H = wsp<bf16>(F, WS_H); const bf16* XH = wsp<const bf16>(F, WS_XH);
    const int per = (nrows + NGW - 1) / NGW, r0 = gw * per, r1 = (r0 + per < nrows) ? r0 + per : nrows;
    f32x4 MA[2][2], MB[2][2]; int pc = -1;
#pragma unroll
    for (int j = 0; j < 2; ++j)
#pragma unroll
        for (int q = 0; q < 2; ++q) { MA[j][q] = (f32x4){0.f, 0.f, 0.f, 0.f}; MB[j][q] = MA[j][q]; }
    v4u nw[2] = {(v4u){0u, 0u, 0u, 0u}, (v4u){0u, 0u, 0u, 0u}};
    if (!first && r0 < r1) { const bf16* xr = XH + (size_t)r0 * DM + 8 * lane; nw[0] = *(const GAS v4u*)xr; nw[1] = *(const GAS v4u*)(xr + 512); }
    f32x4 nf[2][2] = {{(f32x4){0.f, 0.f, 0.f, 0.f}, (f32x4){0.f, 0.f, 0.f, 0.f}}, {(f32x4){0.f, 0.f, 0.f, 0.f}, (f32x4){0.f, 0.f, 0.f, 0.f}}};
    if (first && r0 < r1) { const float* xr = (r0 < NX ? F.in[I_X] + (size_t)r0 * DM : F.in[I_CTX] + (size_t)(r0 - NX) * DM) + 8 * lane;
#pragma unroll
        for (int j = 0; j < 2; ++j) { nf[j][0] = *(const GAS f32x4*)(xr + 512 * j); nf[j][1] = *(const GAS f32x4*)(xr + 512 * j + 4); } }
    for (int rv = r0; rv < r1; ++rv) {
        const int r = __builtin_amdgcn_readfirstlane(rv);
        f32x4 v[2][2]; float s = 0.f;
        if (first) {
#pragma unroll
            for (int j = 0; j < 2; ++j) { v[j][0] = nf[j][0]; v[j][1] = nf[j][1]; }
            if (rv + 1 < r1) { const int rn = r + 1; const float* xn = (rn < NX ? F.in[I_X] + (size_t)rn * DM : F.in[I_CTX] + (size_t)(rn - NX) * DM) + 8 * lane;
#pragma unroll
                for (int j = 0; j < 2; ++j) { nf[j][0] = *(const GAS f32x4*)(xn + 512 * j); nf[j][1] = *(const GAS f32x4*)(xn + 512 * j + 4); } } }
        else {
#pragma unroll
            for (int j = 0; j < 2; ++j) { const v4u w = nw[j]; v[j][0] = (f32x4){bflo(w.x), bfhi(w.x), bflo(w.y), bfhi(w.y)}; v[j][1] = (f32x4){bflo(w.z), bfhi(w.z), bflo(w.w), bfhi(w.w)}; }
            if (rv + 1 < r1) { const bf16* xn = XH + (size_t)(r + 1) * DM + 8 * lane; nw[0] = *(const GAS v4u*)xn; nw[1] = *(const GAS v4u*)(xn + 512); } }
#pragma unroll
        for (int j = 0; j < 2; ++j)
#pragma unroll
            for (int q = 0; q < 2; ++q) s += (v[j][q].x * v[j][q].x + v[j][q].y * v[j][q].y) + (v[j][q].z * v[j][q].z + v[j][q].w * v[j][q].w);
        const float rstd = 1.0f / sqrtf(wave_sum(s) * (1.0f / DM) + EPS_RMS);
        const int cond = cond_of(r);
        if (cond != pc) { pc = cond;
            const float* gp = g + 8 * lane; const float* sh = modp(F, l, cond, piece_shift) + 8 * lane; const float* sc = modp(F, l, cond, piece_scale) + 8 * lane;
#pragma unroll
            for (int j = 0; j < 2; ++j)
#pragma unroll
                for (int q = 0; q < 2; ++q) { const f32x4 gg = *(const GAS f32x4*)(gp + 512 * j + 4 * q), a = *(const GAS f32x4*)(sc + 512 * j + 4 * q); MB[j][q] = *(const GAS f32x4*)(sh + 512 * j + 4 * q); MA[j][q] = gg * (a + 1.0f); } }
        bf16* orow = H + (size_t)r * DM + 8 * lane;
#pragma unroll
        for (int j = 0; j < 2; ++j) { f32x4 y[2];
#pragma unroll
            for (int q = 0; q < 2; ++q) y[q] = v[j][q] * rstd * MA[j][q] + MB[j][q];
            v4u o; o.x = pk2(y[0].x, y[0].y); o.y = pk2(y[0].z, y[0].w); o.z = pk2(y[1].x, y[1].y); o.w = pk2(y[1].z, y[1].w); if (w16) *(GAS v4u*)(orow + 512 * j) = o;
            if (f8out) { v2u o8; o8.x = fp8x4(y[0] * H8_SCALE); o8.y = fp8x4(y[1] * H8_SCALE); *(GAS v2u*)(wsp<unsigned char>(F, WS_H8) + (size_t)r * DM + 8 * lane + 512 * j) = o8; } }
    }
}

__device__ __forceinline__ void topk_rows(const Frame& F0, int l, int r0) {
    PHASE_FRAME(F, F0);
    volatile LAS unsigned* hist = F.MISC + 64; volatile LAS unsigned* base = F.MISC + 128;
    const int tid = F.tid;
    if (tid < 64) hist[tid] = 0u;
    __syncthreads();
    int ex[TOPK]; float gt[TOPK]; unsigned lp[TOPK];
    float lv[TOPK], ls[TOPK]; int li[TOPK];
    { const int half = tid >> 8, tok = tid & 255;
        const float* lg = wsp<const float>(F, WS_LOG) + (size_t)(r0 + tok) * 64 + 32 * half;
        const float* rb = F.in[I_RB] + l * 64 + 32 * half;
        float sc[32], bs[32];
#pragma unroll
        for (int q = 0; q < 8; ++q) { const f32x4 v = *(const GAS f32x4*)(lg + 4 * q); const f32x4 b = *(const GAS f32x4*)(rb + 4 * q);
            sc[4 * q + 0] = sigmoid_f(v.x); sc[4 * q + 1] = sigmoid_f(v.y); sc[4 * q + 2] = sigmoid_f(v.z); sc[4 * q + 3] = sigmoid_f(v.w);
            bs[4 * q + 0] = sc[4 * q + 0] + b.x; bs[4 * q + 1] = sc[4 * q + 1] + b.y; bs[4 * q + 2] = sc[4 * q + 2] + b.z; bs[4 * q + 3] = sc[4 * q + 3] + b.w; }
#pragma unroll
        for (int k = 0; k < TOPK; ++k) {
            float best = -3.0e38f; int bi = 0; float bsc = 0.f;
#pragma unroll
            for (int e = 0; e < 32; ++e) { const bool tk = bs[e] > best; best = tk ? bs[e] : best; bi = tk ? e : bi; bsc = tk ? sc[e] : bsc; }
#pragma unroll
            for (int e = 0; e < 32; ++e) bs[e] = (e == bi) ? -3.0e38f : bs[e];
            lv[k] = best; ls[k] = bsc; li[k] = bi + 32 * half;
        }
        LAS float* xch = (LAS float*)F.lds;
        if (half == 1) {
#pragma unroll
            for (int k = 0; k < TOPK; ++k) { xch[tok * 18 + k] = lv[k]; xch[tok * 18 + 6 + k] = ls[k]; xch[tok * 18 + 12 + k] = __builtin_bit_cast(float, li[k]); } }
    }
    __syncthreads();
    if (tid < 256) {
        const LAS float* xch = (const LAS float*)F.lds + tid * 18;
        float bv[TOPK], bsv_[TOPK]; int bix[TOPK];
#pragma unroll
        for (int k = 0; k < TOPK; ++k) { bv[k] = xch[k]; bsv_[k] = xch[6 + k]; bix[k] = __builtin_bit_cast(int, xch[12 + k]); }
        float gsum = 0.f; int ia = 0, ib = 0;
#pragma unroll
        for (int k = 0; k < TOPK; ++k) {
            float av = -3.0e38f, as_ = 0.f, bvv = -3.0e38f, bss = 0.f; int ai = 0, bi2 = 0;
#pragma unroll
            for (int q = 0; q < TOPK; ++q) { if (q == ia) { av = lv[q]; as_ = ls[q]; ai = li[q]; } if (q == ib) { bvv = bv[q]; bss = bsv_[q]; bi2 = bix[q]; } }
            const bool ta = av >= bvv;
            ex[k] = ta ? ai : bi2; gt[k] = ta ? as_ : bss; gsum += gt[k]; ia += ta ? 1 : 0; ib += ta ? 0 : 1;
        }
        const float inv = 2.5f / (gsum + 1e-20f);
#pragma unroll
        for (int k = 0; k < TOPK; ++k) { gt[k] *= inv; lp[k] = atomicAdd((unsigned*)(hist + ex[k]), 1u); }
    }
    __syncthreads();
    if (tid < 64) { const unsigned c = hist[tid]; base[tid] = c ? atomicAdd(F.ctl + CW_CNT + l * 64 + tid, c) : 0u; }
    __syncthreads();
    if (tid < 256) {
        int* rtok = wsp<int>(F, WS_RTOK); float* rgate = wsp<float>(F, WS_RGATE);
#pragma unroll
        for (int k = 0; k < TOPK; ++k) { const size_t p = (size_t)ex[k] * ECAP + base[ex[k]] + lp[k]; rtok[p] = (r0 + tid) * 8 + k; rgate[p] = gt[k]; }
    }
    __syncthreads();
}

__device__ __forceinline__ void conv_phase(const Frame& F0, int o, int nrows) {
    PHASE_FRAME(F, F0);
    const bf16* GZ = wsp<const bf16>(F, WS_PROJ + PJ_GZ); const bf16* GO = wsp<const bf16>(F, WS_PROJ + PJ_GO); bf16* MIX = wsp<bf16>(F, WS_MIX);
    const float* cw = F.in[I_ODCONV] + (size_t)o * 3 * 512;
    const int total = nrows * 64;
    for (int i = F.bx * 512 + F.tid; i < total; i += F.G * 512) {
        const int r = i >> 6, c0 = (i & 63) * 8;
        const int pos = r < NX ? (r & (SEQ - 1)) : ((r - NX) & (LCTX - 1)), L = r < NX ? SEQ : LCTX;
        const v4u z1 = *(const GAS v4u*)(GZ + (size_t)r * 512 + c0);
        v4u z0 = (v4u){0u, 0u, 0u, 0u}, z2 = (v4u){0u, 0u, 0u, 0u};
        if (pos > 0) z0 = *(const GAS v4u*)(GZ + (size_t)(r - 1) * 512 + c0);
        if (pos < L - 1) z2 = *(const GAS v4u*)(GZ + (size_t)(r + 1) * 512 + c0);
        const v4u go = *(const GAS v4u*)(GO + (size_t)r * 512 + c0);
        const f32x4 w0a = *(const GAS f32x4*)(cw + c0), w0b = *(const GAS f32x4*)(cw + c0 + 4);
        const f32x4 w1a = *(const GAS f32x4*)(cw + 512 + c0), w1b = *(const GAS f32x4*)(cw + 512 + c0 + 4);
        const f32x4 w2a = *(const GAS f32x4*)(cw + 1024 + c0), w2b = *(const GAS f32x4*)(cw + 1024 + c0 + 4);
        float y[8];
#pragma unroll
        for (int q = 0; q < 4; ++q) {
            const float wl0 = q < 2 ? w0a[2 * q] : w0b[2 * q - 4], wh0 = q < 2 ? w0a[2 * q + 1] : w0b[2 * q - 3];
            const float wl1 = q < 2 ? w1a[2 * q] : w1b[2 * q - 4], wh1 = q < 2 ? w1a[2 * q + 1] : w1b[2 * q - 3];
            const float wl2 = q < 2 ? w2a[2 * q] : w2b[2 * q - 4], wh2 = q < 2 ? w2a[2 * q + 1] : w2b[2 * q - 3];
            y[2 * q] = bflo(go[q]) * (wl0 * bflo(z0[q]) + wl1 * bflo(z1[q]) + wl2 * bflo(z2[q]));
            y[2 * q + 1] = bfhi(go[q]) * (wh0 * bfhi(z0[q]) + wh1 * bfhi(z1[q]) + wh2 * bfhi(z2[q]));
        }
        v2u ov; ov.x = mix8x4(y[0], y[1], y[2], y[3]); ov.y = mix8x4(y[4], y[5], y[6], y[7]);
        *(GAS v2u*)((unsigned char*)MIX + (size_t)r * DM + 512 + c0) = ov;
    }
}

__device__ __forceinline__ void gmlp_phase(const Frame& F0, int e, int nchunks) {
    PHASE_FRAME(F, F0);
    const bf16* UV = wsp<const bf16>(F, WS_PROJ + PJ_UV); bf16* MIX = wsp<bf16>(F, WS_MIX);
    const bf16* WSB = wsp<const bf16>(F, WS_EVWS) + (size_t)e * 4 * 128 * 128;
    const float* bsv = F.in[I_EVBS] + (size_t)e * 4 * 128;
    LAS bf16* VT = (LAS bf16*)F.lds;
    const int lane = F.lane, w = F.wave, fr = lane & 15, fq = lane >> 4;
    const bool bal = (F.G == 256 && nchunks * 4 == 1088);
    const int it0 = !bal ? F.bx : F.bx < 128 ? 5 * F.bx : F.bx < 240 ? 640 + 4 * (F.bx - 128) : 1088;
    const int itn = !bal ? nchunks * 4 : it0 + (F.bx < 128 ? 5 : F.bx < 240 ? 4 : 0), its = bal ? 1 : F.G;
    for (int it = it0; it < itn; it += its) {
        const int ch = it >> 2, g = it & 3, t0 = ch * 128;
        const int p = 16 * w + fr; const float bb = bsv[g * 128 + p]; v2u ug[8];
#pragma unroll
        for (int nt = 0; nt < 8; ++nt) ug[nt] = *(const GAS v2u*)(UV + (size_t)(t0 + p) * DM + 128 * g + 16 * nt + 4 * fq);
        { const int rs_ = lane >> 4, cl = lane & 15;
#pragma unroll
          for (int ps = 0; ps < 4; ++ps) { const int q = 16 * w + 4 * ps + rs_;
            const v4u pv = *(const GAS v4u*)(UV + (size_t)(t0 + q) * DM + 512 + 128 * g + 8 * cl);
            float x[8] = {bflo(pv.x), bfhi(pv.x), bflo(pv.y), bfhi(pv.y), bflo(pv.z), bfhi(pv.z), bflo(pv.w), bfhi(pv.w)};
            float s = ((x[0] + x[1]) + (x[2] + x[3])) + ((x[4] + x[5]) + (x[6] + x[7]));
            s += swz_xor<1>(s); s += swz_xor<2>(s); s += swz_xor<4>(s); s += swz_xor<8>(s);
            const float mu = s * (1.0f / 128.0f); float v2 = 0.f;
#pragma unroll
            for (int e = 0; e < 8; ++e) { x[e] -= mu; v2 += x[e] * x[e]; }
            v2 += swz_xor<1>(v2); v2 += swz_xor<2>(v2); v2 += swz_xor<4>(v2); v2 += swz_xor<8>(v2);
            const float rstd = 1.0f / sqrtf(v2 * (1.0f / 128.0f) + 1e-5f);
#pragma unroll
            for (int e = 0; e < 8; ++e) VT[(8 * cl + e) * 136 + q] = (bf16)f2bf(x[e] * rstd); } }
        __syncthreads();
        f32x4 acc[8];
#pragma unroll
        for (int nt = 0; nt < 8; ++nt) acc[nt] = (f32x4){0.f, 0.f, 0.f, 0.f};
        bf16x8 wf[4];
#pragma unroll
        for (int s = 0; s < 4; ++s) wf[s] = *(const GAS bf16x8*)(WSB + (size_t)(g * 128 + 16 * w + fr) * 128 + 32 * s + 8 * fq);
#pragma unroll
        for (int nt = 0; nt < 8; ++nt)
#pragma unroll
            for (int s = 0; s < 4; ++s) { const bf16x8 vf = *(const LAS bf16x8*)(VT + (16 * nt + fr) * 136 + 32 * s + 8 * fq);
                acc[nt] = __builtin_amdgcn_mfma_f32_16x16x32_f16(__builtin_bit_cast(pg8::h16x8, vf), __builtin_bit_cast(pg8::h16x8, wf[s]), acc[nt], 0, 0, 0); }
#pragma unroll
        for (int nt = 0; nt < 8; ++nt) { const size_t off = (size_t)(t0 + p) * DM + 128 * g + 16 * nt + 4 * fq; const v2u uu = ug[nt];
            *(GAS unsigned*)((unsigned char*)MIX + off) = mix8x4(bflo(uu.x) * (acc[nt][0] + bb), bfhi(uu.x) * (acc[nt][1] + bb), bflo(uu.y) * (acc[nt][2] + bb), bfhi(uu.y) * (acc[nt][3] + bb)); }
        __syncthreads();
    }
}
__device__ __forceinline__ void fourier_nyq_phase(const Frame& F0, int e) {
    PHASE_FRAME(F, F0);
    const unsigned char* WF = wsp<const unsigned char>(F, WS_EVF) + (size_t)e * 1024 * 1024; const unsigned char* H = wsp<const unsigned char>(F, WS_H8); float* NY = wsp<float>(F, WS_PROJ + PJ_NY);
    const int gw = F.bx * NWAVES + F.wave, NGW = F.G * NWAVES;
    for (int it = gw; it < 8 * 512; it += NGW) { const int b = it >> 9, n = it & 511;
        const v4u wv = *(const GAS v4u*)(WF + (size_t)(2 * n) * 1024 + 16 * F.lane), hv = *(const GAS v4u*)(H + (size_t)(b * SEQ + 2048) * DM + 16 * F.lane); float a = 0.f;
#pragma unroll
        for (int q = 0; q < 4; ++q) { const f32x2 w0 = __builtin_amdgcn_cvt_pk_f32_fp8((int)wv[q], false), w1 = __builtin_amdgcn_cvt_pk_f32_fp8((int)wv[q], true), h0 = __builtin_amdgcn_cvt_pk_f32_fp8((int)hv[q], false), h1 = __builtin_amdgcn_cvt_pk_f32_fp8((int)hv[q], true);
            a += (w0.x * h0.x + w0.y * h0.y) + (w1.x * h1.x + w1.y * h1.y); }
        a = wave_sum(a) * FO_INV;
        if (F.lane == 0) NY[it] = a; }
}
__device__ __forceinline__ void fourier_combine_phase(const Frame& F0) {
    PHASE_FRAME(F, F0);
    const bf16* PQ = wsp<const bf16>(F, WS_PROJ + PJ_PQ); bf16* MIX = wsp<bf16>(F, WS_MIX); const bf16* FO = wsp<const bf16>(F, WS_PROJ + PJ_GT); const float* NY = wsp<const float>(F, WS_PROJ + PJ_NY);
    const float alpha = 0.0013810679320049757f;
    const int NIT = 8 * 2048 * 64, STR = F.G * 512;
    for (int i0 = F.bx * 512 + F.tid; i0 < NIT; i0 += 4 * STR) {
        v4u pp[4], qq[4];
#pragma unroll
        for (int jj = 0; jj < 4; ++jj) { const int i = i0 + jj * STR; pp[jj] = (v4u){0u, 0u, 0u, 0u}; qq[jj] = pp[jj];
            if (i < NIT) { const int c8 = (i & 63) * 8, k1 = (i >> 6) & 2047, b = i >> 17;
                pp[jj] = *(const GAS v4u*)(PQ + ((size_t)(b * 2 + 0) * 2048 + k1) * 512 + c8); qq[jj] = *(const GAS v4u*)(PQ + ((size_t)(b * 2 + 1) * 2048 + k1) * 512 + c8); } }
        asm volatile("" ::: "memory");
#pragma unroll
        for (int jj = 0; jj < 4; ++jj) { const int i = i0 + jj * STR; if (i < NIT) { const int c8 = (i & 63) * 8, k1 = (i >> 6) & 2047, b = i >> 17; const v4u p = pp[jj], q = qq[jj];
        const float sg = (k1 & 1) ? -alpha : alpha; const f32x4 n0 = *(const GAS f32x4*)(NY + b * 512 + c8) * sg, n1 = *(const GAS f32x4*)(NY + b * 512 + c8 + 4) * sg;
        const float nyv[8] = {n0.x, n0.y, n0.z, n0.w, n1.x, n1.y, n1.z, n1.w};
        float sv[8], dv[8];
#pragma unroll
        for (int w = 0; w < 4; ++w) { const float pl = bflo(p[w]) + nyv[2 * w], ph = bfhi(p[w]) + nyv[2 * w + 1], ql = bflo(q[w]), qh = bfhi(q[w]); sv[2 * w] = pl + ql; sv[2 * w + 1] = ph + qh; dv[2 * w] = pl - ql; dv[2 * w + 1] = ph - qh; }
        v2u s, d; s.x = mix8x4(sv[0], sv[1], sv[2], sv[3]); s.y = mix8x4(sv[4], sv[5], sv[6], sv[7]); d.x = mix8x4(dv[0], dv[1], dv[2], dv[3]); d.y = mix8x4(dv[4], dv[5], dv[6], dv[7]);
        *(GAS v2u*)((unsigned char*)MIX + (size_t)(b * SEQ + k1) * DM + 512 + c8) = s;
        if (k1 > 0) *(GAS v2u*)((unsigned char*)MIX + (size_t)(b * SEQ + SEQ - k1) * DM + 512 + c8) = d; } }
    }
    const int gw = F.bx * NWAVES + F.wave, NGW = F.G * NWAVES;
    for (int it = gw; it < 8 * 512; it += NGW) { const int b = it >> 9, n = it & 511;
        const unsigned char* g = (const unsigned char*)FO + (size_t)(b * 512 + n) * 4096; float a = 0.f;
#pragma unroll
        for (int j = 0; j < 2; ++j) { const v4u v = *(const GAS v4u*)(g + (size_t)(j * 64 + F.lane) * 16);
#pragma unroll
            for (int w = 0; w < 4; ++w) { const f32x2 x0 = __builtin_amdgcn_cvt_pk_f32_fp8((int)v[w], false), x1 = __builtin_amdgcn_cvt_pk_f32_fp8((int)v[w], true); a += (x0.x - x0.y) + (x1.x - x1.y); } }
        a *= 1.0f / FO_SCALE;
        a = (wave_sum(a) + NY[it]) * alpha;
        if (F.lane == 0) ((unsigned char*)MIX)[(size_t)(b * SEQ + 2048) * DM + 512 + n] = (unsigned char)(mix8x4(a, 0.f, 0.f, 0.f) & 0xffu); }
}
__device__ __forceinline__ void attn_phase_frag(const Frame& F0, int o, bool ctx_queries) {
    PHASE_FRAME(F, F0);
    const bf16* Q = wsp<const bf16>(F, WS_PROJ + PJ_Q); const bf16* KB = wsp<const bf16>(F, WS_PROJ + PJ_KV);
    const bf16* VT = wsp<const bf16>(F, WS_PROJ + PJ_VT); const bf16* VTC = wsp<const bf16>(F, WS_PROJ + PJ_VTC);
    bf16* MIX = wsp<bf16>(F, WS_MIX);
    const int lane = F.lane, w = F.wave, r = lane & 31, hh = lane >> 5, g = w >> 1, half = w & 1;
    const int nunits = 512 + (ctx_queries ? 32 : 0);
    for (int u = F.bx; u < nunits; u += F.G) {
        int b, blk, hk, qrow0, qp0, nband, kt_lo;
        if (u < 512) { b = u >> 6; blk = (u >> 1) & 31; hk = u & 1; qp0 = blk * 128 + 64 * half; qrow0 = b * SEQ + qp0;
            kt_lo = qp0 >= 128 ? (qp0 - 128) >> 5 : 0; int kt_hi = ((qp0 + 191) >> 5) + 1; kt_hi = kt_hi > 128 ? 128 : kt_hi; nband = kt_hi - kt_lo; }
        else { const int v = u - 512; b = v >> 2; blk = (v >> 1) & 1; hk = v & 1; qp0 = 0; qrow0 = NX + b * LCTX + blk * 128 + 64 * half; nband = 0; kt_lo = 0; }
        const int h = hk * 4 + g;
        bf16x8 qf[2][4];
#pragma unroll
        for (int qg = 0; qg < 2; ++qg)
#pragma unroll
            for (int s = 0; s < 4; ++s) qf[qg][s] = *(const GAS bf16x8*)(Q + (size_t)(qrow0 + 32 * qg + r) * 512 + h * 64 + 16 * s + 8 * hh);
        const float sink2 = F.in[I_ODSINK][o * 8 + h] * LOG2E;
        float m[2] = {sink2, sink2}, lsum[2] = {hh == 0 ? 1.0f : 0.0f, hh == 0 ? 1.0f : 0.0f};
        f32x16 oacc[2][2];
#pragma unroll
        for (int qg = 0; qg < 2; ++qg)
#pragma unroll
            for (int dh = 0; dh < 2; ++dh)
#pragma unroll
                for (int i = 0; i < 16; ++i) oacc[qg][dh][i] = 0.f;
        const int ntiles = nband + 8;
#pragma unroll 1
        for (int ti = 0; ti < ntiles; ++ti) {
            const bool band = ti < nband;
            const int kpos0 = band ? (kt_lo + ti) * 32 : 0;
            const int krow = band ? b * SEQ + kpos0 : NX + b * LCTX + (ti - nband) * 32;
            const bf16* vbase = band ? VT + (size_t)((b * 2 + hk) * 64) * SEQ + kpos0 : VTC + (size_t)((b * 2 + hk) * 64) * LCTX + (ti - nband) * 32;
            const int vpitch = band ? SEQ : LCTX;
            f32x16 sacc[2];
#pragma unroll
            for (int qg = 0; qg < 2; ++qg)
#pragma unroll
                for (int i = 0; i < 16; ++i) sacc[qg][i] = 0.f;
#pragma unroll
            for (int s = 0; s < 4; ++s) { const bf16x8 kf = *(const GAS bf16x8*)(KB + (size_t)(krow + r) * 128 + hk * 64 + 16 * s + 8 * hh);
                sacc[0] = __builtin_amdgcn_mfma_f32_32x32x16_f16(__builtin_bit_cast(pg8::h16x8, kf), __builtin_bit_cast(pg8::h16x8, qf[0][s]), sacc[0], 0, 0, 0);
                sacc[1] = __builtin_amdgcn_mfma_f32_32x32x16_f16(__builtin_bit_cast(pg8::h16x8, kf), __builtin_bit_cast(pg8::h16x8, qf[1][s]), sacc[1], 0, 0, 0); }
            bf16x8 vf[2][2];
#pragma unroll
            for (int dh = 0; dh < 2; ++dh)
#pragma unroll
                for (int s2 = 0; s2 < 2; ++s2) { const bf16* vp = vbase + (size_t)(32 * dh + r) * vpitch + 16 * s2 + 4 * hh;
                    const s16x4 lo = *(const GAS s16x4*)vp, hi = *(const GAS s16x4*)(vp + 8);
                    vf[dh][s2] = (bf16x8){lo[0], lo[1], lo[2], lo[3], hi[0], hi[1], hi[2], hi[3]}; }
#pragma unroll
            for (int qg = 0; qg < 2; ++qg) {
                if (band && (kpos0 < qp0 - 65 || kpos0 > qp0 + 97)) { const int qpos = qp0 + 32 * qg + r;
#pragma unroll
                    for (int i = 0; i < 16; ++i) { const int kpos = kpos0 + (i & 3) + 8 * (i >> 2) + 4 * hh; const int dlt = kpos - qpos; sacc[qg][i] = (dlt > 128 || dlt < -128) ? -1.0e30f : sacc[qg][i]; } }
                float tm = sacc[qg][0];
#pragma unroll
                for (int i = 1; i < 16; ++i) tm = fmaxf(tm, sacc[qg][i]);
                tm = x32_max(tm);
                const float mn = fmaxf(m[qg], tm), alpha = fast_exp2(m[qg] - mn); const bool same = __all(mn == m[qg]); m[qg] = mn;
                float ps = 0.f; float p[16];
#pragma unroll
                for (int i = 0; i < 16; ++i) { p[i] = fast_exp2(sacc[qg][i] - mn); ps += p[i]; }
                lsum[qg] = lsum[qg] * alpha + ps;
                if (!same) {
#pragma unroll
                for (int dh = 0; dh < 2; ++dh)
#pragma unroll
                    for (int i = 0; i < 16; ++i) oacc[qg][dh][i] *= alpha; }
#pragma unroll
                for (int s2 = 0; s2 < 2; ++s2) {
                    unsigned pw[4];
#pragma unroll
                    for (int j = 0; j < 4; ++j) pw[j] = pk2(p[8 * s2 + 2 * j], p[8 * s2 + 2 * j + 1]);
                    const v4u pv4 = (v4u){pw[0], pw[1], pw[2], pw[3]}; const bf16x8 pf = __builtin_bit_cast(bf16x8, pv4);
                    oacc[qg][0] = __builtin_amdgcn_mfma_f32_32x32x16_f16(__builtin_bit_cast(pg8::h16x8, vf[0][s2]), __builtin_bit_cast(pg8::h16x8, pf), oacc[qg][0], 0, 0, 0);
                    oacc[qg][1] = __builtin_amdgcn_mfma_f32_32x32x16_f16(__builtin_bit_cast(pg8::h16x8, vf[1][s2]), __builtin_bit_cast(pg8::h16x8, pf), oacc[qg][1], 0, 0, 0);
                }
            }
        }
#pragma unroll
        for (int qg = 0; qg < 2; ++qg) {
            const float lt = x32_sum(lsum[qg]), inv = 1.0f / lt;
            bf16* orow = MIX + (size_t)(qrow0 + 32 * qg + r) * DM + h * 64;
#pragma unroll
            for (int dh = 0; dh < 2; ++dh)
#pragma unroll
                for (int t = 0; t < 4; ++t) { v2u ov; ov.x = pk2(oacc[qg][dh][4 * t] * inv, oacc[qg][dh][4 * t + 1] * inv); ov.y = pk2(oacc[qg][dh][4 * t + 2] * inv, oacc[qg][dh][4 * t + 3] * inv);
                    *(GAS v2u*)(orow + 32 * dh + 8 * t + 4 * hh) = ov; }
        }
    }
}
__device__ __forceinline__ float wave_max(float v) { v = fmaxf(v, swz_xor<1>(v)); v = fmaxf(v, swz_xor<2>(v)); v = fmaxf(v, swz_xor<4>(v)); v = fmaxf(v, swz_xor<8>(v)); v = fmaxf(v, swz_xor<16>(v)); return x32_max(v); }
__device__ __forceinline__ void attn_phase_naive(const Frame& F0, int o, bool ctx_queries) {
    PHASE_FRAME(F, F0);
    const bf16* Q = wsp<const bf16>(F, WS_PROJ + PJ_Q); const bf16* KB = wsp<const bf16>(F, WS_PROJ + PJ_KV);
    const bf16* VT = wsp<const bf16>(F, WS_PROJ + PJ_VT); const bf16* VTC = wsp<const bf16>(F, WS_PROJ + PJ_VTC);
    bf16* MIX = wsp<bf16>(F, WS_MIX);
    const int lane = F.lane;
    LAS float* pbuf = (LAS float*)F.lds + F.wave * 1024;
    LAS float* qbuf = pbuf + 768;
    const int gw = F.bx * NWAVES + F.wave, NGW = F.G * NWAVES;
    const int nq = (NX + (ctx_queries ? NC : 0)) * 8;
    for (int itv = gw; itv < nq; itv += NGW) {
        const int it = __builtin_amdgcn_readfirstlane(itv);
        const int row = it >> 3, h = it & 7, hk = h >> 2; const bool isx = row < NX;
        const int b = isx ? (row >> 12) : ((row - NX) >> 8), pos = row & 4095;
        int k0 = 0, nb = 0;
        if (isx) { k0 = pos >= 128 ? pos - 128 : 0; const int k1 = pos + 128 > 4095 ? 4095 : pos + 128; nb = k1 - k0 + 1; }
        const int total = nb + 256;
        qbuf[lane] = bf2f(Q[(size_t)row * 512 + h * 64 + lane]);
        LDS_WAIT(); asm volatile("" ::: "memory");
        const float sink2 = F.in[I_ODSINK][o * 8 + h] * LOG2E;
        float mx = sink2;
        for (int j = lane; j < total; j += 64) { const int krow = j < nb ? b * SEQ + k0 + j : NX + b * LCTX + (j - nb);
            const bf16* kp = KB + (size_t)krow * 128 + hk * 64; float s = 0.f;
#pragma unroll 8
            for (int d = 0; d < 64; ++d) s += qbuf[d] * bf2f(kp[d]);
            pbuf[j] = s; mx = fmaxf(mx, s); }
        mx = wave_max(mx);
        float ps = 0.f;
        for (int j = lane; j < total; j += 64) { const float p = fast_exp2(pbuf[j] - mx); pbuf[j] = p; ps += p; }
        const float den = wave_sum(ps) + fast_exp2(sink2 - mx);
        LDS_WAIT(); asm volatile("" ::: "memory");
        float ov = 0.f;
        const bf16* vb = VT + (size_t)((b * 2 + hk) * 64 + lane) * SEQ + k0; const bf16* vc = VTC + (size_t)((b * 2 + hk) * 64 + lane) * LCTX;
        for (int j = 0; j < nb; ++j) ov += pbuf[j] * bf2f(vb[j]);
        for (int j = 0; j < 256; ++j) ov += pbuf[nb + j] * bf2f(vc[j]);
        MIX[(size_t)row * DM + h * 64 + lane] = (bf16)f2bf(ov / den);
        LDS_WAIT(); asm volatile("" ::: "memory");
    }
}

__device__ __forceinline__ void attn_phase(const Frame& F0, int o, bool ctx_queries) {
    PHASE_FRAME(F, F0);
    const bf16* Q = wsp<const bf16>(F, WS_PROJ + PJ_Q); const bf16* KB = wsp<const bf16>(F, WS_PROJ + PJ_KV);
    const bf16* VT = wsp<const bf16>(F, WS_PROJ + PJ_VT); const bf16* VTC = wsp<const bf16>(F, WS_PROJ + PJ_VTC);
    bf16* MIX = wsp<bf16>(F, WS_MIX);
    const int lane = F.lane, w = F.wave, tid = F.tid, r = lane & 31, hh = lane >> 5, g = w >> 1, half = w & 1;
    const int nunits = 512 + (ctx_queries ? 32 : 0);
    float gq_ = fabsf(F.in[I_ODQG][o * 64 + lane]), gk_ = fabsf(F.in[I_ODKG][o * 64 + lane]);
    gq_ = fmaxf(gq_, swz_xor<1>(gq_)); gq_ = fmaxf(gq_, swz_xor<2>(gq_)); gq_ = fmaxf(gq_, swz_xor<4>(gq_)); gq_ = fmaxf(gq_, swz_xor<8>(gq_)); gq_ = fmaxf(gq_, swz_xor<16>(gq_)); gq_ = x32_max(gq_);
    gk_ = fmaxf(gk_, swz_xor<1>(gk_)); gk_ = fmaxf(gk_, swz_xor<2>(gk_)); gk_ = fmaxf(gk_, swz_xor<4>(gk_)); gk_ = fmaxf(gk_, swz_xor<8>(gk_)); gk_ = fmaxf(gk_, swz_xor<16>(gk_)); gk_ = x32_max(gk_);
    const float M0 = fmaxf(0.0f, 8.0f * LOG2E * gq_ * gk_ - 14.0f);
    const bool ldk = tid < 256; const int lt = ldk ? tid : tid - 256;
    for (int u = F.bx; u < nunits; u += F.G) {
        int b, blk, hk, qrow0, qp0, nband, kt_lo;
        if (u < 512) { b = u >> 6; blk = (u >> 1) & 31; hk = u & 1; qp0 = blk * 128 + 64 * half; qrow0 = b * SEQ + qp0;
            kt_lo = blk >= 1 ? blk * 4 - 4 : 0; int kt_hi = blk * 4 + 8; kt_hi = kt_hi > 128 ? 128 : kt_hi; nband = kt_hi - kt_lo; }
        else { const int v = u - 512; b = v >> 2; blk = (v >> 1) & 1; hk = v & 1; qp0 = 0; qrow0 = NX + b * LCTX + blk * 128 + 64 * half; nband = 0; kt_lo = 0; }
        const int h = hk * 4 + g;
        bf16x8 qf[2][4];
#pragma unroll
        for (int qg = 0; qg < 2; ++qg)
#pragma unroll
            for (int s = 0; s < 4; ++s) qf[qg][s] = *(const GAS bf16x8*)(Q + (size_t)(qrow0 + 32 * qg + r) * 512 + h * 64 + 16 * s + 8 * hh);
        const float sink2 = F.in[I_ODSINK][o * 8 + h] * LOG2E;
        const float sk_ = hh == 0 ? fast_exp2(sink2 - M0) : 0.0f; float lsum[2] = {sk_, sk_};
        f32x16 oacc[2][2];
#pragma unroll
        for (int qg = 0; qg < 2; ++qg)
#pragma unroll
            for (int dh = 0; dh < 2; ++dh)
#pragma unroll
                for (int i = 0; i < 16; ++i) oacc[qg][dh][i] = 0.f;
        const int ntiles = nband + 8;
#define ATT_SRC(ti_) ((ti_) < nband ? (ldk ? KB + (size_t)(b * SEQ + (kt_lo + (ti_)) * 32 + (lt >> 3)) * 128 + hk * 64 + 8 * (lt & 7) \
                                            : VT + (size_t)((b * 2 + hk) * 64 + (lt >> 2)) * SEQ + (kt_lo + (ti_)) * 32 + 8 * (lt & 3)) \
                                    : (ldk ? KB + (size_t)(NX + b * LCTX + ((ti_) - nband) * 32 + (lt >> 3)) * 128 + hk * 64 + 8 * (lt & 7) \
                                            : VTC + (size_t)((b * 2 + hk) * 64 + (lt >> 2)) * LCTX + ((ti_) - nband) * 32 + 8 * (lt & 3)))
        const int ldst = ldk ? (lt >> 3) * 144 + (lt & 7) * 16 : 4608 + (lt >> 2) * 80 + (lt & 3) * 16;
        __syncthreads();
        { const v4u pc = *(const GAS v4u*)ATT_SRC(0); *(LAS v4u*)(F.lds + ldst) = pc; }
        v4u nx = (v4u){0u, 0u, 0u, 0u}; if (ntiles > 1) nx = *(const GAS v4u*)ATT_SRC(1);
        __syncthreads();
#pragma unroll 1
        for (int ti = 0; ti < ntiles; ++ti) {
            const bool band = ti < nband;
            const int kpos0 = band ? (kt_lo + ti) * 32 : 0;
            v4u nx2 = (v4u){0u, 0u, 0u, 0u}; const bool more = ti + 1 < ntiles;
            if (ti + 2 < ntiles) nx2 = *(const GAS v4u*)ATT_SRC(ti + 2);
            const LAS unsigned char* set = F.lds + (ti & 1) * 10240;
            const bool mine = !band || (kpos0 + 31 >= qp0 - 128 && kpos0 <= qp0 + 191);
            if (mine) {
                f32x16 sacc[2];
#pragma unroll
                for (int qg = 0; qg < 2; ++qg)
#pragma unroll
                    for (int i = 0; i < 16; ++i) sacc[qg][i] = -M0;
#pragma unroll
                for (int s = 0; s < 4; ++s) { const bf16x8 kf = *(const LAS bf16x8*)(set + r * 144 + (16 * s + 8 * hh) * 2);
                    sacc[0] = __builtin_amdgcn_mfma_f32_32x32x16_f16(__builtin_bit_cast(pg8::h16x8, kf), __builtin_bit_cast(pg8::h16x8, qf[0][s]), sacc[0], 0, 0, 0);
                    sacc[1] = __builtin_amdgcn_mfma_f32_32x32x16_f16(__builtin_bit_cast(pg8::h16x8, kf), __builtin_bit_cast(pg8::h16x8, qf[1][s]), sacc[1], 0, 0, 0); }
                bf16x8 vf[2][2];
#pragma unroll
                for (int dh = 0; dh < 2; ++dh)
#pragma unroll
                    for (int s2 = 0; s2 < 2; ++s2) { const LAS unsigned char* vp = set + 4608 + (32 * dh + r) * 80 + (16 * s2 + 4 * hh) * 2;
                        const s16x4 lo = *(const LAS s16x4*)vp, hi = *(const LAS s16x4*)(vp + 16);
                        vf[dh][s2] = (bf16x8){lo[0], lo[1], lo[2], lo[3], hi[0], hi[1], hi[2], hi[3]}; }
#pragma unroll
                for (int qg = 0; qg < 2; ++qg) {
                    if (band && (kpos0 < qp0 - 65 || kpos0 > qp0 + 97)) { const int qpos = qp0 + 32 * qg + r;
#pragma unroll
                        for (int i = 0; i < 16; ++i) { const int kpos = kpos0 + (i & 3) + 8 * (i >> 2) + 4 * hh; const int dlt = kpos - qpos; sacc[qg][i] = (dlt > 128 || dlt < -128) ? -1.0e30f : sacc[qg][i]; } }
                    float ps = 0.f; float p[16];
#pragma unroll
                    for (int i = 0; i < 16; ++i) { p[i] = fast_exp2(sacc[qg][i]); ps += p[i]; }
                    lsum[qg] += ps;
#pragma unroll
                    for (int s2 = 0; s2 < 2; ++s2) {
                        unsigned pw[4];
#pragma unroll
                        for (int j = 0; j < 4; ++j) pw[j] = pk2(p[8 * s2 + 2 * j], p[8 * s2 + 2 * j + 1]);
                        const v4u pv4 = (v4u){pw[0], pw[1], pw[2], pw[3]}; const bf16x8 pf = __builtin_bit_cast(bf16x8, pv4);
                        oacc[qg][0] = __builtin_amdgcn_mfma_f32_32x32x16_f16(__builtin_bit_cast(pg8::h16x8, vf[0][s2]), __builtin_bit_cast(pg8::h16x8, pf), oacc[qg][0], 0, 0, 0);
                        oacc[qg][1] = __builtin_amdgcn_mfma_f32_32x32x16_f16(__builtin_bit_cast(pg8::h16x8, vf[1][s2]), __builtin_bit_cast(pg8::h16x8, pf), oacc[qg][1], 0, 0, 0);
                    }
                }
            }
            if (more) *(LAS v4u*)(F.lds + ((ti + 1) & 1) * 10240 + ldst) = nx;
            __syncthreads();
            nx = nx2;
        }
#undef ATT_SRC
#pragma unroll
        for (int qg = 0; qg < 2; ++qg) {
            const float lt2 = x32_sum(lsum[qg]), inv = 1.0f / lt2;
            unsigned char* orow = (unsigned char*)MIX + (size_t)(qrow0 + 32 * qg + r) * DM + h * 64;
#pragma unroll
            for (int dh = 0; dh < 2; ++dh)
#pragma unroll
                for (int t = 0; t < 4; ++t) *(GAS unsigned*)(orow + 32 * dh + 8 * t + 4 * hh) = mix8x4(oacc[qg][dh][4 * t] * inv, oacc[qg][dh][4 * t + 1] * inv, oacc[qg][dh][4 * t + 2] * inv, oacc[qg][dh][4 * t + 3] * inv);
        }
    }
}
using pg8::Unit;
typedef pg8::f32x4 (AccT)[2][2][4][2];
#define ROWL(ai, m) (128 * (ai) + 64 * wr + 16 * (m) + fr)
#define COL8(bj) (128 * (bj) + 32 * wc + 8 * fq)
__device__ __forceinline__ v4u pack8(const f32x4 a, const f32x4 b) { v4u w; w.x = pg8::cvt_pk_bf16(a[0], a[1]); w.y = pg8::cvt_pk_bf16(a[2], a[3]); w.z = pg8::cvt_pk_bf16(b[0], b[1]); w.w = pg8::cvt_pk_bf16(b[2], b[3]); return w; }
__device__ __forceinline__ void dense_aoff(int lda, const int (&R)[2], const int (&C)[2], unsigned (&off)[2][2]) {
#pragma unroll
    for (int h = 0; h < 2; ++h)
#pragma unroll
        for (int i = 0; i < 2; ++i) off[h][i] = (unsigned)((128 * h + R[i]) * lda + C[i]) * 2u;
}
__device__ __forceinline__ unsigned swz16u(unsigned v) { return (unsigned)__builtin_amdgcn_ds_swizzle((int)v, (16 << 10) | 0x1f); }
template <bool F8> struct SchedDenseT {
    static constexpr bool PREFETCH_A = false, FP8 = F8;
    static constexpr bool SPLIT_B = false, DENSE_A = true, CONST_LDB = true;
    const char* A; const char* B; int nM, nN, lda, ldbv, nt, G, c;
    __device__ __forceinline__ bool next(int i, Unit& u) const { const int L = i * G + c; if (L >= nM * nN) return false; int pm, pn; pg8::tile_order(L, nM, nN, pm, pn);
        u.A = A + (size_t)pm * 256 * lda * 2; u.B = B + (size_t)pn * 256 * ldbv * 2; u.nt = nt; u.ldb = ldbv; u.i0 = pm; u.i1 = pn; u.i2 = 0; u.i3 = 0; return true; }
    __device__ __forceinline__ void aoff(const Unit&, const int (&R)[2], const int (&C)[2], unsigned (&off)[2][2]) const { dense_aoff(lda, R, C, off); }
};
using SchedDense = SchedDenseT<false>;
struct SchedE1 {
    static constexpr bool PREFETCH_A = false, FP8 = true;
    static constexpr bool SPLIT_B = true, DENSE_A = true, CONST_LDB = true;
    const char* H; const char* WUV; const char* WF; int nMt  , G, c;
    __device__ __forceinline__ bool next(int i, Unit& u) const { int L = i * G + c; const int n0 = nMt * 4; if (L >= n0 + 512 + 32) return false; int pm, pn; u.nt = 8; u.ldb = 512; u.i3 = 0; u.mir = 0;
        if (L < n0) { pg8::tile_order(L, nMt, 4, pm, pn); u.A = H + (size_t)pm * 256 * 1024; u.B = WUV + (size_t)pn * 256 * 1024; u.B1 = u.B + (size_t)128 * 1024; u.i2 = 0; }
        else if (L < n0 + 512) { pg8::tile_order(L - n0, 4, 128, pm, pn); const int b = pn >> 4, j0 = (pn & 15) * 128;
            u.A = WF + (size_t)pm * 256 * 1024; u.B = H + (size_t)(b * SEQ + j0) * 1024; u.B1 = H + (size_t)(b * SEQ + SEQ - j0 - 127) * 1024; u.mir = 1; u.i2 = 2; }
        else { const int v = L - n0 - 512; pm = v & 3; pn = 128 + (v >> 2); u.A = WF + (size_t)pm * 256 * 1024; u.B = H + (size_t)pn * 256 * 1024; u.B1 = u.B + (size_t)128 * 1024; u.i2 = 1; }
        u.i0 = pm; u.i1 = pn; return true; }
    __device__ __forceinline__ void aoff(const Unit&, const int (&R)[2], const int (&C)[2], unsigned (&off)[2][2]) const { dense_aoff(512, R, C, off); }
};
struct EpiE1 {
    static constexpr int VM_MIN = 0; static constexpr bool PREFETCH = false;
    bf16* UV; bf16* FO; bf16* GTC;
    __device__ __forceinline__ void operator()(const AccT& acc, const Unit& u, int wr, int wc, int fr, int fq) const {
        if (u.i2 == 0) {
#pragma unroll
            for (int ai = 0; ai < 2; ++ai)
#pragma unroll
                for (int m = 0; m < 4; ++m) { bf16* rowp = UV + (size_t)(u.i0 * 256 + ROWL(ai, m)) * DM + u.i1 * 256;
#pragma unroll
                    for (int bj = 0; bj < 2; ++bj) { f32x4 a = acc[ai][bj][m][0], b = acc[ai][bj][m][1];
#pragma unroll
                        for (int j = 0; j < 4; ++j) { a[j] = gelu_f(a[j] * UV_INV); b[j] = gelu_f(b[j] * UV_INV); }
                        *(GAS v4u*)(rowp + COL8(bj)) = pack8(a, b); } }
        } else if (u.i2 == 2) {
            const int b = u.i1 >> 4, j0 = (u.i1 & 15) * 128, c = 32 * wc + 8 * fq;
            const bool cs = (fr & 1) != 0;
#pragma unroll
            for (int ai = 0; ai < 2; ++ai)
#pragma unroll
                for (int m = 0; m < 4; ++m) { const int mp = u.i0 * 256 + ROWL(ai, m);
                    f32x4 a = acc[ai][0][m][0], bq = acc[ai][0][m][1]; const f32x4 ma = acc[ai][1][m][0], mb = acc[ai][1][m][1];
                    if (cs) { a -= ma; bq -= mb; } else { a += ma; bq += mb; }
                    if (j0 + c == 0) a[0] = cs ? 0.f : acc[ai][0][m][0][0];
                    a *= FO_INV * FO_SCALE; bq *= FO_INV * FO_SCALE;
                    { v2u o8; o8.x = fp8x4(a); o8.y = fp8x4(bq); *(GAS v2u*)((unsigned char*)FO + ((size_t)(b * 512 + (mp >> 1)) * 4096 + (cs ? 2048 : 0) + j0 + c)) = o8; } }
        } else {
            bf16* base = GTC + (size_t)(u.i1 - 128) * 1024 * LCTX;
#pragma unroll
            for (int ai = 0; ai < 2; ++ai)
#pragma unroll
                for (int m = 0; m < 4; ++m) { bf16* rowp = base + (size_t)(u.i0 * 256 + ROWL(ai, m)) * LCTX;
#pragma unroll
                    for (int bj = 0; bj < 2; ++bj) *(GAS v4u*)(rowp + COL8(bj)) = pack8(acc[ai][bj][m][0] * FO_INV, acc[ai][bj][m][1] * FO_INV); }
        }
    }
};
template <bool CTX> struct SchedFourier {
    static constexpr bool PREFETCH_A = false, FP8 = !CTX;
    static constexpr bool SPLIT_B = false, DENSE_A = true, CONST_LDB = true;
    const char* DFT; const char* GT; int G, c;
    __device__ __forceinline__ bool next(int i, Unit& u) const { const int L = i * G + c; u.i3 = 0;
        if (!CTX) { if (L >= 256) return false; const int b = L & 7, j = L >> 3, pq = j & 1, pn = (j >> 1) & 1, pm = j >> 2;
            u.A = DFT + ((size_t)pm * 256 * 4096 + (size_t)pq * 2048); u.B = GT + (((size_t)b * 512 + (size_t)pn * 256) * 4096 + (size_t)pq * 2048); u.nt = 16; u.ldb = 2048;
            u.i0 = (b * 2 + pq) * 2048 + pm * 256; u.i1 = pn; u.i2 = 1; return true; }
        else { if (L >= 16) return false; const int b = L >> 1, pn = L & 1; u.A = DFT; u.B = GT + ((size_t)b * 1024 * LCTX + (size_t)pn * 256 * 512) * 2; u.nt = 8; u.ldb = 512; u.i0 = NX + b * LCTX; u.i1 = pn; u.i2 = 0; return true; } }
    __device__ __forceinline__ void aoff(const Unit&, const int (&R)[2], const int (&C)[2], unsigned (&off)[2][2]) const { dense_aoff(CTX ? 512 : 2048, R, C, off); }
};
template <bool CTX> struct EpiFourier {
    static constexpr int VM_MIN = 0; static constexpr bool PREFETCH = false;
    bf16* MIX; bf16* PQ;
    __device__ __forceinline__ void operator()(const AccT& acc, const Unit& u, int wr, int wc, int fr, int fq) const {
        if constexpr (!CTX) { bf16* base = PQ + (size_t)u.i0 * 512 + u.i1 * 256;
#pragma unroll
            for (int ai = 0; ai < 2; ++ai)
#pragma unroll
                for (int m = 0; m < 4; ++m) { bf16* rowp = base + (size_t)ROWL(ai, m) * 512;
#pragma unroll
                    for (int bj = 0; bj < 2; ++bj) *(GAS v4u*)(rowp + COL8(bj)) = pack8(acc[ai][bj][m][0] * PQ_INV, acc[ai][bj][m][1] * PQ_INV); }
        } else { unsigned char* base = (unsigned char*)MIX + (size_t)u.i0 * DM + 512 + u.i1 * 256;
#pragma unroll
            for (int ai = 0; ai < 2; ++ai)
#pragma unroll
                for (int m = 0; m < 4; ++m) { unsigned char* rowp = base + (size_t)ROWL(ai, m) * DM;
#pragma unroll
                    for (int bj = 0; bj < 2; ++bj) { v2u o; o.x = fp8x4(acc[ai][bj][m][0] * MIX_SCALE); o.y = fp8x4(acc[ai][bj][m][1] * MIX_SCALE); *(GAS v2u*)(rowp + COL8(bj)) = o; } }
        }
    }
};
template <bool MOE> struct EpiResid {
    static constexpr int VM_MIN = 0; static constexpr bool PREFETCH = !MOE;
    const float* srcf_x; const float* srcf_c;
    float* dstf;
    bf16* XH;
    const float* mod;
    const bf16* YS;
    unsigned pfl;
    __device__ __forceinline__ void prefetch(const Unit& u, int wave) const {
        if (pfl != 0u && srcf_x == nullptr) { const char* base = (const char*)(XH + (size_t)u.i0 * 256 * DM + u.i1 * 256); const int t = wave * 64 + lane_id_now();
#pragma unroll
            for (int j = 0; j < 2; ++j) { const int li = t + 512 * j; pg8::pg8_dma4(base, (unsigned)((li >> 2) * (DM * 2) + (li & 3) * 128), pfl + (unsigned)wave * 256u); } }
    }
    __device__ __forceinline__ void operator()(const AccT& acc, const Unit& u, int wr, int wc, int fr, int fq) const {
        const int row0 = u.i0 * 256; const bool isx = row0 < NX;
        const int cond = isx ? (row0 >> 12) : 8;
        const float* gatep = mod + (size_t)cond * MODW + u.i1 * 256;
        const float* sfb = srcf_x ? (isx ? srcf_x + (size_t)row0 * DM : srcf_c + (size_t)(row0 - NX) * DM) + u.i1 * 256 : nullptr;
        bf16* xhb = XH + (size_t)row0 * DM + u.i1 * 256;
        float* dfb = dstf ? dstf + (size_t)row0 * DM + u.i1 * 256 : nullptr;
        if constexpr (!MOE) {
        f32x4 gv[2][2];
#pragma unroll
        for (int bj = 0; bj < 2; ++bj)
#pragma unroll
            for (int n = 0; n < 2; ++n) gv[bj][n] = *(const GAS f32x4*)(gatep + COL8(bj) + 4 * n) * MO_INV;
#pragma unroll
        for (int ai = 0; ai < 2; ++ai) {
            f32x4 xo[4][2][2];
#pragma unroll
            for (int m = 0; m < 4; ++m)
#pragma unroll
                for (int bj = 0; bj < 2; ++bj) { const size_t o = (size_t)ROWL(ai, m) * DM + COL8(bj);
                    if (sfb) { xo[m][bj][0] = *(const GAS f32x4*)(sfb + o); xo[m][bj][1] = *(const GAS f32x4*)(sfb + o + 4); }
                    else { const v4u w = *(const GAS v4u*)(xhb + o); xo[m][bj][0] = (f32x4){bflo(w.x), bfhi(w.x), bflo(w.y), bfhi(w.y)}; xo[m][bj][1] = (f32x4){bflo(w.z), bfhi(w.z), bflo(w.w), bfhi(w.w)}; } }
#pragma unroll
            for (int m = 0; m < 4; ++m)
#pragma unroll
                for (int bj = 0; bj < 2; ++bj) { const size_t o = (size_t)ROWL(ai, m) * DM + COL8(bj);
                    const f32x4 r0 = xo[m][bj][0] + gv[bj][0] * acc[ai][bj][m][0], r1 = xo[m][bj][1] + gv[bj][1] * acc[ai][bj][m][1];
                    if (dfb) { *(GAS f32x4*)(dfb + o) = r0; *(GAS f32x4*)(dfb + o + 4) = r1; } else *(GAS v4u*)(xhb + o) = pack8(r0, r1); }
            asm volatile("" ::: "memory"); }
        } else {
#pragma unroll
        for (int ai = 0; ai < 2; ++ai)
#pragma unroll
            for (int m = 0; m < 4; ++m) { const int rl = ROWL(ai, m);
                {
                  const unsigned char* yp = (const unsigned char*)YS + (size_t)(row0 + rl) * (TOPK * DM) + u.i1 * 256 + 64 * wc + 16 * fq;
                  float sm[16];
#pragma unroll
                  for (int q = 0; q < 16; ++q) sm[q] = 0.f;
#pragma unroll
                  for (int k = 0; k < TOPK; ++k) { const v4u y = *(const GAS v4u*)(yp + (size_t)k * DM);
#pragma unroll
                      for (int w = 0; w < 4; ++w) { const f32x2 p0 = __builtin_amdgcn_cvt_pk_f32_fp8((int)y[w], false), p1 = __builtin_amdgcn_cvt_pk_f32_fp8((int)y[w], true);
                          sm[4 * w] += p0.x; sm[4 * w + 1] += p0.y; sm[4 * w + 2] += p1.x; sm[4 * w + 3] += p1.y; } }
                  f32x4 r[2][2];
#pragma unroll
                  for (int q = 0; q < 4; ++q) { r[0][0][q] = sm[q]; r[0][1][q] = sm[4 + q]; r[1][0][q] = sm[8 + q]; r[1][1][q] = sm[12 + q]; }
#pragma unroll
                  for (int bj = 0; bj < 2; ++bj) { const size_t o = (size_t)rl * DM + COL8(bj);
                    const f32x4 a = acc[ai][bj][m][0] + r[bj][0] * YS_INV, b = acc[ai][bj][m][1] + r[bj][1] * YS_INV;
                    const v4u w = *(const GAS v4u*)(xhb + o); const f32x4 g0 = *(const GAS f32x4*)(gatep + COL8(bj)), g1 = *(const GAS f32x4*)(gatep + COL8(bj) + 4);
                    const f32x4 r0 = (f32x4){bflo(w.x), bfhi(w.x), bflo(w.y), bfhi(w.y)} + g0 * a, r1 = (f32x4){bflo(w.z), bfhi(w.z), bflo(w.w), bfhi(w.w)} + g1 * b;
                    if (dfb) { *(GAS f32x4*)(dfb + o) = r0; *(GAS f32x4*)(dfb + o + 4) = r1; } else *(GAS v4u*)(xhb + o) = pack8(r0, r1); } }
                asm volatile("" ::: "memory"); }
        }
    }
};
struct EpiOddIn {
    static constexpr int VM_MIN = 0; static constexpr bool PREFETCH = false;
    bf16* Q; bf16* KB; bf16* VT; bf16* VTC; bf16* GZ; bf16* GO; const float* qg; const float* kg; const float* rope;
    __device__ __forceinline__ void operator()(const AccT& acc, const Unit& u, int wr, int wc, int fr, int fq) const {
        const int pn = u.i1, row0 = u.i0 * 256; const bool isx = row0 < NX;
        if (pn < 2 || (pn == 2 && wc < 2)) {
            const bool isq = pn < 2; const float* gp = isq ? qg : kg;
            f32x4 gn[2][2];
#pragma unroll
            for (int bj = 0; bj < 2; ++bj)
#pragma unroll
                for (int n = 0; n < 2; ++n) gn[bj][n] = *(const GAS f32x4*)(gp + 32 * n + 16 * bj + 4 * fq);
            const float osc = isq ? QSCALE : 1.0f;
#pragma unroll
            for (int ai = 0; ai < 2; ++ai)
#pragma unroll
                for (int m = 0; m < 4; ++m) { const int row = row0 + ROWL(ai, m);
                    float ss = 0.f;
#pragma unroll
                    for (int bj = 0; bj < 2; ++bj)
#pragma unroll
                        for (int n = 0; n < 2; ++n) { const f32x4 v = (acc[ai][bj][m][n] * OD_INV); ss += (v[0] * v[0] + v[1] * v[1]) + (v[2] * v[2] + v[3] * v[3]); }
                    ss += swz_xor<16>(ss); ss = x32_sum(ss);
                    const float rstd = osc / sqrtf(ss * (1.0f / 64.0f) + EPS_RMS);
                    f32x4 y[2][2];
#pragma unroll
                    for (int bj = 0; bj < 2; ++bj)
#pragma unroll
                        for (int n = 0; n < 2; ++n) y[bj][n] = (acc[ai][bj][m][n] * OD_INV) * rstd * gn[bj][n];
                    if (isx) { const int pos = row & (SEQ - 1);
#pragma unroll
                        for (int n = 0; n < 2; ++n) { const int P = n == 0 ? (pos >> 6) : (pos & 63);
                            const f32x4 cs = *(const GAS f32x4*)(rope + P * 16 + 4 * fq), sn = *(const GAS f32x4*)(rope + 1024 + P * 16 + 4 * fq);
                            const f32x4 x1 = y[0][n], x2 = y[1][n]; y[0][n] = x1 * cs - x2 * sn; y[1][n] = x2 * cs + x1 * sn; } }
                    bf16* dst = isq ? Q + (size_t)row * 512 + (4 * pn + wc) * 64 : KB + (size_t)row * 128 + wc * 64;
#pragma unroll
                    for (int bj = 0; bj < 2; ++bj)
#pragma unroll
                        for (int n = 0; n < 2; ++n) { v2u o; o.x = pg8::cvt_pk_bf16(y[bj][n][0], y[bj][n][1]); o.y = pg8::cvt_pk_bf16(y[bj][n][2], y[bj][n][3]); *(GAS v2u*)(dst + 32 * n + 16 * bj + 4 * fq) = o; }
                    asm volatile("" ::: "memory"); }
        } else if (pn == 2) {
            const int hk = wc & 1;
            const int L = isx ? SEQ : LCTX;
            bf16* ubase = isx ? VT + (size_t)(((row0 >> 12) * 2 + hk) * 64) * SEQ + (row0 & (SEQ - 1)) : VTC + (size_t)((((row0 - NX) >> 8) * 2 + hk) * 64) * LCTX;
#pragma unroll
            for (int ai = 0; ai < 2; ++ai)
#pragma unroll
                for (int m = 0; m < 4; ++m) { bf16* base = ubase + ROWL(ai, m);
#pragma unroll
                    for (int bj = 0; bj < 2; ++bj)
#pragma unroll
                        for (int n = 0; n < 2; ++n)
#pragma unroll
                            for (int e = 0; e < 4; ++e) base[(size_t)(32 * n + 16 * bj + 4 * fq + e) * L] = (bf16)f2bf((acc[ai][bj][m][n] * OD_INV)[e]);
                    asm volatile("" ::: "memory"); }
        } else if (pn < 7) {
#pragma unroll
            for (int ai = 0; ai < 2; ++ai)
#pragma unroll
                for (int m = 0; m < 4; ++m) { const int row = row0 + ROWL(ai, m);
                    *(GAS v4u*)(GZ + (size_t)row * 512 + 128 * (pn - 3) + 32 * wc + 8 * fq) = pack8(acc[ai][0][m][0] * acc[ai][1][m][0] * (OD_INV * OD_INV), acc[ai][0][m][1] * acc[ai][1][m][1] * (OD_INV * OD_INV)); }
        } else {
#pragma unroll
            for (int ai = 0; ai < 2; ++ai)
#pragma unroll
                for (int m = 0; m < 4; ++m) { bf16* rowp = GO + (size_t)(row0 + ROWL(ai, m)) * 512 + 256 * (pn - 7);
#pragma unroll
                    for (int bj = 0; bj < 2; ++bj) *(GAS v4u*)(rowp + COL8(bj)) = pack8(acc[ai][bj][m][0] * OD_INV, acc[ai][bj][m][1] * OD_INV); }
        }
    }
};
__device__ __forceinline__ f32x4 swiglu4(const f32x4 g, const f32x4 u) { f32x4 r; r[0] = silu_f(g[0]) * u[0]; r[1] = silu_f(g[1]) * u[1]; r[2] = silu_f(g[2]) * u[2]; r[3] = silu_f(g[3]) * u[3]; return r; }
struct EpiM1 {
    static constexpr int VM_MIN = 0; static constexpr bool PREFETCH = false;
    bf16* HS; float* LOG;
    __device__ __forceinline__ void operator()(const AccT& acc, const Unit& u, int wr, int wc, int fr, int fq) const {
        const int pn = u.i1, row0 = u.i0 * 256;
        if (pn < 2) {
#pragma unroll
            for (int ai = 0; ai < 2; ++ai)
#pragma unroll
                for (int m = 0; m < 4; ++m) *(GAS v4u*)(HS + (size_t)(row0 + ROWL(ai, m)) * 256 + 128 * pn + 32 * wc + 8 * fq) = pack8(swiglu4(acc[ai][0][m][0], acc[ai][1][m][0]), swiglu4(acc[ai][0][m][1], acc[ai][1][m][1]));
        } else if (wc < 2) {
#pragma unroll
            for (int ai = 0; ai < 2; ++ai)
#pragma unroll
                for (int m = 0; m < 4; ++m) { float* lp = LOG + (size_t)(row0 + ROWL(ai, m)) * 64 + 32 * wc + 8 * fq; *(GAS f32x4*)lp = acc[ai][0][m][0]; *(GAS f32x4*)(lp + 4) = acc[ai][0][m][1]; }
        }
    }
};
__device__ __forceinline__ void build_expert_prefix(const Frame& F0, int l) {
    PHASE_FRAME(F, F0);
    volatile LAS unsigned* pfx = F.MISC + 192;
    if (F.wave == 0) { const int e = F.lane; const unsigned c = __hip_atomic_load(F.ctl + CW_CNT + l * 64 + e, RLX_AGENT); pfx[128 + e] = c;
        const unsigned b = (c + 255u) >> 8; unsigned s = b;
#pragma unroll
        for (int d = 1; d < 64; d <<= 1) { const unsigned t = (unsigned)__builtin_amdgcn_ds_bpermute(((e - d) & 63) << 2, (int)s); s += (e >= d) ? t : 0u; }
        pfx[e] = s - b; if (e == 63) pfx[64] = s; }
    __syncthreads();
}
__device__ __forceinline__ unsigned lds_u(volatile LAS unsigned* p) { return (unsigned)__builtin_amdgcn_readfirstlane((int)*p); }
__device__ __forceinline__ int find_expert(volatile LAS unsigned* pfx, unsigned rbg) { int e = 0;
#pragma unroll
    for (int s = 32; s >= 1; s >>= 1) e += (lds_u(pfx + e + s) <= rbg) ? s : 0;
    return e; }
struct SchedExpertGU {
    static constexpr bool SPLIT_B = false, DENSE_A = false, CONST_LDB = true;
    const char* H; const char* EGU; const int* rtok; const unsigned* cnt; volatile LAS unsigned* pfx; int G, c; LAS unsigned char* desc;
    static constexpr bool PREFETCH_A = true, FP8 = true;
    static constexpr unsigned ROWB = 1024u, NROWS = (unsigned)NT;
    __device__ __forceinline__ const LAS int* table(const Unit& u) const { return (const LAS int*)(desc + u.mir * 1024); }

    __device__ __forceinline__ void prefetch_rows(const Unit& u, int wave) const {
        if (wave == 0) __builtin_amdgcn_global_load_lds((const unsigned*)((const char*)(rtok + (size_t)u.i0 * ECAP + u.i1 * 256) + lane_id_now() * 16), (LAS unsigned*)(desc + u.mir * 1024), 16, 0, 0); }
    __device__ __forceinline__ bool next(int i, Unit& u) const { const unsigned cp = G == 256 ? (unsigned)(((c & 7) << 5) | ((c >> 4) << 1) | ((c >> 3) & 1)) : (unsigned)c;
        const unsigned L = (unsigned)(i * G) + cp; if (L >= 2u * lds_u(pfx + 64)) return false; const unsigned rbg = L >> 1; const int t = L & 1, e = find_expert(pfx, rbg);
        u.A = H; u.B = EGU + ((size_t)e * 512 + t * 256) * 1024; u.nt = 8; u.ldb = 512;     u.i0 = e; u.i1 = (int)(rbg - lds_u(pfx + e)); u.i2 = t; u.i3 = (int)rbg * 256; u.mir = i & 1; return true; }
    __device__ __forceinline__ void aoff(const Unit& u, const int (&R)[2], const int (&C)[2], unsigned (&off)[2][2]) const {
        const int n = (int)lds_u(pfx + 128 + u.i0); const LAS int* rt = (const LAS int*)(desc + u.mir * 1024);
#pragma unroll
        for (int h = 0; h < 2; ++h)
#pragma unroll
            for (int i = 0; i < 2; ++i) { const int rho = 128 * h + R[i]; const int tok = (u.i1 * 256 + rho < n) ? (rt[rho] >> 3) : 0; off[h][i] = (unsigned)(tok * 512 + C[i]) * 2u; }
    }
};
struct EpiGU {
    static constexpr int VM_MIN = 0; static constexpr bool PREFETCH = false;
    unsigned char* HMID;
    __device__ __forceinline__ void operator()(const AccT& acc, const Unit& u, int wr, int wc, int fr, int fq) const {
#pragma unroll
        for (int ai = 0; ai < 2; ++ai)
#pragma unroll
            for (int m = 0; m < 4; ++m) { v2u o; o.x = fp8x4(swiglu4(acc[ai][0][m][0] * GU_INV, acc[ai][1][m][0] * GU_INV) * HM_SCALE); o.y = fp8x4(swiglu4(acc[ai][0][m][1] * GU_INV, acc[ai][1][m][1] * GU_INV) * HM_SCALE);
                *(GAS v2u*)(HMID + (size_t)(u.i3 + ROWL(ai, m)) * 256 + 128 * u.i2 + 32 * wc + 8 * fq) = o; asm volatile("" ::: "memory"); }
    }
};
struct SchedExpertDown {
    static constexpr bool PREFETCH_A = false, FP8 = true;
    static constexpr bool SPLIT_B = false, DENSE_A = true, CONST_LDB = true;
    const char* HMID; const char* EDN; volatile LAS unsigned* pfx; int G, c;
    __device__ __forceinline__ bool next(int i, Unit& u) const { const unsigned cp = G == 256 ? (unsigned)(((c & 7) << 5) | ((c >> 5) << 2) | ((c >> 3) & 3)) : (unsigned)c;
        const unsigned L = (unsigned)(i * G) + cp; if (L >= 4u * lds_u(pfx + 64)) return false; const unsigned rbg = L >> 2; const int pn = L & 3, e = find_expert(pfx, rbg);
        u.A = HMID + (size_t)rbg * 256 * 256; u.B = EDN + ((size_t)e * 1024 + pn * 256) * 256; u.nt = 2; u.ldb = 128;     u.i0 = e; u.i1 = (int)(rbg - lds_u(pfx + e)); u.i2 = pn; u.i3 = i & 1; return true; }
    __device__ __forceinline__ void aoff(const Unit&, const int (&R)[2], const int (&C)[2], unsigned (&off)[2][2]) const { dense_aoff(128, R, C, off); }
};
struct EpiDown {
    static constexpr int VM_MIN = 0;  static constexpr bool PREFETCH = true;
    bf16* YS; const int* rtok; const float* rgate; volatile LAS unsigned* pfx; unsigned char* dummy;
    LAS unsigned char* desc;
    __device__ __forceinline__ void prefetch(const Unit& u, int wave) const {
        if (wave < 2) { const size_t tb = (size_t)u.i0 * ECAP + u.i1 * 256; const char* src = wave == 0 ? (const char*)(rtok + tb) : (const char*)(rgate + tb);
            __builtin_amdgcn_global_load_lds((const unsigned*)(src + lane_id_now() * 16), (LAS unsigned*)(desc + u.i3 * 2048 + wave * 1024), 16, 0, 0); }
    }
    __device__ __forceinline__ void operator()(const AccT& acc, const Unit& u, int wr, int wc, int fr, int fq) const {
        const int n = (int)lds_u(pfx + 128 + u.i0); const LAS int* dt = (const LAS int*)(desc + u.i3 * 2048); const LAS float* dg = (const LAS float*)(dt + 256);
#pragma unroll
        for (int ai = 0; ai < 2; ++ai)
#pragma unroll
            for (int m = 0; m < 4; ++m) { const int rho = ROWL(ai, m); const bool ok = u.i1 * 256 + rho < n; const int t = dt[rho]; const float g = dg[rho] * (YS_SCALE * DN_INV);
                const unsigned x0 = fp8x4(acc[ai][0][m][0] * g), y0 = fp8x4(acc[ai][0][m][1] * g), x1 = fp8x4(acc[ai][1][m][0] * g), y1 = fp8x4(acc[ai][1][m][1] * g);
                if (ok) *(GAS v4u*)((unsigned char*)YS + ((size_t)(t >> 3) * TOPK + (t & 7)) * DM + u.i2 * 256 + 64 * wc + 16 * fq) = (v4u){x0, y0, x1, y1};
                asm volatile("" ::: "memory"); }
    }
};
constexpr int NPHASES = 1 + 9 * DEPTH;
#ifndef PHMASK
#define PHMASK 0x3ff
#endif
#define PH_ON(k) ((PHMASK >> (k)) & 1)
#ifndef REPSEL
#define REPSEL -1
#endif
#ifndef REPPAR
#define REPPAR -1
#endif
#define NREP(k) ((REPSEL == (k) && (REPPAR < 0 || REPPAR == (l & 1))) ? 2 : 1)
#ifndef PHSUB
#define PHSUB 0xf
#endif
struct Args { const float* in[26]; float* out; unsigned char* ws; int ph_lo, ph_hi; };
static_assert(sizeof(Args) == 26 * 8 + 8 + 8 + 8, "Args has no padding");

__global__ void __launch_bounds__(NWAVES * 64, 2) fwd_kernel(Args args) {
    extern __shared__ __attribute__((aligned(16))) unsigned char lds_raw[];
    Frame F;
    F.lds = (LAS unsigned char*)lds_raw;
    F.MISC = (volatile LAS unsigned*)(F.lds + MISC_OFF);
    F.wave = __builtin_amdgcn_readfirstlane((int)threadIdx.x >> 6); F.lane = 0; F.tid = 0;
    F.G = gridDim.x; F.bx = blockIdx.x;
    F.ws = args.ws; F.out = args.out; F.ctl = (unsigned*)(args.ws + WS_CTL);
    F.in = args.in;
    for (int u = threadIdx.x; u < (LDS_BYTES - MISC_OFF) / 4; u += NWAVES * 64) F.MISC[u] = 0u;
    __syncthreads();
    const int lo = args.ph_lo, hi = args.ph_hi;
    const bool use_bar = (hi - lo) > 1;
    XcdBarrier bar; bar.bar = F.ctl + CW_BAR; bar.x = 0; bar.st = nullptr; bar.wave = F.wave;
    if (use_bar) bar = xcd_barrier_post(F.ctl + CW_BAR, F.MISC + 8);
#define IN(k) (lo <= (k) && (k) < hi)
#define SEAM(k) do { if (IN(k) && IN((k) + 1)) xcd_barrier(bar); } while (0)
    LAS unsigned char* ring = F.lds;
#define STEAL_IF_IDLE(total_units, layer, quota) do { const int rem_ = (total_units) % F.G; if ((layer) < DEPTH && rem_ != 0 && F.bx >= rem_) expert_convert_steal(F, (layer), (quota)); } while (0)
    const int gw = F.bx * NWAVES + F.wave, NGW = F.G * NWAVES;

    if (PH_ON(0) && IN(0)) { const int l = 0; for (int rep = 0; rep < NREP(0); ++rep) p0_prologue(F); }
    SEAM(0);
#ifdef PROBE_CHECK
    check_mod(F);
#endif

#pragma unroll 1
    for (int l = 0; l < DEPTH; ++l) {
        const int pb = 1 + 9 * l;
        const bool odd = (l & 1) != 0, lastl = (l == DEPTH - 1);
        const int e2 = l >> 1;
        const int nrows = lastl ? NX : NT;
        const float* modl = wsp<const float>(F, WS_MOD) + (size_t)l * 9 * MODW;

        if (PH_ON(1) && IN(pb + 0)) for (int rep = 0; rep < NREP(1); ++rep) {
            norm_phase(F, l, NT, l == 0, F.in[I_N1G] + l * DM, 0, 1, false, true);
        }
#ifdef PROBE_CHECK
        if (l == 0) { xcd_barrier(bar); check_norm(F, l, NT, true, F.in[I_N1G] + l * DM, 0, 1, 9); }
#endif
        SEAM(pb + 0);

        if (PH_ON(2) && IN(pb + 1)) for (int rep = 0; rep < NREP(2); ++rep) {
            if ((PHSUB & 1) && !odd) {
                SchedE1 S{(const char*)wsp<unsigned char>(F, WS_H8), (const char*)(wsp<unsigned char>(F, WS_EVUV) + (size_t)e2 * 1024 * 1024), (const char*)(wsp<unsigned char>(F, WS_EVF) + (size_t)e2 * 1024 * 1024), NT / 256, F.G, F.bx};
                EpiE1 E{wsp<bf16>(F, WS_PROJ + PJ_UV), wsp<bf16>(F, WS_PROJ + PJ_GT), wsp<bf16>(F, WS_PROJ + PJ_GTC)};
                pg8::gemm_phase(ring, F.wave, S, E);
                STEAL_IF_IDLE(2 * (NT / 256) * 4, l, 1);
            } else if ((PHSUB & 2) && odd) {
                SchedDenseT<true> S{(const char*)wsp<unsigned char>(F, WS_H8), (const char*)(wsp<unsigned char>(F, WS_ODIN) + (size_t)e2 * 2304 * 1024), NT / 256, 9, 512, 512, 8, F.G, F.bx};
                EpiOddIn E{wsp<bf16>(F, WS_PROJ + PJ_Q), wsp<bf16>(F, WS_PROJ + PJ_KV), wsp<bf16>(F, WS_PROJ + PJ_VT), wsp<bf16>(F, WS_PROJ + PJ_VTC), wsp<bf16>(F, WS_PROJ + PJ_GZ), wsp<bf16>(F, WS_PROJ + PJ_GO),
                           F.in[I_ODQG] + e2 * 64, F.in[I_ODKG] + e2 * 64, wsp<const float>(F, WS_ROPE)};
                pg8::gemm_phase(ring, F.wave, S, E);
                STEAL_IF_IDLE((NT / 256) * 9, l, 1);
            }
        }
#ifdef PROBE_CHECK
        if (l == 0) { xcd_barrier(bar); check_e1(F, e2); }
#endif
        SEAM(pb + 1);

        if (PH_ON(3) && IN(pb + 2)) for (int rep = 0; rep < NREP(3); ++rep) {
            if ((PHSUB & 1) && !odd) {
                SchedFourier<false> S{(const char*)wsp<bf16>(F, WS_DFT), (const char*)wsp<bf16>(F, WS_PROJ + PJ_GT), F.G, F.bx};
                EpiFourier<false> E{wsp<bf16>(F, WS_MIX), wsp<bf16>(F, WS_PROJ + PJ_PQ)};
                pg8::gemm_phase(ring, F.wave, S, E);
                SchedFourier<true> SC{(const char*)wsp<bf16>(F, WS_DFTC), (const char*)wsp<bf16>(F, WS_PROJ + PJ_GTC), F.G, (F.bx + 16) % F.G};
                EpiFourier<true> EC{wsp<bf16>(F, WS_MIX), wsp<bf16>(F, WS_PROJ + PJ_PQ)};
                pg8::gemm_phase(ring, F.wave, SC, EC);
                __syncthreads();
                if (PHSUB & 4) gmlp_phase(F, e2, NT / 128);
                fourier_nyq_phase(F, e2);
#ifdef REPG
                gmlp_phase(F, e2, NT / 128);
#endif
            } else if ((PHSUB & 2) && odd) {
#ifdef PROBE_ATTN
                attn_phase_naive(F, e2, !lastl);
#else
                attn_phase(F, e2, !lastl);
#endif
                if (PHSUB & 8) conv_phase(F, e2, nrows);
#ifdef REPC
                conv_phase(F, e2, nrows);
#endif
            }
        }
#ifdef PROBE_CHECK
        if (l == 0) { xcd_barrier(bar); check_gmlp(F, e2); check_fourier(F); }
#endif
        SEAM(pb + 2);
        if (!odd && PH_ON(3) && IN(pb + 2)) { fourier_combine_phase(F); if (IN(pb + 3)) xcd_barrier(bar); }

        if (PH_ON(4) && IN(pb + 3)) {
            const unsigned char* W = (odd ? wsp<unsigned char>(F, WS_ODOUT) : wsp<unsigned char>(F, WS_EVOUT)) + (size_t)e2 * 1024 * 1024;
            SchedDenseT<true> S{(const char*)wsp<unsigned char>(F, WS_MIX), (const char*)W, nrows / 256, 4, 512, 512, 8, F.G, F.bx};
            EpiResid<false> E{l == 0 ? F.in[I_X] : nullptr, l == 0 ? F.in[I_CTX] : nullptr, nullptr, wsp<bf16>(F, WS_XH), modl + 2 * DM, nullptr, (unsigned)(unsigned long)(F.lds + MISC_OFF + 4096)};
            pg8::gemm_phase(ring, F.wave, S, E);
            STEAL_IF_IDLE((nrows / 256) * 4, l, 1);
        }
#ifdef PROBE_CHECK
        if (l == 0) { xcd_barrier(bar); check_e4(F, l, e2); }
#endif
        SEAM(pb + 3);

        if (PH_ON(5) && IN(pb + 4)) for (int rep = 0; rep < NREP(5); ++rep) norm_phase(F, l, nrows, false, F.in[I_N2G] + l * DM, 3, 4, true, true);
#ifdef PROBE_CHECK
        if (l == 0) { xcd_barrier(bar); check_norm(F, l, nrows, false, F.in[I_N2G] + l * DM, 3, 4, 15); }
#endif
        SEAM(pb + 4);

        if (PH_ON(6) && IN(pb + 5)) {
            SchedDense S{(const char*)wsp<bf16>(F, WS_H), (const char*)(wsp<bf16>(F, WS_RS) + (size_t)l * 768 * 1024), nrows / 256, 3, 1024, 1024, 16, F.G, F.bx};
            EpiM1 E{wsp<bf16>(F, WS_HS), wsp<float>(F, WS_LOG)};
            for (int rep = 0; rep < NREP(6); ++rep) pg8::gemm_phase(ring, F.wave, S, E);
            VM_WAIT(); __syncthreads();
            Unit u;
            for (int i = 0; S.next(i, u); ++i) if (u.i1 == 2) topk_rows(F, l, u.i0 * 256);
            expert_convert_steal(F, l, -1);
        }
        SEAM(pb + 5);

        if (PH_ON(7) && IN(pb + 6)) for (int rep = 0; rep < NREP(7); ++rep) {
            build_expert_prefix(F, l);
            SchedExpertGU S{(const char*)wsp<unsigned char>(F, WS_H8), (const char*)wsp<bf16>(F, WS_EGU), wsp<const int>(F, WS_RTOK), F.ctl + CW_CNT + l * 64, F.MISC + 192, F.G, F.bx, F.lds + MISC_OFF + 4096};
            EpiGU E{wsp<unsigned char>(F, WS_PROJ)};
            pg8::gemm_phase(ring, F.wave, S, E);
        }
        SEAM(pb + 6);

        if (PH_ON(8) && IN(pb + 7)) for (int rep = 0; rep < NREP(8); ++rep) {
            build_expert_prefix(F, l);
            SchedExpertDown S{(const char*)wsp<bf16>(F, WS_PROJ), (const char*)wsp<bf16>(F, WS_EDN), F.MISC + 192, F.G, F.bx};
            EpiDown E{wsp<bf16>(F, WS_YS), wsp<const int>(F, WS_RTOK), wsp<const float>(F, WS_RGATE), F.MISC + 192, wsp<unsigned char>(F, WS_LOG) + (size_t)F.bx * 8192, F.lds + MISC_OFF + 4096};
            pg8::gemm_phase(ring, F.wave, S, E);
        }
#ifdef PROBE_CHECK
        stash_phase(F, l, nrows);
#endif
        SEAM(pb + 7);

        if (PH_ON(9) && IN(pb + 8)) {
            SchedDense S{(const char*)wsp<bf16>(F, WS_HS), (const char*)(wsp<bf16>(F, WS_SHDN) + (size_t)l * 1024 * 256), nrows / 256, 4, 256, 256, 4, F.G, F.bx};
            EpiResid<true> E{nullptr, nullptr, lastl ? F.out : nullptr, wsp<bf16>(F, WS_XH), modl + 5 * DM, wsp<const bf16>(F, WS_YS), 0u};
            pg8::gemm_phase(ring, F.wave, S, E);
            STEAL_IF_IDLE((nrows / 256) * 4, l + 1, 2);
        }
#ifdef PROBE_CHECK
        xcd_barrier(bar); check_moe(F, l, nrows); xcd_barrier(bar);
#else
        SEAM(pb + 8);
#endif
    }
#ifdef PROBE_CHECK
    xcd_barrier(bar); encode_phase(F, 16);
#endif
#undef IN
#undef SEAM
}

#ifndef MK_MULTI
#define MK_MULTI 0
#endif
extern "C" void kernel_launch(void* const* d_in, const int* in_sizes, int n_in, void* d_out, int out_size, void* d_ws, size_t ws_size, hipStream_t stream) {
    static int grid = 0;
    if (grid == 0) {
        if (n_in != 26 || out_size != NX * DM || ws_size < WS_END) { fprintf(stderr, "kernel_launch: unexpected shapes (n_in %d out %d ws %zu need %zu)\n", n_in, out_size, ws_size, (size_t)WS_END); grid = -1; return; }
        int dev = 0, cus = 0, per_cu = 0;
        if (hipGetDevice(&dev) != hipSuccess || hipDeviceGetAttribute(&cus, hipDeviceAttributeMultiprocessorCount, dev) != hipSuccess) { grid = -1; return; }
        if (hipFuncSetAttribute((const void*)fwd_kernel, hipFuncAttributeMaxDynamicSharedMemorySize, LDS_BYTES) != hipSuccess) { fprintf(stderr, "kernel_launch: hipFuncSetAttribute failed\n"); grid = -1; return; }
        if (hipOccupancyMaxActiveBlocksPerMultiprocessor(&per_cu, (const void*)fwd_kernel, NWAVES * 64, LDS_BYTES) != hipSuccess || per_cu < 1) fprintf(stderr, "kernel_launch: occupancy query says %d\n", per_cu);
        (void)hipGetLastError();
        grid = cus;
    }
    if (grid < 0) return;
    (void)hipMemsetAsync((char*)d_ws + WS_CTL, 0, CTL_ZERO_BYTES, stream);
    Args a{};
    for (int i = 0; i < 26; ++i) a.in[i] = (const float*)d_in[i];
    a.out = (float*)d_out; a.ws = (unsigned char*)d_ws;
#if MK_MULTI
    for (int p = 0; p < NPHASES; ++p) { a.ph_lo = p; a.ph_hi = p + 1; hipLaunchKernelGGL(fwd_kernel, dim3(grid), dim3(NWAVES * 64), LDS_BYTES, stream, a); }
#else
    a.ph_lo = 0; a.ph_hi = NPHASES;
    hipLaunchKernelGGL(fwd_kernel, dim3(grid), dim3(NWAVES * 64), LDS_BYTES, stream, a);
#endif
}
```
